# Optimizing an MI355X kernel written in HIP

```python
import math
import jax, jax.numpy as jnp
from jax import lax
import numpy as np

D_MODEL = 2048
BATCH = 2
SEQ = 4096
DEPTH = 2

CTX_LEN = 256
GRID_W = 64
MIX_WIDTH = D_MODEL
N_MIXERS = 4
GROUP_W = MIX_WIDTH // N_MIXERS
S5_CH = 16
S5_GROUPS = GROUP_W // S5_CH
S5_STATE = 64
S5_DT_MIN = 1e-3
S5_DT_MAX = 1e-1
SG_HEADS = 4
SG_HEAD_DIM = GROUP_W // SG_HEADS
SG_CHUNK = 128
POOL_WINDOWS = (2, 4, 8, 16)
POOL_DIM = GROUP_W // len(POOL_WINDOWS)
M2_HEAD_DIM = 64
M2_HEADS = GROUP_W // M2_HEAD_DIM
M2_STATE = 128
M2_GROUPS = 2
M2_CONV = 4
M2_PAD = (M2_CONV // 2, M2_CONV - 1 - M2_CONV // 2)
M2_CHUNK = 128
M2_XBC = GROUP_W + 2 * M2_GROUPS * M2_STATE
M2_DT_MIN = 1e-3
M2_DT_MAX = 1e-1
IN_SIZES = (GROUP_W, GROUP_W, GROUP_W, GROUP_W, GROUP_W, M2_XBC, 2 * M2_HEADS)
IN_WIDTH = 5 * GROUP_W + M2_XBC + 2 * M2_HEADS
FFN_HIDDEN = ((8 * D_MODEL // 3 + 255) // 256) * 256
FFN_CONV = 3
DEEPNORM_ALPHA = (2 * DEPTH) ** 0.25
DEEPNORM_BETA = (8 * DEPTH) ** -0.25
LN_EPS = 1e-5
RMS_EPS = 1e-5

kernel_name = "hybrid_parallel_s5_gmlp_pool_ssd_dit"


def layer_norm(x, g, b):
    xf = x.astype(jnp.float32)
    mu = jnp.mean(xf, -1, keepdims=True)
    var = jnp.mean(jnp.square(xf - mu), -1, keepdims=True)
    return ((xf - mu) * lax.rsqrt(var + LN_EPS) * g + b).astype(x.dtype)


def modulate(x, shift, scale):
    return x * (1 + scale) + shift


def split_in(p):
    offs, o = [], 0
    for s in IN_SIZES[:-1]:
        o += s
        offs.append(o)
    return jnp.split(p, offs, axis=-1)


def dw_conv1d(x, w, b, pad):
    y = lax.conv_general_dilated(x, w[:, None, :].astype(x.dtype), window_strides=(1,), padding=[pad],
                                 dimension_numbers=('NWC', 'WIO', 'NWC'), feature_group_count=x.shape[-1])
    return y + b.astype(x.dtype)


def _lin_combine(e1, e2):
    a1, b1 = e1
    a2, b2 = e2
    return a2 * a1, a2 * b1 + b2


def s5_states(u, a_bar, b_bar, h0, reverse):
    bu = jnp.einsum('blgh,gph->blgp', u.astype(jnp.complex64), b_bar)
    a = jnp.broadcast_to(a_bar, (1, u.shape[1]) + a_bar.shape)
    a_cum, h = lax.associative_scan(_lin_combine, (a, bu), reverse=reverse, axis=1)
    return h + a_cum * h0[:, None]


def s5_mixer(u_ctx, u_lat, a_re, a_im, b_re, b_im, c_re, c_im, log_step, d, glu_w, glu_b, need_ctx):
    f32 = jnp.float32

    def groups(u):
        return u.astype(f32).reshape(u.shape[0], u.shape[1], S5_GROUPS, S5_CH)

    uc, ul = groups(u_ctx), groups(u_lat)
    ys_ctx, ys_lat = [], []
    for direction, reverse in enumerate((False, True)):
        lam = lax.complex(a_re[direction].astype(f32), a_im[direction].astype(f32))
        step = jnp.exp(log_step[direction].astype(f32))[:, None]
        a_bar = jnp.exp(lam * step)
        b_bar = ((a_bar - 1.0) / lam)[..., None] * lax.complex(b_re[direction].astype(f32),
                                                               b_im[direction].astype(f32))
        c_mat = lax.complex(c_re[direction].astype(f32), c_im[direction].astype(f32))
        h0 = jnp.zeros((uc.shape[0], S5_GROUPS, S5_STATE), jnp.complex64)
        hc = s5_states(uc, a_bar, b_bar, h0, reverse)
        hc_final = hc[:, 0] if reverse else hc[:, -1]
        hl = s5_states(ul, a_bar, b_bar, hc_final, reverse)
        ys_lat.append(jnp.einsum('blgp,ghp->blgh', hl, c_mat).real)
        if need_ctx:
            ys_ctx.append(jnp.einsum('blgp,ghp->blgh', hc, c_mat).real)

    def finish(ys, u, u_orig):
        y = (ys[0] + ys[1] + d.astype(f32).reshape(S5_GROUPS, S5_CH) * u).reshape(u_orig.shape)
        z = jax.nn.gelu(y)
        return (z * jax.nn.sigmoid(z @ glu_w.astype(f32) + glu_b.astype(f32))).astype(u_orig.dtype)

    y_lat = finish(ys_lat, ul, u_lat)
    y_ctx = finish(ys_ctx, uc, u_ctx) if need_ctx else None
    return y_ctx, y_lat


def chunk_gating(u, v, ln_g, ln_b, w_s, b_s):
    bsz, l, _ = u.shape
    u = jax.nn.gelu(u)
    v = jax.nn.gelu(v).reshape(bsz, l // SG_CHUNK, SG_CHUNK, SG_HEADS, SG_HEAD_DIM)
    v = layer_norm(v, ln_g.reshape(SG_HEADS, SG_HEAD_DIM), ln_b.reshape(SG_HEADS, SG_HEAD_DIM))
    s = jnp.einsum('hij,bcjhd->bcihd', w_s, v) + b_s.T[None, None, :, :, None]
    return u * s.reshape(bsz, l, GROUP_W)


def pool_mixer(p, w, bias, scale):
    bsz, l, _ = p.shape
    pf = p.astype(jnp.float32)
    csum = jnp.pad(jnp.cumsum(pf, axis=1), ((0, 0), (1, 0), (0, 0)))
    t = jnp.arange(l)
    outs = []
    for g, win in enumerate(POOL_WINDOWS):
        lo = jnp.clip(t - win // 2, 0, l - 1)
        hi = jnp.clip(t + win // 2 - 1, 0, l - 1)
        sl = slice(g * POOL_DIM, (g + 1) * POOL_DIM)
        cs = csum[..., sl]
        total = jnp.take(cs, hi + 1, axis=1) - jnp.take(cs, lo, axis=1)
        mean = total / (hi - lo + 1).astype(jnp.float32)[None, :, None]
        outs.append(jnp.einsum('blc,cd->bld', mean - pf[..., sl], w[g]))
    y = jnp.concatenate(outs, axis=-1) + bias
    return (y * scale).astype(p.dtype)


def m2_prepare(xbc, dt_raw, conv_w, conv_b, dt_bias):
    f32 = jnp.float32
    xbc = jax.nn.silu(dw_conv1d(xbc, conv_w, conv_b, M2_PAD)).astype(f32)
    bsz, l, _ = xbc.shape
    n_bc = M2_GROUPS * M2_STATE
    rep = M2_HEADS // M2_GROUPS
    xs = xbc[..., :GROUP_W].reshape(bsz, l, M2_HEADS, M2_HEAD_DIM)
    bm = jnp.repeat(xbc[..., GROUP_W:GROUP_W + n_bc].reshape(bsz, l, M2_GROUPS, M2_STATE), rep, axis=2)
    cm = jnp.repeat(xbc[..., GROUP_W + n_bc:].reshape(bsz, l, M2_GROUPS, M2_STATE), rep, axis=2)
    dt = jax.nn.softplus(dt_raw.astype(f32).reshape(bsz, l, 2, M2_HEADS) + dt_bias.astype(f32))
    return xs, bm, cm, dt


def ssd_scan(xs, dt, a, bm, cm, h0, need_y):
    bsz, l, nh, hp = xs.shape
    nc = l // M2_CHUNK

    def chunks(t):
        return t.reshape((bsz, nc, M2_CHUNK) + t.shape[2:])

    xd = chunks(xs * dt[..., None])
    bc, cc = chunks(bm), chunks(cm)
    a_cum = jnp.cumsum(chunks(dt * a), axis=2)
    a_tot = a_cum[:, :, -1]
    decay_end = jnp.exp(a_tot[:, :, None] - a_cum)
    chunk_states = jnp.einsum('bcqhn,bcqh,bcqhp->bchpn', bc, decay_end, xd)

    def step(s, inp):
        tot, st = inp
        return jnp.exp(tot)[..., None, None] * s + st, s

    h_final, h_prev = lax.scan(step, h0, (jnp.moveaxis(a_tot, 1, 0), jnp.moveaxis(chunk_states, 1, 0)))
    if not need_y:
        return None, h_final
    h_prev = jnp.moveaxis(h_prev, 0, 1)
    seg = a_cum[:, :, :, None, :] - a_cum[:, :, None, :, :]
    lower = jnp.tril(jnp.ones((M2_CHUNK, M2_CHUNK), bool))[None, None, :, :, None]
    decay = jnp.exp(jnp.where(lower, seg, -jnp.inf))
    scores = jnp.einsum('bcihn,bcjhn->bcijh', cc, bc) * decay
    y = (jnp.einsum('bcijh,bcjhp->bcihp', scores, xd)
         + jnp.einsum('bcihn,bchpn->bcihp', cc, h_prev) * jnp.exp(a_cum)[..., None])
    return y.reshape(bsz, l, nh, hp), h_final


def ssd_direction(inputs, direction, a, h0, need_y):
    xs, bm, cm, dt = inputs
    dt = dt[:, :, direction]
    if direction == 1:
        xs, bm, cm, dt = (jnp.flip(t, 1) for t in (xs, bm, cm, dt))
    y, h_final = ssd_scan(xs, dt, a, bm, cm, h0, need_y)
    if direction == 1 and y is not None:
        y = jnp.flip(y, 1)
    return y, h_final


def gated_rmsnorm(y, z, w):
    bsz, l, _ = z.shape
    g = (y * jax.nn.silu(z.astype(jnp.float32))).reshape(bsz, l, M2_GROUPS, GROUP_W // M2_GROUPS)
    g = g * lax.rsqrt(jnp.mean(jnp.square(g), -1, keepdims=True) + RMS_EPS)
    return (g.reshape(bsz, l, GROUP_W) * w.astype(jnp.float32)).astype(z.dtype)


def mamba2_mixer(z_ctx, xbc_ctx, dt_ctx, z_lat, xbc_lat, dt_lat, conv_w, conv_b, dt_bias, a_log, d,
                 norm_w, need_ctx):
    ctx_in = m2_prepare(xbc_ctx, dt_ctx, conv_w, conv_b, dt_bias)
    lat_in = m2_prepare(xbc_lat, dt_lat, conv_w, conv_b, dt_bias)
    a = -jnp.exp(a_log.astype(jnp.float32))
    ys_ctx, ys_lat = [], []
    for direction in range(2):
        h0 = jnp.zeros((ctx_in[0].shape[0], M2_HEADS, M2_HEAD_DIM, M2_STATE), jnp.float32)
        y_c, h_c = ssd_direction(ctx_in, direction, a[direction], h0, need_ctx)
        y_l, _ = ssd_direction(lat_in, direction, a[direction], h_c, True)
        ys_lat.append(y_l)
        if need_ctx:
            ys_ctx.append(y_c)
    d_h = d.astype(jnp.float32)[None, None, :, None]

    def finish(ys, xs, z):
        y = (ys[0] + ys[1] + d_h * xs).reshape(z.shape[0], z.shape[1], GROUP_W)
        return gated_rmsnorm(y, z, norm_w)

    y_lat = finish(ys_lat, lat_in[0], z_lat)
    y_ctx = finish(ys_ctx, ctx_in[0], z_ctx) if need_ctx else None
    return y_ctx, y_lat


def conv_ffn(h, w_up, conv_w, conv_b, w_down, rows):
    gate, val = jnp.split(h @ w_up, 2, axis=-1)
    bsz, l, f = gate.shape
    if rows is None:
        gate = dw_conv1d(gate, conv_w[FFN_CONV // 2], conv_b, (FFN_CONV // 2, FFN_CONV // 2))
    else:
        g2 = gate.reshape(bsz, rows, GRID_W, f)
        g2 = lax.conv_general_dilated(g2, conv_w[:, :, None, :].astype(g2.dtype), (1, 1), 'SAME',
                                      dimension_numbers=('NHWC', 'HWIO', 'NHWC'), feature_group_count=f)
        gate = g2.reshape(bsz, l, f) + conv_b.astype(gate.dtype)
    return (jax.nn.gelu(gate) * val) @ w_down


def setup_inputs(seed: int = 0) -> dict:
    key = jax.random.key(seed)
    ks = iter(jax.random.split(key, 64))
    f32 = jnp.float32
    L, D, F = DEPTH, D_MODEL, FFN_HIDDEN

    def nrm(shape, s):
        return s * jax.random.normal(next(ks), shape, f32)

    def unif(shape, lo, hi):
        return jax.random.uniform(next(ks), shape, f32, lo, hi)

    n_idx = jnp.arange(S5_STATE, dtype=f32)
    m2_dt = jnp.exp(unif((L, 2, M2_HEADS), math.log(M2_DT_MIN), math.log(M2_DT_MAX)))
    return {
        'x': nrm((BATCH, SEQ, D), 1.0),
        'c': nrm((BATCH, D), 1.0),
        'ctx': nrm((BATCH, CTX_LEN, D), 1.0),
        'c_ctx': nrm((D,), 1.0),
        'w_ada': nrm((L, D, 6 * D), 0.5 * D ** -0.5),
        'b_ada': nrm((L, 6 * D), 0.01),
        'w_in': nrm((L, D, IN_WIDTH), D ** -0.5),
        'w_out': nrm((L, MIX_WIDTH, D), DEEPNORM_BETA * MIX_WIDTH ** -0.5),
        'ln1_g': 1.0 + nrm((L, D), 0.02),
        'ln1_b': nrm((L, D), 0.02),
        'ln2_g': 1.0 + nrm((L, D), 0.02),
        'ln2_b': nrm((L, D), 0.02),
        's5_a_re': -0.5 + nrm((L, 2, S5_GROUPS, S5_STATE), 0.01),
        's5_a_im': math.pi * n_idx + nrm((L, 2, S5_GROUPS, S5_STATE), 0.01),
        's5_b_re': nrm((L, 2, S5_GROUPS, S5_STATE, S5_CH), (2 * S5_CH) ** -0.5),
        's5_b_im': nrm((L, 2, S5_GROUPS, S5_STATE, S5_CH), (2 * S5_CH) ** -0.5),
        's5_c_re': nrm((L, 2, S5_GROUPS, S5_CH, S5_STATE), 0.5),
        's5_c_im': nrm((L, 2, S5_GROUPS, S5_CH, S5_STATE), 0.5),
        's5_log_step': unif((L, 2, S5_GROUPS), math.log(S5_DT_MIN), math.log(S5_DT_MAX)),
        's5_d': nrm((L, GROUP_W), 1.0),
        's5_glu_w': nrm((L, GROUP_W, GROUP_W), GROUP_W ** -0.5),
        's5_glu_b': nrm((L, GROUP_W), 0.01),
        'sg_ln_g': 1.0 + nrm((L, GROUP_W), 0.02),
        'sg_ln_b': nrm((L, GROUP_W), 0.02),
        'sg_w': nrm((L, SG_HEADS, SG_CHUNK, SG_CHUNK), SG_CHUNK ** -0.5),
        'sg_b': 1.0 + nrm((L, SG_HEADS, SG_CHUNK), 0.01),
        'pool_w': nrm((L, len(POOL_WINDOWS), POOL_DIM, POOL_DIM), POOL_DIM ** -0.5),
        'pool_b': nrm((L, GROUP_W), 0.01),
        'pool_scale': 1.0 + nrm((L, GROUP_W), 0.02),
        'm2_conv_w': nrm((L, M2_CONV, M2_XBC), M2_CONV ** -0.5),
        'm2_conv_b': nrm((L, M2_XBC), 0.01),
        'm2_dt_bias': m2_dt + jnp.log(-jnp.expm1(-m2_dt)),
        'm2_a_log': jnp.log(unif((L, 2, M2_HEADS), 1.0, 16.0)),
        'm2_d': 1.0 + nrm((L, M2_HEADS), 0.01),
        'm2_norm_w': 1.0 + nrm((L, GROUP_W), 0.02),
        'ffn_w_up': nrm((L, D, 2 * F), D ** -0.5),
        'ffn_conv_w': nrm((L, FFN_CONV, FFN_CONV, F), 1.0 / FFN_CONV),
        'ffn_conv_b': nrm((L, F), 0.01),
        'ffn_w_down': nrm((L, F, D), DEEPNORM_BETA * F ** -0.5),
    }


def reference(x, c, ctx, c_ctx, w_ada, b_ada, w_in, w_out, ln1_g, ln1_b, ln2_g, ln2_b,
              s5_a_re, s5_a_im, s5_b_re, s5_b_im, s5_c_re, s5_c_im, s5_log_step, s5_d, s5_glu_w, s5_glu_b,
              sg_ln_g, sg_ln_b, sg_w, sg_b, pool_w, pool_b, pool_scale,
              m2_conv_w, m2_conv_b, m2_dt_bias, m2_a_log, m2_d, m2_norm_w,
              ffn_w_up, ffn_conv_w, ffn_conv_b, ffn_w_down):
    h_lat, h_ctx = x, ctx
    rows = h_lat.shape[1] // GRID_W
    silu_c = jax.nn.silu(c)[:, None, :]
    silu_cc = jax.nn.silu(c_ctx)[None, None, :]
    for i in range(DEPTH):
        need_ctx = i < DEPTH - 1
        m_lat = jnp.split(silu_c @ w_ada[i] + b_ada[i], 6, axis=-1)
        m_ctx = jnp.split(silu_cc @ w_ada[i] + b_ada[i], 6, axis=-1)

        pl = split_in(modulate(h_lat, m_lat[0], m_lat[1]) @ w_in[i])
        pc = split_in(modulate(h_ctx, m_ctx[0], m_ctx[1]) @ w_in[i])
        ya_ctx, ya_lat = s5_mixer(pc[0], pl[0], s5_a_re[i], s5_a_im[i], s5_b_re[i], s5_b_im[i],
                                  s5_c_re[i], s5_c_im[i], s5_log_step[i], s5_d[i], s5_glu_w[i],
                                  s5_glu_b[i], need_ctx)
        yd_ctx, yd_lat = mamba2_mixer(pc[4], pc[5], pc[6], pl[4], pl[5], pl[6], m2_conv_w[i], m2_conv_b[i],
                                      m2_dt_bias[i], m2_a_log[i], m2_d[i], m2_norm_w[i], need_ctx)
        mix_lat = jnp.concatenate([
            ya_lat,
            chunk_gating(pl[1], pl[2], sg_ln_g[i], sg_ln_b[i], sg_w[i], sg_b[i]),
            pool_mixer(pl[3], pool_w[i], pool_b[i], pool_scale[i]),
            yd_lat], axis=-1) @ w_out[i]
        h_lat = layer_norm(DEEPNORM_ALPHA * h_lat + m_lat[2] * mix_lat, ln1_g[i], ln1_b[i])
        if need_ctx:
            mix_ctx = jnp.concatenate([
                ya_ctx,
                chunk_gating(pc[1], pc[2], sg_ln_g[i], sg_ln_b[i], sg_w[i], sg_b[i]),
                pool_mixer(pc[3], pool_w[i], pool_b[i], pool_scale[i]),
                yd_ctx], axis=-1) @ w_out[i]
            h_ctx = layer_norm(DEEPNORM_ALPHA * h_ctx + m_ctx[2] * mix_ctx, ln1_g[i], ln1_b[i])

        f_lat = conv_ffn(modulate(h_lat, m_lat[3], m_lat[4]), ffn_w_up[i], ffn_conv_w[i], ffn_conv_b[i],
                         ffn_w_down[i], rows)
        h_lat = layer_norm(DEEPNORM_ALPHA * h_lat + m_lat[5] * f_lat, ln2_g[i], ln2_b[i])
        if need_ctx:
            f_ctx = conv_ffn(modulate(h_ctx, m_ctx[3], m_ctx[4]), ffn_w_up[i], ffn_conv_w[i], ffn_conv_b[i],
                             ffn_w_down[i], None)
            h_ctx = layer_norm(DEEPNORM_ALPHA * h_ctx + m_ctx[5] * f_ctx, ln2_g[i], ln2_b[i])
    return h_lat
```

```cpp
#include <hip/hip_runtime.h>
#include <hip/hip_cooperative_groups.h>
#include <cstdio>
#include <cstdint>
namespace cg = cooperative_groups;
namespace pg8 {
#define PG8_LAS __attribute__((address_space(3)))
typedef unsigned short bf16_t;
typedef short bf16x8 __attribute__((ext_vector_type(8)));
typedef float f32x4 __attribute__((ext_vector_type(4)));
typedef unsigned u32x4 __attribute__((ext_vector_type(4)));
constexpr int BM = 256, BK = 64, HALF = 128, HTB = HALF * BK * 2  , STAGE_BYTES = 8 * HTB, NXCD = 8, WGM = 8;

__host__ __device__ __forceinline__ int lds_byte(int r, int c) { const int st = (r >> 4) * 2 + (c >> 5), rr = r & 15, cc = c & 31, ob = rr * 64 + cc * 2; return st * 1024 + (ob ^ (((ob >> 9) & 1) << 5)); }
__host__ __device__ __forceinline__ void stage_rc(int b, int& R, int& C) { const int st = b / 1024, sb = b % 1024, swz = sb ^ (((sb >> 9) & 1) << 5); R = (st >> 1) * 16 + swz / 64; C = (st & 1) * 32 + (swz % 64) / 2; }
__host__ __device__ __forceinline__ int perm32(int rho) { const int n = rho >> 4, i = rho & 15; return 8 * (i >> 2) + 4 * n + (i & 3); }

struct Unit { int pm, pn; };
struct Gemm { const bf16_t* A; const bf16_t* Bt; int M, N, K; };

struct StaticOrder {
    int nM, nN, nwg, G, c;
    __host__ __device__ void init(int M, int N, int G_, int c_) { nM = M / BM; nN = N / BM; nwg = nM * nN; G = G_; c = c_; }
    __host__ __device__ bool next(int i, Unit& u) const {
        const long L = (long)i * G + c; if (L >= nwg) return false;
        int wgid = (int)L; { const int q = nwg / NXCD, r = nwg % NXCD, xcd = wgid % NXCD, off = wgid / NXCD; wgid = (xcd < r ? xcd * (q + 1) : r * (q + 1) + (xcd - r) * q) + off; }
        const int nig = WGM * nN, gid = wgid / nig, fm = gid * WGM, gsz = (nM - fm) < WGM ? (nM - fm) : WGM;
        u.pm = fm + ((wgid % nig) % gsz); u.pn = (wgid % nig) / gsz; return true;
    }
    __device__ __forceinline__ void a_ready(const Unit&) const {}
    __device__ __forceinline__ void done(const Unit&) const {}
};

__device__ __forceinline__ unsigned cvt_pk_bf16(float lo, float hi) { unsigned r; asm volatile("v_cvt_pk_bf16_f32 %0, %1, %2" : "=v"(r) : "v"(lo), "v"(hi)); return r; }
typedef float f32x2 __attribute__((ext_vector_type(2)));

template <class Epi, class Sched, bool ALIGN_EPI = false, bool SP2 = false>
__device__ __forceinline__ void gemm_phase(PG8_LAS unsigned char* lds, const Gemm g, const Sched& S, const Epi& E) {
    const int tid = threadIdx.x, wid = __builtin_amdgcn_readfirstlane(tid >> 6), lane = tid & 63, wr = wid >> 2, wc = wid & 3, fr = lane & 15, fq = lane >> 4;
    const int K = g.K, nt = K / BK;
    unsigned voffA[2], voffB[2];
#pragma unroll
    for (int i = 0; i < 2; ++i) { int R, C; stage_rc(tid * 16 + i * 8192, R, C); const int Rb = Epi::PERM ? ((R & ~31) + perm32(R & 31)) : R;
        voffA[i] = (unsigned)(R * K + C) * 2u; voffB[i] = (unsigned)(Rb * K + C) * 2u; }
    const size_t kstep = (size_t)(BK * 2);
    const size_t hstep = (size_t)HALF * K * 2;
    const size_t tstep = 2 * hstep;
    const unsigned ldsw = (unsigned)wid * 1024u;
    const int aoff = lds_byte(wr * 64 + fr, fq * 8), boff = lds_byte(wc * 32 + fr, fq * 8);
#define PG8_SA(b, h) (((b) * 2 + (h)) * HTB)
#define PG8_SB(b, h) ((4 + (b) * 2 + (h)) * HTB)
#define PG8_STAGE(bufoff, gbase, voff) do { _Pragma("unroll") for (int _i = 0; _i < 2; ++_i) \
        __builtin_amdgcn_global_load_lds((const unsigned*)((const char*)(gbase) + (voff)[_i]), (PG8_LAS unsigned*)(lds + (bufoff) + ldsw + _i * 8192), 16, 0, 0); } while (0)
#define PG8_LDA(dst, b, h) do { _Pragma("unroll") for (int m = 0; m < 4; ++m) _Pragma("unroll") for (int k = 0; k < 2; ++k) dst[m][k] = *(const PG8_LAS bf16x8*)(lds + PG8_SA(b, h) + aoff + m * 2048 + k * 1024); } while (0)
#define PG8_LDB(dst, b, h) do { _Pragma("unroll") for (int n = 0; n < 2; ++n) _Pragma("unroll") for (int k = 0; k < 2; ++k) dst[n][k] = *(const PG8_LAS bf16x8*)(lds + PG8_SB(b, h) + boff + n * 2048 + k * 1024); } while (0)
#define PG8_MMA(ai, bj, At, Bt) do { __builtin_amdgcn_s_setprio(1); _Pragma("unroll") for (int m = 0; m < 4; ++m) _Pragma("unroll") for (int n = 0; n < 2; ++n) _Pragma("unroll") for (int k = 0; k < 2; ++k) \
        acc[ai][bj][m][n] = __builtin_amdgcn_mfma_f32_16x16x32_bf16(Bt[n][k], At[m][k], acc[ai][bj][m][n], 0, 0, 0); __builtin_amdgcn_s_setprio(0); } while (0)
#define PG8_WAIT_V(n) asm volatile("s_waitcnt vmcnt(" #n ")" ::: "memory")
#define PG8_WAIT_L(n) asm volatile("s_waitcnt lgkmcnt(" #n ")" ::: "memory")
#define PG8_BAR __builtin_amdgcn_s_barrier()
#define PG8_SCHED __builtin_amdgcn_sched_barrier(0)
    Unit cur, nxt; int ui = 0;
    if (!S.next(0, cur)) return;
    f32x4 acc[2][2][4][2];
#pragma unroll
    for (int a = 0; a < 2; ++a)
#pragma unroll
        for (int b = 0; b < 2; ++b)
#pragma unroll
            for (int m = 0; m < 4; ++m)
#pragma unroll
                for (int n = 0; n < 2; ++n) acc[a][b][m][n] = (f32x4){0.f, 0.f, 0.f, 0.f};
    bf16x8 At[4][2], B0[2][2], B1[2][2];
    const char* cA = (const char*)g.A + (size_t)cur.pm * tstep; const char* cB = (const char*)g.Bt + (size_t)cur.pn * tstep;
    S.a_ready(cur);
    if constexpr (SP2) {
        PG8_STAGE(PG8_SB(0, 0), cB, voffB); PG8_STAGE(PG8_SB(0, 1), cB + hstep, voffB); PG8_STAGE(PG8_SA(0, 0), cA, voffA); PG8_STAGE(PG8_SA(0, 1), cA + hstep, voffA);
        if (wr == 1) PG8_BAR;
        PG8_WAIT_V(2); PG8_BAR;
        PG8_STAGE(PG8_SB(1, 0), cB + kstep, voffB); PG8_STAGE(PG8_SA(1, 0), cA + kstep, voffA); PG8_STAGE(PG8_SB(1, 1), cB + hstep + kstep, voffB);
        PG8_WAIT_V(6); PG8_BAR;
    } else {
        PG8_STAGE(PG8_SB(0, 0), cB, voffB); PG8_STAGE(PG8_SA(0, 0), cA, voffA); PG8_STAGE(PG8_SB(0, 1), cB + hstep, voffB); PG8_STAGE(PG8_SA(0, 1), cA + hstep, voffA);
        if (wr == 1) PG8_BAR;
        PG8_WAIT_V(4); PG8_BAR;
        PG8_STAGE(PG8_SB(1, 0), cB + kstep, voffB); PG8_STAGE(PG8_SA(1, 0), cA + kstep, voffA); PG8_STAGE(PG8_SB(1, 1), cB + hstep + kstep, voffB);
        PG8_WAIT_V(6); PG8_BAR;
    }
    for (;;) {
        const bool has_next = S.next(ui + 1, nxt);
        const char* nA = has_next ? (const char*)g.A + (size_t)nxt.pm * tstep : cA; const char* nB = has_next ? (const char*)g.Bt + (size_t)nxt.pn * tstep : cB;
        for (int t = 0; t < nt; t += 2) {
            const bool last = (t == nt - 2);
            const char* a1 = cA + (size_t)(t + 1) * kstep;
            const char* a2 = last ? nA : cA + (size_t)(t + 2) * kstep; const char* b2 = last ? nB : cB + (size_t)(t + 2) * kstep;
            const char* a3 = a2 + kstep; const char* b3 = b2 + kstep;
            if (last && has_next) S.a_ready(nxt);
            if constexpr (SP2) {
            PG8_LDB(B0, 0, 0); PG8_LDB(B1, 0, 1); PG8_SCHED; PG8_LDA(At, 0, 0); PG8_STAGE(PG8_SA(1, 1), a1 + hstep, voffA);
            PG8_WAIT_V(8); PG8_WAIT_L(0); PG8_BAR; PG8_MMA(0, 0, At, B0); PG8_MMA(0, 1, At, B1); PG8_BAR; PG8_SCHED;
            PG8_LDA(At, 0, 1); PG8_STAGE(PG8_SB(0, 0), b2, voffB); PG8_STAGE(PG8_SB(0, 1), b2 + hstep, voffB); PG8_STAGE(PG8_SA(0, 0), a2, voffA);
            PG8_WAIT_V(8); PG8_WAIT_L(0); PG8_BAR; PG8_MMA(1, 0, At, B0); PG8_MMA(1, 1, At, B1); PG8_BAR; PG8_SCHED;
            PG8_LDB(B0, 1, 0); PG8_LDB(B1, 1, 1); PG8_SCHED; PG8_LDA(At, 1, 0); PG8_STAGE(PG8_SA(0, 1), a2 + hstep, voffA);
            PG8_WAIT_V(8); PG8_WAIT_L(0); PG8_BAR; PG8_MMA(0, 0, At, B0); PG8_MMA(0, 1, At, B1); PG8_BAR; PG8_SCHED;
            PG8_LDA(At, 1, 1); PG8_STAGE(PG8_SB(1, 0), b3, voffB); PG8_STAGE(PG8_SB(1, 1), b3 + hstep, voffB); PG8_STAGE(PG8_SA(1, 0), a3, voffA);
            PG8_WAIT_V(8); PG8_WAIT_L(0); PG8_BAR; PG8_MMA(1, 0, At, B0); PG8_MMA(1, 1, At, B1); PG8_BAR; PG8_SCHED;
            } else {
            PG8_LDB(B0, 0, 0); PG8_SCHED; PG8_LDA(At, 0, 0); PG8_STAGE(PG8_SA(1, 1), a1 + hstep, voffA);
            PG8_WAIT_L(8); PG8_BAR; PG8_WAIT_L(0); PG8_MMA(0, 0, At, B0); PG8_BAR; PG8_SCHED;
            PG8_LDB(B1, 0, 1); PG8_STAGE(PG8_SB(0, 0), b2, voffB);
            PG8_BAR; PG8_WAIT_L(0); PG8_MMA(0, 1, At, B1); PG8_BAR;
            PG8_LDA(At, 0, 1); PG8_STAGE(PG8_SA(0, 0), a2, voffA);
            PG8_BAR; PG8_WAIT_L(0); PG8_MMA(1, 0, At, B0); PG8_BAR; PG8_SCHED;
            PG8_STAGE(PG8_SB(0, 1), b2 + hstep, voffB);
            PG8_WAIT_V(6); PG8_BAR; PG8_MMA(1, 1, At, B1); PG8_BAR;
            PG8_LDB(B0, 1, 0); PG8_SCHED; PG8_LDA(At, 1, 0); PG8_STAGE(PG8_SA(0, 1), a2 + hstep, voffA);
            PG8_WAIT_L(8); PG8_BAR; PG8_WAIT_L(0); PG8_MMA(0, 0, At, B0); PG8_BAR; PG8_SCHED;
            PG8_LDB(B1, 1, 1); PG8_STAGE(PG8_SB(1, 0), b3, voffB);
            PG8_BAR; PG8_WAIT_L(0); PG8_MMA(0, 1, At, B1); PG8_BAR;
            PG8_LDA(At, 1, 1); PG8_STAGE(PG8_SA(1, 0), a3, voffA);
            PG8_BAR; PG8_WAIT_L(0); PG8_MMA(1, 0, At, B0); PG8_BAR; PG8_SCHED;
            PG8_STAGE(PG8_SB(1, 1), b3 + hstep, voffB);
            PG8_WAIT_V(6); PG8_BAR; PG8_MMA(1, 1, At, B1); PG8_BAR;
            }
        }
        if constexpr (ALIGN_EPI) { if (wr == 0) PG8_BAR; }
        if constexpr (!Epi::AFTER_DRAIN) { E(acc, cur, wr, wc, fr, fq); S.done(cur); }
        if (!has_next) break;
#pragma unroll
        for (int a = 0; a < 2; ++a)
#pragma unroll
            for (int b = 0; b < 2; ++b)
#pragma unroll
                for (int m = 0; m < 4; ++m)
#pragma unroll
                    for (int n = 0; n < 2; ++n) acc[a][b][m][n] = (f32x4){0.f, 0.f, 0.f, 0.f};
        cur = nxt; cA = nA; cB = nB; ++ui;
        if constexpr (ALIGN_EPI) { if (wr == 1) PG8_BAR; }
    }
    PG8_WAIT_V(0);
    if constexpr (!ALIGN_EPI) { if (wr == 0) PG8_BAR; }
    PG8_BAR;
    if constexpr (Epi::AFTER_DRAIN) { E.fused(acc, cur, wr, wc, fr, fq, lds, wid, lane); S.done(cur); }
#undef PG8_SA
#undef PG8_SB
#undef PG8_STAGE
#undef PG8_LDA
#undef PG8_LDB
#undef PG8_MMA
#undef PG8_WAIT_V
#undef PG8_WAIT_L
#undef PG8_BAR
#undef PG8_SCHED
}
}


constexpr int DM = 2048, NB = 2, SEQL = 4096, CTXL = 256, DEPTH = 2;
constexpr int ML = NB * SEQL, MC = NB * CTXL, MT = ML + MC;
constexpr int NIN = 3840, NINR = 3600;
constexpr int FF = 5632, FF2 = 11264;
constexpr int GW = 512;
constexpr float ALPHA = 1.4142135623730951f;
constexpr float LN_EPS = 1e-5f, RMS_EPS = 1e-5f;
constexpr int ADA_KS = 16;
constexpr int PC_S5 = 0, PC_SGU = 512, PC_SGV = 1024, PC_POOL = 1536, PC_Z = 2048, PC_XBC = 2560, PC_DT = 3584;
constexpr int MX_S5 = 0, MX_SG = 512, MX_POOL = 1024, MX_SSD = 1536;

enum { I_X = 0, I_C, I_CTX, I_CCTX, I_WADA, I_BADA, I_WIN, I_WOUT, I_LN1G, I_LN1B, I_LN2G, I_LN2B,
       I_S5ARE, I_S5AIM, I_S5BRE, I_S5BIM, I_S5CRE, I_S5CIM, I_S5LS, I_S5D, I_GLUW, I_GLUB,
       I_SGLNG, I_SGLNB, I_SGW, I_SGB, I_POOLW, I_POOLB, I_POOLS,
       I_M2CW, I_M2CB, I_M2DTB, I_M2ALOG, I_M2D, I_M2NW,
       I_WUP, I_FCW, I_FCB, I_WDN, N_IN };

constexpr size_t MiB = 1u << 20;
constexpr size_t WS_CTL = 0;
constexpr size_t WS_MADA = 1 * MiB;
constexpr size_t WS_MPART = 2 * MiB;
constexpr size_t WS_WIN = 8 * MiB;
constexpr size_t WS_WOUT = 40 * MiB;
constexpr size_t WS_WUP = 56 * MiB;
constexpr size_t WS_WDN = 144 * MiB;
constexpr size_t WS_WGLU = 188 * MiB;
constexpr size_t WS_H = 190 * MiB;
constexpr size_t WS_HMOD = 258 * MiB;
constexpr size_t WS_P = 292 * MiB;
constexpr size_t WS_DT = 356 * MiB;
constexpr size_t WS_DTS = 357 * MiB;
constexpr size_t WS_MIX = 358 * MiB;
constexpr size_t WS_Z = 392 * MiB;
constexpr size_t WS_Y5 = 401 * MiB;
constexpr size_t WS_XC = 418 * MiB;
constexpr size_t WS_YD = 452 * MiB;
constexpr size_t WS_GV = 486 * MiB;
constexpr size_t WS_ACT = 673 * MiB;
constexpr size_t WS_END = 767 * MiB;

constexpr int NWAVES = 8, NTHREADS = 512;
constexpr int LDS_BYTES = 147456;

#define GAS __attribute__((address_space(1)))
#define LAS __attribute__((address_space(3)))
typedef unsigned short bf16;
typedef unsigned v4u __attribute__((ext_vector_type(4)));
typedef unsigned v2u __attribute__((ext_vector_type(2)));
typedef float f32x4 __attribute__((ext_vector_type(4)));

__device__ __forceinline__ unsigned f2bf(float f) { unsigned u = __builtin_bit_cast(unsigned, f); return (u + 0x7fffu + ((u >> 16) & 1u)) >> 16; }
__device__ __forceinline__ unsigned pk2(float lo, float hi) { return f2bf(lo) | (f2bf(hi) << 16); }
__device__ __forceinline__ float bf2f(unsigned short h) { return __builtin_bit_cast(float, (unsigned)h << 16); }
__device__ __forceinline__ float bflo(unsigned w) { return __builtin_bit_cast(float, w << 16); }
__device__ __forceinline__ float bfhi(unsigned w) { return __builtin_bit_cast(float, w & 0xffff0000u); }
__device__ __forceinline__ float sigmoidf_(float x) { return 1.f / (1.f + __expf(-x)); }
__device__ __forceinline__ float siluf_(float x) { return x * sigmoidf_(x); }
__device__ __forceinline__ float gelu_tanh(float x) {
    const float u = 0.7978845608028654f * (x + 0.044715f * x * x * x);
    const float t = 1.f - 2.f / (1.f + __expf(2.f * u));
    return 0.5f * x * (1.f + t);
}
__device__ __forceinline__ float softplusf_(float x) { return x > 20.f ? x : log1pf(expf(x)); }
__device__ __forceinline__ float wave_sum(float v) {
#pragma unroll
    for (int o = 1; o < 64; o <<= 1) v += __shfl_xor(v, o);
    return v;
}

namespace pg8 {
struct EpiIn {
    static constexpr bool PERM = true, AFTER_DRAIN = false;
    bf16_t* P; float* DT;
    __device__ __forceinline__ void operator()(const f32x4 (&acc)[2][2][4][2], const Unit& u, int wr, int wc, int fr, int fq) const {
        const int row0 = u.pm * BM + wr * 64 + fr;
        if (u.pn == 14) {
            if (wc == 0 && fq < 2) {
#pragma unroll
                for (int ai = 0; ai < 2; ++ai)
#pragma unroll
                    for (int m = 0; m < 4; ++m) { float* d = DT + (size_t)(row0 + ai * HALF + m * 16) * 16 + 8 * fq;
                        *(f32x4*)(d) = acc[ai][0][m][0]; *(f32x4*)(d + 4) = acc[ai][0][m][1]; }
            }
            return;
        }
        const int col0 = u.pn * BM + wc * 32 + 8 * fq;
#pragma unroll
        for (int ai = 0; ai < 2; ++ai)
#pragma unroll
            for (int m = 0; m < 4; ++m) { bf16_t* rowp = P + (size_t)(row0 + ai * HALF + m * 16) * NIN + col0;
#pragma unroll
                for (int bj = 0; bj < 2; ++bj) { const f32x4 v0 = acc[ai][bj][m][0], v1 = acc[ai][bj][m][1];
                    u32x4 w; w.x = cvt_pk_bf16(v0[0], v0[1]); w.y = cvt_pk_bf16(v0[2], v0[3]); w.z = cvt_pk_bf16(v1[0], v1[1]); w.w = cvt_pk_bf16(v1[2], v1[3]);
                    *(u32x4*)(rowp + bj * HALF) = w; } }
    }
};
struct EpiStore {
    static constexpr bool PERM = true, AFTER_DRAIN = false;
    bf16_t* O; int ldc;
    __device__ __forceinline__ void operator()(const f32x4 (&acc)[2][2][4][2], const Unit& u, int wr, int wc, int fr, int fq) const {
        const int row0 = u.pm * BM + wr * 64 + fr, col0 = u.pn * BM + wc * 32 + 8 * fq;
#pragma unroll
        for (int ai = 0; ai < 2; ++ai)
#pragma unroll
            for (int m = 0; m < 4; ++m) { bf16_t* rowp = O + (size_t)(row0 + ai * HALF + m * 16) * ldc + col0;
#pragma unroll
                for (int bj = 0; bj < 2; ++bj) { const f32x4 v0 = acc[ai][bj][m][0], v1 = acc[ai][bj][m][1];
                    u32x4 w; w.x = cvt_pk_bf16(v0[0], v0[1]); w.y = cvt_pk_bf16(v0[2], v0[3]); w.z = cvt_pk_bf16(v1[0], v1[1]); w.w = cvt_pk_bf16(v1[2], v1[3]);
                    *(u32x4*)(rowp + bj * HALF) = w; } }
    }
};
struct EpiGlu {
    static constexpr bool PERM = true, AFTER_DRAIN = false;
    const bf16_t* Z; bf16_t* O; const float* bias;
    __device__ __forceinline__ void operator()(const f32x4 (&acc)[2][2][4][2], const Unit& u, int wr, int wc, int fr, int fq) const {
        const int row0 = u.pm * BM + wr * 64 + fr, col0 = u.pn * BM + wc * 32 + 8 * fq;
#pragma unroll
        for (int ai = 0; ai < 2; ++ai)
#pragma unroll
            for (int m = 0; m < 4; ++m) { const int row = row0 + ai * HALF + m * 16;
#pragma unroll
                for (int bj = 0; bj < 2; ++bj) { const int col = col0 + bj * HALF;
                    const u32x4 zz = *(const u32x4*)(Z + (size_t)row * GW + col);
                    const f32x4 b0 = *(const f32x4*)(bias + col), b1 = *(const f32x4*)(bias + col + 4);
                    const f32x4 v0 = acc[ai][bj][m][0] + b0, v1 = acc[ai][bj][m][1] + b1;
                    float o[8];
                    o[0] = bflo(zz.x) * sigmoidf_(v0[0]); o[1] = bfhi(zz.x) * sigmoidf_(v0[1]); o[2] = bflo(zz.y) * sigmoidf_(v0[2]); o[3] = bfhi(zz.y) * sigmoidf_(v0[3]);
                    o[4] = bflo(zz.z) * sigmoidf_(v1[0]); o[5] = bfhi(zz.z) * sigmoidf_(v1[1]); o[6] = bflo(zz.w) * sigmoidf_(v1[2]); o[7] = bfhi(zz.w) * sigmoidf_(v1[3]);
                    u32x4 w; w.x = cvt_pk_bf16(o[0], o[1]); w.y = cvt_pk_bf16(o[2], o[3]); w.z = cvt_pk_bf16(o[4], o[5]); w.w = cvt_pk_bf16(o[6], o[7]);
                    *(u32x4*)(O + (size_t)row * DM + col) = w; } }
    }
};
struct EpiRes {
    static constexpr bool PERM = false, AFTER_DRAIN = false;
    float* H; const float* gate; int vstride;
    __device__ __forceinline__ void operator()(const f32x4 (&acc)[2][2][4][2], const Unit& u, int wr, int wc, int fr, int fq) const {
        const int row0 = u.pm * BM + wr * 64 + fr, col0 = u.pn * BM + wc * 32 + 4 * fq;
        const int var = u.pm < 16 ? 0 : (u.pm < 32 ? 1 : 2);
        const float* gv = gate + (size_t)var * vstride;
#pragma unroll
        for (int bj = 0; bj < 2; ++bj)
#pragma unroll
            for (int n = 0; n < 2; ++n) { const int col = col0 + bj * HALF + n * 16; const f32x4 g4 = *(const f32x4*)(gv + col);
#pragma unroll
                for (int ai = 0; ai < 2; ++ai)
#pragma unroll
                    for (int m = 0; m < 4; ++m) { float* p = H + (size_t)(row0 + ai * HALF + m * 16) * DM + col;
                        const f32x4 hv = *(const f32x4*)p; *(f32x4*)p = hv * ALPHA + g4 * acc[ai][bj][m][n]; } }
    }
};
}

struct Args { const float* in[N_IN]; float* out; unsigned char* ws; };

struct Frame {
    LAS unsigned char* lds;
    int tid, lane, wave, bid, G;
    const float* const* in;
    unsigned char* ws;
    float* out;
};
#define WSP(T, off) ((T*)(F.ws + (off)))

__device__ __forceinline__ void row_seq(int row, int& base, int& t, int& len) {
    if (row < ML) { base = row & ~(SEQL - 1); t = row & (SEQL - 1); len = SEQL; }
    else { base = ML + ((row - ML) & ~(CTXL - 1)); t = (row - ML) & (CTXL - 1); len = CTXL; }
}
__device__ __forceinline__ int proc_row(int q, int dir, int b) {
    if (q < CTXL) { const int t = dir ? (CTXL - 1 - q) : q; return ML + b * CTXL + t; }
    const int ql = q - CTXL; const int t = dir ? (SEQL - 1 - ql) : ql; return b * SEQL + t;
}

__device__ __forceinline__ void transpose_item(const float* W, int K, int N, bf16* WT, LAS float* scr, int item, int nblk, int lane) {
    const int kb = item / nblk, nb = item % nblk, k0 = 64 * kb, n0 = 32 * nb;
    const int nn = n0 + (lane & 31);
#pragma unroll 8
    for (int i = 0; i < 32; ++i) { const int kk = 2 * i + (lane >> 5); scr[kk * 33 + (lane & 31)] = (nn < N) ? W[(size_t)(k0 + kk) * N + nn] : 0.f; }
    asm volatile("s_waitcnt lgkmcnt(0)" ::: "memory");
    const int c = lane & 7;
#pragma unroll
    for (int j = 0; j < 4; ++j) { const int n = (lane >> 3) + 8 * j; const LAS float* s = scr + (8 * c) * 33 + n;
        v4u o; o.x = pk2(s[0 * 33], s[1 * 33]); o.y = pk2(s[2 * 33], s[3 * 33]); o.z = pk2(s[4 * 33], s[5 * 33]); o.w = pk2(s[6 * 33], s[7 * 33]);
        *(v4u*)(WT + (size_t)(n0 + n) * K + k0 + 8 * c) = o; }
    asm volatile("s_waitcnt lgkmcnt(0)" ::: "memory");
}

__device__ __forceinline__ void phase_pro_a(Frame& F) {
    LAS float* scr = (LAS float*)(F.lds + F.wave * 16384);
    const int gw = F.bid * NWAVES + F.wave, NGW = F.G * NWAVES;
    constexpr int I_IN = (DM / 64) * (NIN / 32), I_OUT = (DM / 64) * (DM / 32), I_UP = (DM / 64) * (FF2 / 32), I_DN = (FF / 64) * (DM / 32), I_GL = (GW / 64) * (GW / 32);
    constexpr int PER_L = I_IN + I_OUT + I_UP + I_DN + I_GL;
    for (int it = gw; it < DEPTH * PER_L; it += NGW) {
        const int l = it / PER_L; int r = it % PER_L;
        if (r < I_IN) { transpose_item(F.in[I_WIN] + (size_t)l * DM * NINR, DM, NINR, WSP(bf16, WS_WIN) + (size_t)l * NIN * DM, scr, r, NIN / 32, F.lane); continue; } r -= I_IN;
        if (r < I_OUT) { transpose_item(F.in[I_WOUT] + (size_t)l * DM * DM, DM, DM, WSP(bf16, WS_WOUT) + (size_t)l * DM * DM, scr, r, DM / 32, F.lane); continue; } r -= I_OUT;
        if (r < I_UP) { transpose_item(F.in[I_WUP] + (size_t)l * DM * FF2, DM, FF2, WSP(bf16, WS_WUP) + (size_t)l * FF2 * DM, scr, r, FF2 / 32, F.lane); continue; } r -= I_UP;
        if (r < I_DN) { transpose_item(F.in[I_WDN] + (size_t)l * FF * DM, FF, DM, WSP(bf16, WS_WDN) + (size_t)l * DM * FF, scr, r, DM / 32, F.lane); continue; } r -= I_DN;
        transpose_item(F.in[I_GLUW] + (size_t)l * GW * GW, GW, GW, WSP(bf16, WS_WGLU) + (size_t)l * GW * GW, scr, r, GW / 32, F.lane);
    }
    constexpr int NCB = 6 * DM / 256, KSL = DM / ADA_KS;
    const float* c = F.in[I_C]; const float* cc = F.in[I_CCTX];
    for (int job = gw; job < DEPTH * NCB * ADA_KS; job += NGW) {
        const int l = job / (NCB * ADA_KS), r = job % (NCB * ADA_KS), cb = r / ADA_KS, ks = r % ADA_KS;
        const float* W = F.in[I_WADA] + (size_t)l * DM * 6 * DM + cb * 256 + F.lane * 4;
        f32x4 a0 = {0.f, 0.f, 0.f, 0.f}, a1 = a0, a2 = a0;
#pragma unroll 4
        for (int k = ks * KSL; k < (ks + 1) * KSL; ++k) {
            const f32x4 w = *(const f32x4*)(W + (size_t)k * 6 * DM);
            const float s0 = siluf_(c[k]), s1 = siluf_(c[DM + k]), s2 = siluf_(cc[k]);
            a0 += w * s0; a1 += w * s1; a2 += w * s2;
        }
        float* mp = WSP(float, WS_MPART) + ((size_t)(l * ADA_KS + ks) * 3) * 6 * DM + cb * 256 + F.lane * 4;
        *(f32x4*)(mp) = a0; *(f32x4*)(mp + 6 * DM) = a1; *(f32x4*)(mp + 2 * 6 * DM) = a2;
    }
}

__device__ __forceinline__ void phase_pro_b(Frame& F) {
    const int gt = F.bid * NTHREADS + F.tid, NGT = F.G * NTHREADS;
    for (int i = gt; i < DEPTH * 3 * 6 * DM; i += NGT) {
        const int l = i / (3 * 6 * DM), r = i % (3 * 6 * DM), v = r / (6 * DM), n = r % (6 * DM);
        float s = F.in[I_BADA][l * 6 * DM + n];
        const float* mp = WSP(float, WS_MPART) + ((size_t)(l * ADA_KS) * 3 + v) * 6 * DM + n;
#pragma unroll
        for (int ks = 0; ks < ADA_KS; ++ks) s += mp[(size_t)ks * 3 * 6 * DM];
        WSP(float, WS_MADA)[i] = s;
    }
}
__device__ __forceinline__ const float* mvec(Frame& F, int l, int v, int j) { return WSP(float, WS_MADA) + ((size_t)(l * 3 + v) * 6 + j) * DM; }
__device__ __forceinline__ int row_var(int row) { return row < SEQL ? 0 : (row < ML ? 1 : 2); }

template <bool DO_LN>
__device__ __forceinline__ void row_pass(Frame& F, const float* srcrow, const float* g, const float* b, float* dstrow, bf16* modrow, const float* shift, const float* scale) {
    f32x4 v[8];
#pragma unroll
    for (int j = 0; j < 8; ++j) v[j] = *(const f32x4*)(srcrow + j * 256 + F.lane * 4);
    if (DO_LN) {
        float s = 0.f;
#pragma unroll
        for (int j = 0; j < 8; ++j) s += (v[j][0] + v[j][1]) + (v[j][2] + v[j][3]);
        const float mean = wave_sum(s) * (1.f / DM); float s2 = 0.f;
#pragma unroll
        for (int j = 0; j < 8; ++j) { v[j] = v[j] - mean; s2 += (v[j][0] * v[j][0] + v[j][1] * v[j][1]) + (v[j][2] * v[j][2] + v[j][3] * v[j][3]); }
        const float rstd = 1.f / sqrtf(wave_sum(s2) * (1.f / DM) + LN_EPS);
#pragma unroll
        for (int j = 0; j < 8; ++j) { const f32x4 gg = *(const f32x4*)(g + j * 256 + F.lane * 4), bb = *(const f32x4*)(b + j * 256 + F.lane * 4); v[j] = v[j] * rstd * gg + bb; }
    }
    if (dstrow) {
#pragma unroll
        for (int j = 0; j < 8; ++j) *(f32x4*)(dstrow + j * 256 + F.lane * 4) = v[j];
    }
    if (modrow) {
#pragma unroll
        for (int j = 0; j < 8; ++j) { const f32x4 sh = *(const f32x4*)(shift + j * 256 + F.lane * 4), sc = *(const f32x4*)(scale + j * 256 + F.lane * 4);
            const f32x4 o = v[j] * (sc + 1.f) + sh; v2u w; w.x = pk2(o[0], o[1]); w.y = pk2(o[2], o[3]);
            *(v2u*)(modrow + j * 256 + F.lane * 4) = w; }
    }
}
__device__ __forceinline__ void phase_pro_c(Frame& F) {
    const int gw = F.bid * NWAVES + F.wave, NGW = F.G * NWAVES;
    for (int row = gw; row < MT; row += NGW) {
        const float* src = row < ML ? F.in[I_X] + (size_t)row * DM : F.in[I_CTX] + (size_t)(row - ML) * DM;
        const int v = row_var(row);
        row_pass<false>(F, src, nullptr, nullptr, WSP(float, WS_H) + (size_t)row * DM, WSP(bf16, WS_HMOD) + (size_t)row * DM, mvec(F, 0, v, 0), mvec(F, 0, v, 1));
    }
}
__device__ __forceinline__ void phase_ln(Frame& F, const float* g, const float* b, int ml, int js, bool final_out) {
    const int gw = F.bid * NWAVES + F.wave, NGW = F.G * NWAVES;
    const int nrows = final_out ? ML : MT;
    for (int row = gw; row < nrows; row += NGW) {
        const int v = row_var(row);
        float* hrow = WSP(float, WS_H) + (size_t)row * DM;
        if (final_out) row_pass<true>(F, hrow, g, b, F.out + (size_t)row * DM, nullptr, nullptr, nullptr);
        else row_pass<true>(F, hrow, g, b, hrow, WSP(bf16, WS_HMOD) + (size_t)row * DM, mvec(F, ml, v, js), mvec(F, ml, v, js + 1));
    }
}

__device__ __forceinline__ void s5_oracle_job(Frame& F, int l, int b, int g) {
    LAS float* hb = (LAS float*)(F.lds);
    LAS float* cs = (LAS float*)(F.lds + 8192);
    const int p = F.lane;
    const bf16* P = WSP(bf16, WS_P);
    float* Y5 = WSP(float, WS_Y5); bf16* Z = WSP(bf16, WS_Z);
    for (int dir = 0; dir < 2; ++dir) {
        const int gi = (l * 2 + dir) * 32 + g;
        const float ar = F.in[I_S5ARE][gi * 64 + p], ai = F.in[I_S5AIM][gi * 64 + p];
        const float step = expf(F.in[I_S5LS][gi]);
        const float e = expf(ar * step); float sn, cn; sincosf(ai * step, &sn, &cn);
        const float abr = e * cn, abi = e * sn;
        const float den = ar * ar + ai * ai;
        const float qr = ((abr - 1.f) * ar + abi * ai) / den, qi = (abi * ar - (abr - 1.f) * ai) / den;
        float bbr[16], bbi[16];
#pragma unroll
        for (int h = 0; h < 16; ++h) { const float br = F.in[I_S5BRE][(size_t)(gi * 64 + p) * 16 + h], bi = F.in[I_S5BIM][(size_t)(gi * 64 + p) * 16 + h];
            bbr[h] = qr * br - qi * bi; bbi[h] = qr * bi + qi * br; }
        asm volatile("s_waitcnt lgkmcnt(0)" ::: "memory");
#pragma unroll
        for (int ho = 0; ho < 16; ++ho) { cs[(ho * 64 + p) * 2] = F.in[I_S5CRE][(size_t)(gi * 16 + ho) * 64 + p]; cs[(ho * 64 + p) * 2 + 1] = F.in[I_S5CIM][(size_t)(gi * 16 + ho) * 64 + p]; }
        float hr = 0.f, hi = 0.f;
        for (int blk = 0; blk < (CTXL + SEQL) / 16; ++blk) {
            for (int i = 0; i < 16; ++i) {
                const int row = proc_row(blk * 16 + i, dir, b);
                const v4u u0 = *(const v4u*)(P + (size_t)row * NIN + PC_S5 + g * 16), u1 = *(const v4u*)(P + (size_t)row * NIN + PC_S5 + g * 16 + 8);
                float u[16];
                u[0] = bflo(u0.x); u[1] = bfhi(u0.x); u[2] = bflo(u0.y); u[3] = bfhi(u0.y); u[4] = bflo(u0.z); u[5] = bfhi(u0.z); u[6] = bflo(u0.w); u[7] = bfhi(u0.w);
                u[8] = bflo(u1.x); u[9] = bfhi(u1.x); u[10] = bflo(u1.y); u[11] = bfhi(u1.y); u[12] = bflo(u1.z); u[13] = bfhi(u1.z); u[14] = bflo(u1.w); u[15] = bfhi(u1.w);
                float bur = 0.f, bui = 0.f;
#pragma unroll
                for (int h = 0; h < 16; ++h) { bur += bbr[h] * u[h]; bui += bbi[h] * u[h]; }
                const float nr = abr * hr - abi * hi + bur, ni = abr * hi + abi * hr + bui;
                hr = nr; hi = ni;
                hb[(i * 64 + p) * 2] = hr; hb[(i * 64 + p) * 2 + 1] = hi;
            }
            asm volatile("s_waitcnt lgkmcnt(0)" ::: "memory");
            {
                const int i = F.lane >> 2, ho4 = (F.lane & 3) * 4;
                float y[4] = {0.f, 0.f, 0.f, 0.f};
                for (int pp = 0; pp < 64; ++pp) { const float xr = hb[(i * 64 + pp) * 2], xi = hb[(i * 64 + pp) * 2 + 1];
#pragma unroll
                    for (int j = 0; j < 4; ++j) y[j] += xr * cs[((ho4 + j) * 64 + pp) * 2] - xi * cs[((ho4 + j) * 64 + pp) * 2 + 1]; }
                const int row = proc_row(blk * 16 + i, dir, b);
                float* yp = Y5 + (size_t)row * GW + g * 16 + ho4;
                if (dir == 0) { *(f32x4*)yp = (f32x4){y[0], y[1], y[2], y[3]}; }
                else {
                    const f32x4 yf = *(const f32x4*)yp;
                    const v2u uu = *(const v2u*)(P + (size_t)row * NIN + PC_S5 + g * 16 + ho4);
                    const float* dd = F.in[I_S5D] + l * GW + g * 16 + ho4;
                    const float z0 = gelu_tanh(yf[0] + y[0] + dd[0] * bflo(uu.x)), z1 = gelu_tanh(yf[1] + y[1] + dd[1] * bfhi(uu.x));
                    const float z2 = gelu_tanh(yf[2] + y[2] + dd[2] * bflo(uu.y)), z3 = gelu_tanh(yf[3] + y[3] + dd[3] * bfhi(uu.y));
                    v2u w; w.x = pk2(z0, z1); w.y = pk2(z2, z3);
                    *(v2u*)(Z + (size_t)row * GW + g * 16 + ho4) = w;
                }
            }
            asm volatile("s_waitcnt vmcnt(0) lgkmcnt(0)" ::: "memory");
        }
        asm volatile("s_waitcnt vmcnt(0) lgkmcnt(0)" ::: "memory");
    }
}
__device__ __forceinline__ void ssd_prep_oracle(Frame& F, int l) {
    const int gt = F.bid * NTHREADS + F.tid, NGT = F.G * NTHREADS;
    const bf16* P = WSP(bf16, WS_P); float* XC = WSP(float, WS_XC);
    const float* cw = F.in[I_M2CW] + (size_t)l * 4 * 1024; const float* cb = F.in[I_M2CB] + l * 1024;
    for (int i = gt; i < MT * 1024; i += NGT) {
        const int row = i >> 10, ch = i & 1023; int base, t, len; row_seq(row, base, t, len);
        float a = cb[ch];
#pragma unroll
        for (int k = 0; k < 4; ++k) { const int tt = t - 2 + k; if (tt >= 0 && tt < len) a += cw[k * 1024 + ch] * bf2f(P[(size_t)(base + tt) * NIN + PC_XBC + ch]); }
        XC[i] = siluf_(a);
    }
    const float* dtr = WSP(float, WS_DT); float* dts = WSP(float, WS_DTS);
    for (int i = gt; i < MT * 16; i += NGT) dts[i] = softplusf_(dtr[i] + F.in[I_M2DTB][l * 16 + (i & 15)]);
}
__device__ __forceinline__ void ssd_scan_oracle_job(Frame& F, int l, int b, int hd, int dir) {
    LAS float* xs = (LAS float*)(F.lds);
    LAS float* Bs = (LAS float*)(F.lds + 8192);
    LAS float* Cs = (LAS float*)(F.lds + 8192 + 16384);
    LAS float* ds = (LAS float*)(F.lds + 8192 + 32768);
    LAS float* yb = (LAS float*)(F.lds + 8192 + 32768 + 256);
    LAS int* rws = (LAS int*)(F.lds + 8192 + 32768 + 256 + 8192);
    const float* XC = WSP(float, WS_XC); const float* dts = WSP(float, WS_DTS); float* YD = WSP(float, WS_YD) + (size_t)dir * MT * GW;
    const int p = F.tid >> 3, nq = F.tid & 7, n0 = nq * 16, grp = hd >> 2;
    const float a = -expf(F.in[I_M2ALOG][l * 16 + dir * 8 + hd]);
    float hs[16];
#pragma unroll
    for (int k = 0; k < 16; ++k) hs[k] = 0.f;
    for (int q0 = 0; q0 < CTXL + SEQL; q0 += 32) {
        __syncthreads();
        for (int idx = F.tid; idx < 32 * 64; idx += NTHREADS) { const int i = idx >> 6, c = idx & 63; const int row = proc_row(q0 + i, dir, b); xs[idx] = XC[(size_t)row * 1024 + hd * 64 + c]; }
        for (int idx = F.tid; idx < 32 * 128; idx += NTHREADS) { const int i = idx >> 7, n = idx & 127; const int row = proc_row(q0 + i, dir, b);
            Bs[idx] = XC[(size_t)row * 1024 + 512 + grp * 128 + n]; Cs[idx] = XC[(size_t)row * 1024 + 768 + grp * 128 + n]; }
        if (F.tid < 32) { const int row = proc_row(q0 + F.tid, dir, b); ds[F.tid] = dts[(size_t)row * 16 + dir * 8 + hd]; rws[F.tid] = row; }
        __syncthreads();
        for (int i = 0; i < 32; ++i) {
            const float dt = ds[i], da = expf(dt * a), xd = xs[i * 64 + p] * dt;
            float part = 0.f;
#pragma unroll
            for (int k = 0; k < 16; ++k) { hs[k] = da * hs[k] + xd * Bs[i * 128 + n0 + k]; part += Cs[i * 128 + n0 + k] * hs[k]; }
            part += __shfl_xor(part, 1); part += __shfl_xor(part, 2); part += __shfl_xor(part, 4);
            if (nq == 0) yb[i * 64 + p] = part;
        }
        __syncthreads();
        for (int idx = F.tid; idx < 32 * 64; idx += NTHREADS) { const int i = idx >> 6, c = idx & 63; YD[(size_t)rws[i] * GW + hd * 64 + c] = yb[idx]; }
    }
    __syncthreads();
}
__device__ __forceinline__ void ssd_finish_oracle(Frame& F, int l) {
    const int gw = F.bid * NWAVES + F.wave, NGW = F.G * NWAVES;
    const float* XC = WSP(float, WS_XC); const float* YD = WSP(float, WS_YD); const bf16* P = WSP(bf16, WS_P); bf16* MIX = WSP(bf16, WS_MIX);
    for (int row = gw; row < MT; row += NGW) {
#pragma unroll
        for (int j = 0; j < 2; ++j) {
            const int ch = j * 256 + F.lane * 4;
            const f32x4 y0 = *(const f32x4*)(YD + (size_t)row * GW + ch), y1 = *(const f32x4*)(YD + (size_t)(MT + row) * GW + ch), xv = *(const f32x4*)(XC + (size_t)row * 1024 + ch);
            const float dh = F.in[I_M2D][l * 8 + (ch >> 6)];
            const v2u zz = *(const v2u*)(P + (size_t)row * NIN + PC_Z + ch);
            f32x4 gq; float zf[4] = {bflo(zz.x), bfhi(zz.x), bflo(zz.y), bfhi(zz.y)};
#pragma unroll
            for (int k = 0; k < 4; ++k) gq[k] = (y0[k] + y1[k] + dh * xv[k]) * siluf_(zf[k]);
            const float ss = wave_sum((gq[0] * gq[0] + gq[1] * gq[1]) + (gq[2] * gq[2] + gq[3] * gq[3]));
            const float rs = 1.f / sqrtf(ss * (1.f / 256.f) + RMS_EPS);
            const f32x4 nw = *(const f32x4*)(F.in[I_M2NW] + l * GW + ch);
            v2u w; w.x = pk2(gq[0] * rs * nw[0], gq[1] * rs * nw[1]); w.y = pk2(gq[2] * rs * nw[2], gq[3] * rs * nw[3]);
            *(v2u*)(MIX + (size_t)row * DM + MX_SSD + ch) = w;
        }
    }
}
__device__ __forceinline__ void sg_oracle_job(Frame& F, int l, int cj, int hh) {
    LAS float* v = (LAS float*)(F.lds);
    const bf16* P = WSP(bf16, WS_P); bf16* MIX = WSP(bf16, WS_MIX);
    const int r0 = cj * 128;
    __syncthreads();
    for (int j = F.wave; j < 128; j += NWAVES) {
        const unsigned w = *(const unsigned*)(P + (size_t)(r0 + j) * NIN + PC_SGV + hh * 128 + F.lane * 2);
        const float a0 = gelu_tanh(bflo(w)), a1 = gelu_tanh(bfhi(w));
        const float mean = wave_sum(a0 + a1) * (1.f / 128.f);
        const float d0 = a0 - mean, d1 = a1 - mean;
        const float rstd = 1.f / sqrtf(wave_sum(d0 * d0 + d1 * d1) * (1.f / 128.f) + LN_EPS);
        const int d = F.lane * 2;
        v[j * 128 + d] = d0 * rstd * F.in[I_SGLNG][l * GW + hh * 128 + d] + F.in[I_SGLNB][l * GW + hh * 128 + d];
        v[j * 128 + d + 1] = d1 * rstd * F.in[I_SGLNG][l * GW + hh * 128 + d + 1] + F.in[I_SGLNB][l * GW + hh * 128 + d + 1];
    }
    __syncthreads();
    const int d = F.tid & 127, ig = F.tid >> 7;
    const float* ws = F.in[I_SGW] + (size_t)(l * 4 + hh) * 128 * 128;
    for (int ii = 0; ii < 32; ++ii) {
        const int i = ig * 32 + ii;
        float s = F.in[I_SGB][(l * 4 + hh) * 128 + i];
        for (int j = 0; j < 128; ++j) s += ws[i * 128 + j] * v[j * 128 + d];
        const float uu = gelu_tanh(bf2f(P[(size_t)(r0 + i) * NIN + PC_SGU + hh * 128 + d]));
        MIX[(size_t)(r0 + i) * DM + MX_SG + hh * 128 + d] = (bf16)f2bf(uu * s);
    }
    __syncthreads();
}
__device__ __forceinline__ void pool_oracle_job(Frame& F, int l, int tile, int gp) {
    LAS float* m = (LAS float*)(F.lds);
    const bf16* P = WSP(bf16, WS_P); bf16* MIX = WSP(bf16, WS_MIX);
    const int r0 = tile * 32, win = 2 << gp;
    __syncthreads();
    for (int idx = F.tid; idx < 32 * 128; idx += NTHREADS) {
        const int i = idx >> 7, c = idx & 127; int base, t, len; row_seq(r0 + i, base, t, len);
        int lo = t - win / 2; if (lo < 0) lo = 0; int hi = t + win / 2 - 1; if (hi > len - 1) hi = len - 1;
        float s = 0.f;
        for (int k = lo; k <= hi; ++k) s += bf2f(P[(size_t)(base + k) * NIN + PC_POOL + gp * 128 + c]);
        m[idx] = s / (float)(hi - lo + 1) - bf2f(P[(size_t)(r0 + i) * NIN + PC_POOL + gp * 128 + c]);
    }
    __syncthreads();
    const int d = F.tid & 127, ig = F.tid >> 7;
    const float* w = F.in[I_POOLW] + (size_t)(l * 4 + gp) * 128 * 128;
    for (int ii = 0; ii < 8; ++ii) {
        const int i = ig * 8 + ii; float s = 0.f;
        for (int c = 0; c < 128; ++c) s += m[i * 128 + c] * w[c * 128 + d];
        s = (s + F.in[I_POOLB][l * GW + gp * 128 + d]) * F.in[I_POOLS][l * GW + gp * 128 + d];
        MIX[(size_t)(r0 + i) * DM + MX_POOL + gp * 128 + d] = (bf16)f2bf(s);
    }
    __syncthreads();
}
__device__ __forceinline__ void ffn_act_oracle(Frame& F, int l) {
    const int gt = F.bid * NTHREADS + F.tid, NGT = F.G * NTHREADS;
    const bf16* GV = WSP(bf16, WS_GV); bf16* ACT = WSP(bf16, WS_ACT);
    const float* cw = F.in[I_FCW] + (size_t)l * 9 * FF; const float* cb = F.in[I_FCB] + l * FF;
    constexpr int FV = FF / 8;
    for (int i = gt; i < MT * FV; i += NGT) {
        const int row = i / FV, f0 = (i % FV) * 8;
        float a[8];
#pragma unroll
        for (int k = 0; k < 8; ++k) a[k] = cb[f0 + k];
        if (row < ML) {
            const int b = row >> 12, t = row & 4095, r = t >> 6, c = t & 63;
            for (int dr = -1; dr <= 1; ++dr) for (int dc = -1; dc <= 1; ++dc) {
                const int rr = r + dr, c2 = c + dc; if (rr < 0 || rr > 63 || c2 < 0 || c2 > 63) continue;
                const v4u g = *(const v4u*)(GV + (size_t)(b * SEQL + rr * 64 + c2) * FF2 + f0);
                const float* w = cw + ((dr + 1) * 3 + (dc + 1)) * FF + f0;
                a[0] += w[0] * bflo(g.x); a[1] += w[1] * bfhi(g.x); a[2] += w[2] * bflo(g.y); a[3] += w[3] * bfhi(g.y);
                a[4] += w[4] * bflo(g.z); a[5] += w[5] * bfhi(g.z); a[6] += w[6] * bflo(g.w); a[7] += w[7] * bfhi(g.w);
            }
        } else {
            int base, t, len; row_seq(row, base, t, len);
            for (int k = 0; k < 3; ++k) { const int tt = t + k - 1; if (tt < 0 || tt >= len) continue;
                const v4u g = *(const v4u*)(GV + (size_t)(base + tt) * FF2 + f0);
                const float* w = cw + (3 + k) * FF + f0;
                a[0] += w[0] * bflo(g.x); a[1] += w[1] * bfhi(g.x); a[2] += w[2] * bflo(g.y); a[3] += w[3] * bfhi(g.y);
                a[4] += w[4] * bflo(g.z); a[5] += w[5] * bfhi(g.z); a[6] += w[6] * bflo(g.w); a[7] += w[7] * bfhi(g.w);
            }
        }
        const v4u vv = *(const v4u*)(GV + (size_t)row * FF2 + FF + f0);
        v4u o;
        o.x = pk2(gelu_tanh(a[0]) * bflo(vv.x), gelu_tanh(a[1]) * bfhi(vv.x)); o.y = pk2(gelu_tanh(a[2]) * bflo(vv.y), gelu_tanh(a[3]) * bfhi(vv.y));
        o.z = pk2(gelu_tanh(a[4]) * bflo(vv.z), gelu_tanh(a[5]) * bfhi(vv.z)); o.w = pk2(gelu_tanh(a[6]) * bflo(vv.w), gelu_tanh(a[7]) * bfhi(vv.w));
        *(v4u*)(ACT + (size_t)row * FF + f0) = o;
    }
}

constexpr int PH_PRO_A = 0, PH_PRO_B = 1, PH_PRO_C = 2, PH_L0 = 3, NPH_L = 10, N_PHASES = PH_L0 + DEPTH * NPH_L;


template <int PH>
__device__ __forceinline__ void run_phase(const Args& args, LAS unsigned char* ldsp) {
    Frame F;
    F.lds = ldsp;
    F.tid = threadIdx.x; F.lane = F.tid & 63; F.wave = __builtin_amdgcn_readfirstlane(F.tid >> 6);
    F.bid = blockIdx.x; F.G = gridDim.x;
    F.in = args.in; F.ws = args.ws; F.out = args.out;
    if constexpr (PH == PH_PRO_A) phase_pro_a(F);
    else if constexpr (PH == PH_PRO_B) phase_pro_b(F);
    else if constexpr (PH == PH_PRO_C) phase_pro_c(F);
    else {
        constexpr int l = (PH - PH_L0) / NPH_L, sp = (PH - PH_L0) % NPH_L;
        if constexpr (sp == 0) {
            pg8::Gemm g{WSP(bf16, WS_HMOD), WSP(bf16, WS_WIN) + (size_t)l * NIN * DM, MT, NIN, DM}; pg8::StaticOrder S; S.init(MT, NIN, F.G, F.bid);
            pg8::EpiIn E{WSP(bf16, WS_P), WSP(float, WS_DT)};
            pg8::gemm_phase<pg8::EpiIn, pg8::StaticOrder, true, true>(F.lds, g, S, E);
        } else if constexpr (sp == 1) {
            if (F.bid < 64) { if (F.wave == 0) s5_oracle_job(F, l, F.bid >> 5, F.bid & 31); }
            else {
                F.bid -= 64; F.G -= 64;
                ssd_prep_oracle(F, l);
                for (int j = F.bid; j < 68 * 4; j += F.G) sg_oracle_job(F, l, j >> 2, j & 3);
                for (int j = F.bid; j < 272 * 4; j += F.G) pool_oracle_job(F, l, j >> 2, j & 3);
            }
        } else if constexpr (sp == 2) {
            if (F.bid < 32) ssd_scan_oracle_job(F, l, F.bid >> 4, (F.bid >> 1) & 7, F.bid & 1);
        } else if constexpr (sp == 3) {
            ssd_finish_oracle(F, l);
            pg8::Gemm g{WSP(bf16, WS_Z), WSP(bf16, WS_WGLU) + (size_t)l * GW * GW, MT, GW, GW}; pg8::StaticOrder S; S.init(MT, GW, F.G, F.bid);
            pg8::EpiGlu E{WSP(bf16, WS_Z), WSP(bf16, WS_MIX), F.in[I_GLUB] + l * GW};
            pg8::gemm_phase<pg8::EpiGlu, pg8::StaticOrder, true, true>(F.lds, g, S, E);
        } else if constexpr (sp == 4) {
            pg8::Gemm g{WSP(bf16, WS_MIX), WSP(bf16, WS_WOUT) + (size_t)l * DM * DM, MT, DM, DM}; pg8::StaticOrder S; S.init(MT, DM, F.G, F.bid);
            pg8::EpiRes E{WSP(float, WS_H), mvec(F, l, 0, 2), 6 * DM};
            pg8::gemm_phase<pg8::EpiRes, pg8::StaticOrder, true, true>(F.lds, g, S, E);
        } else if constexpr (sp == 5) {
            phase_ln(F, F.in[I_LN1G] + l * DM, F.in[I_LN1B] + l * DM, l, 3, false);
        } else if constexpr (sp == 6) {
            pg8::Gemm g{WSP(bf16, WS_HMOD), WSP(bf16, WS_WUP) + (size_t)l * FF2 * DM, MT, FF2, DM}; pg8::StaticOrder S; S.init(MT, FF2, F.G, F.bid);
            pg8::EpiStore E{WSP(bf16, WS_GV), FF2};
            pg8::gemm_phase<pg8::EpiStore, pg8::StaticOrder, true, true>(F.lds, g, S, E);
        } else if constexpr (sp == 7) {
            ffn_act_oracle(F, l);
        } else if constexpr (sp == 8) {
            pg8::Gemm g{WSP(bf16, WS_ACT), WSP(bf16, WS_WDN) + (size_t)l * DM * FF, MT, DM, FF}; pg8::StaticOrder S; S.init(MT, DM, F.G, F.bid);
            pg8::EpiRes E{WSP(float, WS_H), mvec(F, l, 0, 5), 6 * DM};
            pg8::gemm_phase<pg8::EpiRes, pg8::StaticOrder, true, true>(F.lds, g, S, E);
        } else {
            constexpr bool fin = (l == DEPTH - 1);
            phase_ln(F, F.in[I_LN2G] + l * DM, F.in[I_LN2B] + l * DM, fin ? l : l + 1, 0, fin);
        }
    }
}
template <int PH, int HI>
__device__ __forceinline__ void run_range(const Args& args, LAS unsigned char* ldsp) {
    run_phase<PH>(args, ldsp);
    if constexpr (PH + 1 < HI) { cg::this_grid().sync(); run_range<PH + 1, HI>(args, ldsp); }
}
template <int LO, int HI>
__global__ void __launch_bounds__(NTHREADS, 2) mk_fwd(Args args) {
    extern __shared__ __attribute__((aligned(16))) unsigned char lds[];
    run_range<LO, HI>(args, (LAS unsigned char*)lds);
}

#ifndef MK_ONE_LAUNCH
#define MK_ONE_LAUNCH 0
#endif
template <int PH> static void launch_phases(const Args& a, int grid, hipStream_t stream) {
    hipFuncSetAttribute((const void*)mk_fwd<PH, PH + 1>, hipFuncAttributeMaxDynamicSharedMemorySize, LDS_BYTES);
    hipLaunchKernelGGL((mk_fwd<PH, PH + 1>), dim3(grid), dim3(NTHREADS), LDS_BYTES, stream, a);
    if constexpr (PH + 1 < N_PHASES) launch_phases<PH + 1>(a, grid, stream);
}

extern "C" void kernel_launch(void* const* d_in, const int* in_sizes, int n_in, void* d_out, int out_size, void* d_ws, size_t ws_size, hipStream_t stream) {
    static int grid = 0;
    if (grid == 0) {
        if (n_in != N_IN || out_size != ML * DM || ws_size < WS_END) { fprintf(stderr, "kernel_launch: unexpected shapes n_in %d out %d ws %zu (need %zu)\n", n_in, out_size, ws_size, (size_t)WS_END); grid = -1; return; }
        int dev = 0, cus = 0;
        (void)hipGetDevice(&dev); (void)hipDeviceGetAttribute(&cus, hipDeviceAttributeMultiprocessorCount, dev);
#if MK_ONE_LAUNCH
        int per_cu = 0;
        if (hipFuncSetAttribute((const void*)mk_fwd<0, N_PHASES>, hipFuncAttributeMaxDynamicSharedMemorySize, LDS_BYTES) != hipSuccess) { fprintf(stderr, "hipFuncSetAttribute failed\n"); grid = -1; return; }
        (void)hipOccupancyMaxActiveBlocksPerMultiprocessor(&per_cu, (const void*)mk_fwd<0, N_PHASES>, NTHREADS, LDS_BYTES);
        (void)hipGetLastError();
        fprintf(stderr, "kernel_launch: cus %d per_cu %d\n", cus, per_cu);
        if (per_cu < 1) { grid = -1; return; }
#endif
        grid = cus;
    }
    if (grid < 0) return;
    Args a{};
    for (int i = 0; i < N_IN; ++i) a.in[i] = (const float*)d_in[i];
    a.out = (float*)d_out; a.ws = (unsigned char*)d_ws;
#if MK_ONE_LAUNCH
    void* kargs[] = {&a};
    hipError_t e = hipLaunchCooperativeKernel((const void*)mk_fwd<0, N_PHASES>, dim3(grid), dim3(NTHREADS), kargs, LDS_BYTES, stream);
    if (e != hipSuccess) fprintf(stderr, "cooperative launch failed: %s\n", hipGetErrorString(e));
#else
    launch_phases<0>(a, grid, stream);
#endif
}
```

```cpp
#include <hip/hip_runtime.h>
#include <hip/hip_cooperative_groups.h>
#include <cstdio>
#include <cstdint>
namespace cg = cooperative_groups;
namespace pg8 {
#define PG8_LAS __attribute__((address_space(3)))
typedef unsigned short bf16_t;
typedef short bf16x8 __attribute__((ext_vector_type(8)));
typedef float f32x4 __attribute__((ext_vector_type(4)));
typedef unsigned u32x4 __attribute__((ext_vector_type(4)));
constexpr int BM = 256, BK = 64, HALF = 128, HTB = HALF * BK * 2  , STAGE_BYTES = 8 * HTB, NXCD = 8, WGM = 8;

__host__ __device__ __forceinline__ int lds_byte(int r, int c) { const int st = (r >> 4) * 2 + (c >> 5), rr = r & 15, cc = c & 31, ob = rr * 64 + cc * 2; return st * 1024 + (ob ^ (((ob >> 9) & 1) << 5)); }
__host__ __device__ __forceinline__ void stage_rc(int b, int& R, int& C) { const int st = b / 1024, sb = b % 1024, swz = sb ^ (((sb >> 9) & 1) << 5); R = (st >> 1) * 16 + swz / 64; C = (st & 1) * 32 + (swz % 64) / 2; }
__host__ __device__ __forceinline__ int perm32(int rho) { const int n = rho >> 4, i = rho & 15; return 8 * (i >> 2) + 4 * n + (i & 3); }

struct Unit { int pm, pn; };
struct Gemm { const bf16_t* A; const bf16_t* Bt; int M, N, K; };

struct StaticOrder {
    int nM, nN, nwg, G, c;
    __host__ __device__ void init(int M, int N, int G_, int c_) { nM = M / BM; nN = N / BM; nwg = nM * nN; G = G_; c = c_; }
    __host__ __device__ bool next(int i, Unit& u) const {
        const long L = (long)i * G + c; if (L >= nwg) return false;
        int wgid = (int)L; { const int q = nwg / NXCD, r = nwg % NXCD, xcd = wgid % NXCD, off = wgid / NXCD; wgid = (xcd < r ? xcd * (q + 1) : r * (q + 1) + (xcd - r) * q) + off; }
        const int nig = WGM * nN, gid = wgid / nig, fm = gid * WGM, gsz = (nM - fm) < WGM ? (nM - fm) : WGM;
        u.pm = fm + ((wgid % nig) % gsz); u.pn = (wgid % nig) / gsz; return true;
    }
    __device__ __forceinline__ void a_ready(const Unit&) const {}
    __device__ __forceinline__ void done(const Unit&) const {}
};

__device__ __forceinline__ unsigned cvt_pk_bf16(float lo, float hi) { unsigned r; asm volatile("v_cvt_pk_bf16_f32 %0, %1, %2" : "=v"(r) : "v"(lo), "v"(hi)); return r; }
typedef float f32x2 __attribute__((ext_vector_type(2)));

template <class Epi, class Sched, bool ALIGN_EPI = false, bool SP2 = false>
__device__ __forceinline__ void gemm_phase(PG8_LAS unsigned char* lds, const Gemm g, const Sched& S, const Epi& E) {
    const int tid = threadIdx.x, wid = __builtin_amdgcn_readfirstlane(tid >> 6), lane = tid & 63, wr = wid >> 2, wc = wid & 3, fr = lane & 15, fq = lane >> 4;
    const int K = g.K, nt = K / BK;
    unsigned voffA[2], voffB[2];
#pragma unroll
    for (int i = 0; i < 2; ++i) { int R, C; stage_rc(tid * 16 + i * 8192, R, C); const int Rb = Epi::PERM ? ((R & ~31) + perm32(R & 31)) : R;
        voffA[i] = (unsigned)(R * K + C) * 2u; voffB[i] = (unsigned)(Rb * K + C) * 2u; }
    const size_t kstep = (size_t)(BK * 2);
    const size_t hstep = (size_t)HALF * K * 2;
    const size_t tstep = 2 * hstep;
    const unsigned ldsw = (unsigned)wid * 1024u;
    const int aoff = lds_byte(wr * 64 + fr, fq * 8), boff = lds_byte(wc * 32 + fr, fq * 8);
#define PG8_SA(b, h) (((b) * 2 + (h)) * HTB)
#define PG8_SB(b, h) ((4 + (b) * 2 + (h)) * HTB)
#define PG8_STAGE(bufoff, gbase, voff) do { _Pragma("unroll") for (int _i = 0; _i < 2; ++_i) \
        __builtin_amdgcn_global_load_lds((const unsigned*)((const char*)(gbase) + (voff)[_i]), (PG8_LAS unsigned*)(lds + (bufoff) + ldsw + _i * 8192), 16, 0, 0); } while (0)
#define PG8_LDA(dst, b, h) do { _Pragma("unroll") for (int m = 0; m < 4; ++m) _Pragma("unroll") for (int k = 0; k < 2; ++k) dst[m][k] = *(const PG8_LAS bf16x8*)(lds + PG8_SA(b, h) + aoff + m * 2048 + k * 1024); } while (0)
#define PG8_LDB(dst, b, h) do { _Pragma("unroll") for (int n = 0; n < 2; ++n) _Pragma("unroll") for (int k = 0; k < 2; ++k) dst[n][k] = *(const PG8_LAS bf16x8*)(lds + PG8_SB(b, h) + boff + n * 2048 + k * 1024); } while (0)
#define PG8_MMA(ai, bj, At, Bt) do { __builtin_amdgcn_s_setprio(1); _Pragma("unroll") for (int m = 0; m < 4; ++m) _Pragma("unroll") for (int n = 0; n < 2; ++n) _Pragma("unroll") for (int k = 0; k < 2; ++k) \
        acc[ai][bj][m][n] = __builtin_amdgcn_mfma_f32_16x16x32_bf16(Bt[n][k], At[m][k], acc[ai][bj][m][n], 0, 0, 0); __builtin_amdgcn_s_setprio(0); } while (0)
#define PG8_WAIT_V(n) asm volatile("s_waitcnt vmcnt(" #n ")" ::: "memory")
#define PG8_WAIT_L(n) asm volatile("s_waitcnt lgkmcnt(" #n ")" ::: "memory")
#define PG8_BAR __builtin_amdgcn_s_barrier()
#define PG8_SCHED __builtin_amdgcn_sched_barrier(0)
    Unit cur, nxt; int ui = 0;
    if (!S.next(0, cur)) return;
    f32x4 acc[2][2][4][2];
#pragma unroll
    for (int a = 0; a < 2; ++a)
#pragma unroll
        for (int b = 0; b < 2; ++b)
#pragma unroll
            for (int m = 0; m < 4; ++m)
#pragma unroll
                for (int n = 0; n < 2; ++n) acc[a][b][m][n] = (f32x4){0.f, 0.f, 0.f, 0.f};
    bf16x8 At[4][2], B0[2][2], B1[2][2];
    const char* cA = (const char*)g.A + (size_t)cur.pm * tstep; const char* cB = (const char*)g.Bt + (size_t)cur.pn * tstep;
    S.a_ready(cur);
    if constexpr (SP2) {
        PG8_STAGE(PG8_SB(0, 0), cB, voffB); PG8_STAGE(PG8_SB(0, 1), cB + hstep, voffB); PG8_STAGE(PG8_SA(0, 0), cA, voffA); PG8_STAGE(PG8_SA(0, 1), cA + hstep, voffA);
        if (wr == 1) PG8_BAR;
        PG8_WAIT_V(2); PG8_BAR;
        PG8_STAGE(PG8_SB(1, 0), cB + kstep, voffB); PG8_STAGE(PG8_SA(1, 0), cA + kstep, voffA); PG8_STAGE(PG8_SB(1, 1), cB + hstep + kstep, voffB);
        PG8_WAIT_V(6); PG8_BAR;
    } else {
        PG8_STAGE(PG8_SB(0, 0), cB, voffB); PG8_STAGE(PG8_SA(0, 0), cA, voffA); PG8_STAGE(PG8_SB(0, 1), cB + hstep, voffB); PG8_STAGE(PG8_SA(0, 1), cA + hstep, voffA);
        if (wr == 1) PG8_BAR;
        PG8_WAIT_V(4); PG8_BAR;
        PG8_STAGE(PG8_SB(1, 0), cB + kstep, voffB); PG8_STAGE(PG8_SA(1, 0), cA + kstep, voffA); PG8_STAGE(PG8_SB(1, 1), cB + hstep + kstep, voffB);
        PG8_WAIT_V(6); PG8_BAR;
    }
    for (;;) {
        const bool has_next = S.next(ui + 1, nxt);
        const char* nA = has_next ? (const char*)g.A + (size_t)nxt.pm * tstep : cA; const char* nB = has_next ? (const char*)g.Bt + (size_t)nxt.pn * tstep : cB;
        for (int t = 0; t < nt; t += 2) {
            const bool last = (t == nt - 2);
            const char* a1 = cA + (size_t)(t + 1) * kstep;
            const char* a2 = last ? nA : cA + (size_t)(t + 2) * kstep; const char* b2 = last ? nB : cB + (size_t)(t + 2) * kstep;
            const char* a3 = a2 + kstep; const char* b3 = b2 + kstep;
            if (last && has_next) S.a_ready(nxt);
            if constexpr (SP2) {
            PG8_LDB(B0, 0, 0); PG8_LDB(B1, 0, 1); PG8_SCHED; PG8_LDA(At, 0, 0); PG8_STAGE(PG8_SA(1, 1), a1 + hstep, voffA);
            PG8_WAIT_V(8); PG8_WAIT_L(0); PG8_BAR; PG8_MMA(0, 0, At, B0); PG8_MMA(0, 1, At, B1); PG8_BAR; PG8_SCHED;
            PG8_LDA(At, 0, 1); PG8_STAGE(PG8_SB(0, 0), b2, voffB); PG8_STAGE(PG8_SB(0, 1), b2 + hstep, voffB); PG8_STAGE(PG8_SA(0, 0), a2, voffA);
            PG8_WAIT_V(8); PG8_WAIT_L(0); PG8_BAR; PG8_MMA(1, 0, At, B0); PG8_MMA(1, 1, At, B1); PG8_BAR; PG8_SCHED;
            PG8_LDB(B0, 1, 0); PG8_LDB(B1, 1, 1); PG8_SCHED; PG8_LDA(At, 1, 0); PG8_STAGE(PG8_SA(0, 1), a2 + hstep, voffA);
            PG8_WAIT_V(8); PG8_WAIT_L(0); PG8_BAR; PG8_MMA(0, 0, At, B0); PG8_MMA(0, 1, At, B1); PG8_BAR; PG8_SCHED;
            PG8_LDA(At, 1, 1); PG8_STAGE(PG8_SB(1, 0), b3, voffB); PG8_STAGE(PG8_SB(1, 1), b3 + hstep, voffB); PG8_STAGE(PG8_SA(1, 0), a3, voffA);
            PG8_WAIT_V(8); PG8_WAIT_L(0); PG8_BAR; PG8_MMA(1, 0, At, B0); PG8_MMA(1, 1, At, B1); PG8_BAR; PG8_SCHED;
            } else {
            PG8_LDB(B0, 0, 0); PG8_SCHED; PG8_LDA(At, 0, 0); PG8_STAGE(PG8_SA(1, 1), a1 + hstep, voffA);
            PG8_WAIT_L(8); PG8_BAR; PG8_WAIT_L(0); PG8_MMA(0, 0, At, B0); PG8_BAR; PG8_SCHED;
            PG8_LDB(B1, 0, 1); PG8_STAGE(PG8_SB(0, 0), b2, voffB);
            PG8_BAR; PG8_WAIT_L(0); PG8_MMA(0, 1, At, B1); PG8_BAR;
            PG8_LDA(At, 0, 1); PG8_STAGE(PG8_SA(0, 0), a2, voffA);
            PG8_BAR; PG8_WAIT_L(0); PG8_MMA(1, 0, At, B0); PG8_BAR; PG8_SCHED;
            PG8_STAGE(PG8_SB(0, 1), b2 + hstep, voffB);
            PG8_WAIT_V(6); PG8_BAR; PG8_MMA(1, 1, At, B1); PG8_BAR;
            PG8_LDB(B0, 1, 0); PG8_SCHED; PG8_LDA(At, 1, 0); PG8_STAGE(PG8_SA(0, 1), a2 + hstep, voffA);
            PG8_WAIT_L(8); PG8_BAR; PG8_WAIT_L(0); PG8_MMA(0, 0, At, B0); PG8_BAR; PG8_SCHED;
            PG8_LDB(B1, 1, 1); PG8_STAGE(PG8_SB(1, 0), b3, voffB);
            PG8_BAR; PG8_WAIT_L(0); PG8_MMA(0, 1, At, B1); PG8_BAR;
            PG8_LDA(At, 1, 1); PG8_STAGE(PG8_SA(1, 0), a3, voffA);
            PG8_BAR; PG8_WAIT_L(0); PG8_MMA(1, 0, At, B0); PG8_BAR; PG8_SCHED;
            PG8_STAGE(PG8_SB(1, 1), b3 + hstep, voffB);
            PG8_WAIT_V(6); PG8_BAR; PG8_MMA(1, 1, At, B1); PG8_BAR;
            }
        }
        if constexpr (ALIGN_EPI) { if (wr == 0) PG8_BAR; }
        if constexpr (!Epi::AFTER_DRAIN) { E(acc, cur, wr, wc, fr, fq); S.done(cur); }
        if (!has_next) break;
#pragma unroll
        for (int a = 0; a < 2; ++a)
#pragma unroll
            for (int b = 0; b < 2; ++b)
#pragma unroll
                for (int m = 0; m < 4; ++m)
#pragma unroll
                    for (int n = 0; n < 2; ++n) acc[a][b][m][n] = (f32x4){0.f, 0.f, 0.f, 0.f};
        cur = nxt; cA = nA; cB = nB; ++ui;
        if constexpr (ALIGN_EPI) { if (wr == 1) PG8_BAR; }
    }
    PG8_WAIT_V(0);
    if constexpr (!ALIGN_EPI) { if (wr == 0) PG8_BAR; }
    PG8_BAR;
    if constexpr (Epi::AFTER_DRAIN) { E.fused(acc, cur, wr, wc, fr, fq, lds, wid, lane); S.done(cur); }
#undef PG8_SA
#undef PG8_SB
#undef PG8_STAGE
#undef PG8_LDA
#undef PG8_LDB
#undef PG8_MMA
#undef PG8_WAIT_V
#undef PG8_WAIT_L
#undef PG8_BAR
#undef PG8_SCHED
}
}


constexpr int DM = 2048, NB = 2, SEQL = 4096, CTXL = 256, DEPTH = 2;
constexpr int ML = NB * SEQL, MC = NB * CTXL, MT = ML + MC;
constexpr int NIN = 3840, NINR = 3600;
constexpr int FF = 5632, FF2 = 11264;
constexpr int GW = 512;
constexpr float ALPHA = 1.4142135623730951f;
constexpr float LN_EPS = 1e-5f, RMS_EPS = 1e-5f;
constexpr int ADA_KS = 16;
constexpr int PC_S5 = 0, PC_SGU = 512, PC_SGV = 1024, PC_POOL = 1536, PC_Z = 2048, PC_XBC = 2560, PC_DT = 3584;
constexpr int MX_S5 = 0, MX_SG = 512, MX_POOL = 1024, MX_SSD = 1536;

enum { I_X = 0, I_C, I_CTX, I_CCTX, I_WADA, I_BADA, I_WIN, I_WOUT, I_LN1G, I_LN1B, I_LN2G, I_LN2B,
       I_S5ARE, I_S5AIM, I_S5BRE, I_S5BIM, I_S5CRE, I_S5CIM, I_S5LS, I_S5D, I_GLUW, I_GLUB,
       I_SGLNG, I_SGLNB, I_SGW, I_SGB, I_POOLW, I_POOLB, I_POOLS,
       I_M2CW, I_M2CB, I_M2DTB, I_M2ALOG, I_M2D, I_M2NW,
       I_WUP, I_FCW, I_FCB, I_WDN, N_IN };

constexpr size_t MiB = 1u << 20;
constexpr size_t WS_CTL = 0;
constexpr size_t WS_MADA = 1 * MiB;
constexpr size_t WS_MPART = 2 * MiB;
constexpr size_t WS_WIN = 8 * MiB;
constexpr size_t WS_WOUT = 40 * MiB;
constexpr size_t WS_WUP = 56 * MiB;
constexpr size_t WS_WDN = 144 * MiB;
constexpr size_t WS_WGLU = 188 * MiB;
constexpr size_t WS_H = 190 * MiB;
constexpr size_t WS_HMOD = 258 * MiB;
constexpr size_t WS_P = 292 * MiB;
constexpr size_t WS_DT = 356 * MiB;
constexpr size_t WS_DTS = 357 * MiB;
constexpr size_t WS_MIX = 358 * MiB;
constexpr size_t WS_Z = 392 * MiB;
constexpr size_t WS_Y5 = 401 * MiB;
constexpr size_t WS_XC = 418 * MiB;
constexpr size_t WS_YD = 452 * MiB;
constexpr size_t WS_GV = 486 * MiB;
constexpr size_t WS_ACT = 673 * MiB;
constexpr size_t WS_END = 767 * MiB;

constexpr int NWAVES = 8, NTHREADS = 512;
constexpr int LDS_BYTES = 147456;

#define GAS __attribute__((address_space(1)))
#define LAS __attribute__((address_space(3)))
typedef unsigned short bf16;
typedef unsigned v4u __attribute__((ext_vector_type(4)));
typedef unsigned v2u __attribute__((ext_vector_type(2)));
typedef float f32x4 __attribute__((ext_vector_type(4)));

__device__ __forceinline__ unsigned f2bf(float f) { unsigned u = __builtin_bit_cast(unsigned, f); return (u + 0x7fffu + ((u >> 16) & 1u)) >> 16; }
__device__ __forceinline__ unsigned pk2(float lo, float hi) { return f2bf(lo) | (f2bf(hi) << 16); }
__device__ __forceinline__ float bf2f(unsigned short h) { return __builtin_bit_cast(float, (unsigned)h << 16); }
__device__ __forceinline__ float bflo(unsigned w) { return __builtin_bit_cast(float, w << 16); }
__device__ __forceinline__ float bfhi(unsigned w) { return __builtin_bit_cast(float, w & 0xffff0000u); }
__device__ __forceinline__ float sigmoidf_(float x) { return 1.f / (1.f + __expf(-x)); }
__device__ __forceinline__ float siluf_(float x) { return x * sigmoidf_(x); }
__device__ __forceinline__ float gelu_tanh(float x) {
    const float u = 0.7978845608028654f * (x + 0.044715f * x * x * x);
    const float t = 1.f - 2.f / (1.f + __expf(2.f * u));
    return 0.5f * x * (1.f + t);
}
__device__ __forceinline__ float softplusf_(float x) { return x > 20.f ? x : log1pf(expf(x)); }
__device__ __forceinline__ float wave_sum(float v) {
#pragma unroll
    for (int o = 1; o < 64; o <<= 1) v += __shfl_xor(v, o);
    return v;
}

namespace pg8 {
struct EpiIn {
    static constexpr bool PERM = true, AFTER_DRAIN = false;
    bf16_t* P; float* DT;
    __device__ __forceinline__ void operator()(const f32x4 (&acc)[2][2][4][2], const Unit& u, int wr, int wc, int fr, int fq) const {
        const int row0 = u.pm * BM + wr * 64 + fr;
        if (u.pn == 14) {
            if (wc == 0 && fq < 2) {
#pragma unroll
                for (int ai = 0; ai < 2; ++ai)
#pragma unroll
                    for (int m = 0; m < 4; ++m) { float* d = DT + (size_t)(row0 + ai * HALF + m * 16) * 16 + 8 * fq;
                        *(f32x4*)(d) = acc[ai][0][m][0]; *(f32x4*)(d + 4) = acc[ai][0][m][1]; }
            }
            return;
        }
        const int col0 = u.pn * BM + wc * 32 + 8 * fq;
#pragma unroll
        for (int ai = 0; ai < 2; ++ai)
#pragma unroll
            for (int m = 0; m < 4; ++m) { bf16_t* rowp = P + (size_t)(row0 + ai * HALF + m * 16) * NIN + col0;
#pragma unroll
                for (int bj = 0; bj < 2; ++bj) { const f32x4 v0 = acc[ai][bj][m][0], v1 = acc[ai][bj][m][1];
                    u32x4 w; w.x = cvt_pk_bf16(v0[0], v0[1]); w.y = cvt_pk_bf16(v0[2], v0[3]); w.z = cvt_pk_bf16(v1[0], v1[1]); w.w = cvt_pk_bf16(v1[2], v1[3]);
                    *(u32x4*)(rowp + bj * HALF) = w; } }
    }
};
struct EpiStore {
    static constexpr bool PERM = true, AFTER_DRAIN = false;
    bf16_t* O; int ldc;
    __device__ __forceinline__ void operator()(const f32x4 (&acc)[2][2][4][2], const Unit& u, int wr, int wc, int fr, int fq) const {
        const int row0 = u.pm * BM + wr * 64 + fr, col0 = u.pn * BM + wc * 32 + 8 * fq;
#pragma unroll
        for (int ai = 0; ai < 2; ++ai)
#pragma unroll
            for (int m = 0; m < 4; ++m) { bf16_t* rowp = O + (size_t)(row0 + ai * HALF + m * 16) * ldc + col0;
#pragma unroll
                for (int bj = 0; bj < 2; ++bj) { const f32x4 v0 = acc[ai][bj][m][0], v1 = acc[ai][bj][m][1];
                    u32x4 w; w.x = cvt_pk_bf16(v0[0], v0[1]); w.y = cvt_pk_bf16(v0[2], v0[3]); w.z = cvt_pk_bf16(v1[0], v1[1]); w.w = cvt_pk_bf16(v1[2], v1[3]);
                    *(u32x4*)(rowp + bj * HALF) = w; } }
    }
};
struct EpiGlu {
    static constexpr bool PERM = true, AFTER_DRAIN = false;
    const bf16_t* Z; bf16_t* O; const float* bias;
    __device__ __forceinline__ void operator()(const f32x4 (&acc)[2][2][4][2], const Unit& u, int wr, int wc, int fr, int fq) const {
        const int row0 = u.pm * BM + wr * 64 + fr, col0 = u.pn * BM + wc * 32 + 8 * fq;
#pragma unroll
        for (int ai = 0; ai < 2; ++ai)
#pragma unroll
            for (int m = 0; m < 4; ++m) { const int row = row0 + ai * HALF + m * 16;
#pragma unroll
                for (int bj = 0; bj < 2; ++bj) { const int col = col0 + bj * HALF;
                    const u32x4 zz = *(const u32x4*)(Z + (size_t)row * GW + col);
                    const f32x4 b0 = *(const f32x4*)(bias + col), b1 = *(const f32x4*)(bias + col + 4);
                    const f32x4 v0 = acc[ai][bj][m][0] + b0, v1 = acc[ai][bj][m][1] + b1;
                    float o[8];
                    o[0] = bflo(zz.x) * sigmoidf_(v0[0]); o[1] = bfhi(zz.x) * sigmoidf_(v0[1]); o[2] = bflo(zz.y) * sigmoidf_(v0[2]); o[3] = bfhi(zz.y) * sigmoidf_(v0[3]);
                    o[4] = bflo(zz.z) * sigmoidf_(v1[0]); o[5] = bfhi(zz.z) * sigmoidf_(v1[1]); o[6] = bflo(zz.w) * sigmoidf_(v1[2]); o[7] = bfhi(zz.w) * sigmoidf_(v1[3]);
                    u32x4 w; w.x = cvt_pk_bf16(o[0], o[1]); w.y = cvt_pk_bf16(o[2], o[3]); w.z = cvt_pk_bf16(o[4], o[5]); w.w = cvt_pk_bf16(o[6], o[7]);
                    *(u32x4*)(O + (size_t)row * DM + col) = w; } }
    }
};
struct EpiRes {
    static constexpr bool PERM = false, AFTER_DRAIN = false;
    float* H; const float* gate; int vstride;
    __device__ __forceinline__ void operator()(const f32x4 (&acc)[2][2][4][2], const Unit& u, int wr, int wc, int fr, int fq) const {
        const int row0 = u.pm * BM + wr * 64 + fr, col0 = u.pn * BM + wc * 32 + 4 * fq;
        const int var = u.pm < 16 ? 0 : (u.pm < 32 ? 1 : 2);
        const float* gv = gate + (size_t)var * vstride;
#pragma unroll
        for (int bj = 0; bj < 2; ++bj)
#pragma unroll
            for (int n = 0; n < 2; ++n) { const int col = col0 + bj * HALF + n * 16; const f32x4 g4 = *(const f32x4*)(gv + col);
#pragma unroll
                for (int ai = 0; ai < 2; ++ai)
#pragma unroll
                    for (int m = 0; m < 4; ++m) { float* p = H + (size_t)(row0 + ai * HALF + m * 16) * DM + col;
                        const f32x4 hv = *(const f32x4*)p; *(f32x4*)p = hv * ALPHA + g4 * acc[ai][bj][m][n]; } }
    }
};
}

struct Args { const float* in[N_IN]; float* out; unsigned char* ws; };

struct Frame {
    LAS unsigned char* lds;
    int tid, lane, wave, bid, G;
    const __attribute__((address_space(4))) Args* a;
};
#define WSP(T, off) ((T*)(F.a->ws + (off)))

__device__ __forceinline__ void row_seq(int row, int& base, int& t, int& len) {
    if (row < ML) { base = row & ~(SEQL - 1); t = row & (SEQL - 1); len = SEQL; }
    else { base = ML + ((row - ML) & ~(CTXL - 1)); t = (row - ML) & (CTXL - 1); len = CTXL; }
}
__device__ __forceinline__ int proc_row(int q, int dir, int b) {
    if (q < CTXL) { const int t = dir ? (CTXL - 1 - q) : q; return ML + b * CTXL + t; }
    const int ql = q - CTXL; const int t = dir ? (SEQL - 1 - ql) : ql; return b * SEQL + t;
}

__device__ __forceinline__ void transpose_item(const float* W, int K, int N, bf16* WT, LAS float* scr, int item, int nblk, int lane) {
    const int kb = item / nblk, nb = item % nblk, k0 = 64 * kb, n0 = 32 * nb;
    const int nn = n0 + (lane & 31);
#pragma unroll 8
    for (int i = 0; i < 32; ++i) { const int kk = 2 * i + (lane >> 5); scr[kk * 33 + (lane & 31)] = (nn < N) ? W[(size_t)(k0 + kk) * N + nn] : 0.f; }
    asm volatile("s_waitcnt lgkmcnt(0)" ::: "memory");
    const int c = lane & 7;
#pragma unroll
    for (int j = 0; j < 4; ++j) { const int n = (lane >> 3) + 8 * j; const LAS float* s = scr + (8 * c) * 33 + n;
        v4u o; o.x = pk2(s[0 * 33], s[1 * 33]); o.y = pk2(s[2 * 33], s[3 * 33]); o.z = pk2(s[4 * 33], s[5 * 33]); o.w = pk2(s[6 * 33], s[7 * 33]);
        *(v4u*)(WT + (size_t)(n0 + n) * K + k0 + 8 * c) = o; }
    asm volatile("s_waitcnt lgkmcnt(0)" ::: "memory");
}

__device__ __forceinline__ void phase_pro_a(Frame& F) {
    LAS float* scr = (LAS float*)(F.lds + F.wave * 16384);
    const int gw = F.bid * NWAVES + F.wave, NGW = F.G * NWAVES;
    constexpr int I_IN = (DM / 64) * (NIN / 32), I_OUT = (DM / 64) * (DM / 32), I_UP = (DM / 64) * (FF2 / 32), I_DN = (FF / 64) * (DM / 32), I_GL = (GW / 64) * (GW / 32);
    constexpr int PER_L = I_IN + I_OUT + I_UP + I_DN + I_GL;
    for (int it = gw; it < DEPTH * PER_L; it += NGW) {
        const int l = it / PER_L; int r = it % PER_L;
        if (r < I_IN) { transpose_item(F.a->in[I_WIN] + (size_t)l * DM * NINR, DM, NINR, WSP(bf16, WS_WIN) + (size_t)l * NIN * DM, scr, r, NIN / 32, F.lane); continue; } r -= I_IN;
        if (r < I_OUT) { transpose_item(F.a->in[I_WOUT] + (size_t)l * DM * DM, DM, DM, WSP(bf16, WS_WOUT) + (size_t)l * DM * DM, scr, r, DM / 32, F.lane); continue; } r -= I_OUT;
        if (r < I_UP) { transpose_item(F.a->in[I_WUP] + (size_t)l * DM * FF2, DM, FF2, WSP(bf16, WS_WUP) + (size_t)l * FF2 * DM, scr, r, FF2 / 32, F.lane); continue; } r -= I_UP;
        if (r < I_DN) { transpose_item(F.a->in[I_WDN] + (size_t)l * FF * DM, FF, DM, WSP(bf16, WS_WDN) + (size_t)l * DM * FF, scr, r, DM / 32, F.lane); continue; } r -= I_DN;
        transpose_item(F.a->in[I_GLUW] + (size_t)l * GW * GW, GW, GW, WSP(bf16, WS_WGLU) + (size_t)l * GW * GW, scr, r, GW / 32, F.lane);
    }
    constexpr int NCB = 6 * DM / 256, KSL = DM / ADA_KS;
    const float* c = F.a->in[I_C]; const float* cc = F.a->in[I_CCTX];
    for (int job = gw; job < DEPTH * NCB * ADA_KS; job += NGW) {
        const int l = job / (NCB * ADA_KS), r = job % (NCB * ADA_KS), cb = r / ADA_KS, ks = r % ADA_KS;
        const float* W = F.a->in[I_WADA] + (size_t)l * DM * 6 * DM + cb * 256 + F.lane * 4;
        f32x4 a0 = {0.f, 0.f, 0.f, 0.f}, a1 = a0, a2 = a0;
#pragma unroll 4
        for (int k = ks * KSL; k < (ks + 1) * KSL; ++k) {
            const f32x4 w = *(const f32x4*)(W + (size_t)k * 6 * DM);
            const float s0 = siluf_(c[k]), s1 = siluf_(c[DM + k]), s2 = siluf_(cc[k]);
            a0 += w * s0; a1 += w * s1; a2 += w * s2;
        }
        float* mp = WSP(float, WS_MPART) + ((size_t)(l * ADA_KS + ks) * 3) * 6 * DM + cb * 256 + F.lane * 4;
        *(f32x4*)(mp) = a0; *(f32x4*)(mp + 6 * DM) = a1; *(f32x4*)(mp + 2 * 6 * DM) = a2;
    }
}

__device__ __forceinline__ void phase_pro_b(Frame& F) {
    const int gt = F.bid * NTHREADS + F.tid, NGT = F.G * NTHREADS;
    for (int i = gt; i < DEPTH * 3 * 6 * DM; i += NGT) {
        const int l = i / (3 * 6 * DM), r = i % (3 * 6 * DM), v = r / (6 * DM), n = r % (6 * DM);
        float s = F.a->in[I_BADA][l * 6 * DM + n];
        const float* mp = WSP(float, WS_MPART) + ((size_t)(l * ADA_KS) * 3 + v) * 6 * DM + n;
#pragma unroll
        for (int ks = 0; ks < ADA_KS; ++ks) s += mp[(size_t)ks * 3 * 6 * DM];
        WSP(float, WS_MADA)[i] = s;
    }
}
__device__ __forceinline__ const float* mvec(Frame& F, int l, int v, int j) { return WSP(float, WS_MADA) + ((size_t)(l * 3 + v) * 6 + j) * DM; }
__device__ __forceinline__ int row_var(int row) { return row < SEQL ? 0 : (row < ML ? 1 : 2); }

template <bool DO_LN>
__device__ __forceinline__ void row_pass(Frame& F, const float* srcrow, const float* g, const float* b, float* dstrow, bf16* modrow, const float* shift, const float* scale) {
    f32x4 v[8];
#pragma unroll
    for (int j = 0; j < 8; ++j) v[j] = *(const f32x4*)(srcrow + j * 256 + F.lane * 4);
    if (DO_LN) {
        float s = 0.f;
#pragma unroll
        for (int j = 0; j < 8; ++j) s += (v[j][0] + v[j][1]) + (v[j][2] + v[j][3]);
        const float mean = wave_sum(s) * (1.f / DM); float s2 = 0.f;
#pragma unroll
        for (int j = 0; j < 8; ++j) { v[j] = v[j] - mean; s2 += (v[j][0] * v[j][0] + v[j][1] * v[j][1]) + (v[j][2] * v[j][2] + v[j][3] * v[j][3]); }
        const float rstd = 1.f / sqrtf(wave_sum(s2) * (1.f / DM) + LN_EPS);
#pragma unroll
        for (int j = 0; j < 8; ++j) { const f32x4 gg = *(const f32x4*)(g + j * 256 + F.lane * 4), bb = *(const f32x4*)(b + j * 256 + F.lane * 4); v[j] = v[j] * rstd * gg + bb; }
    }
    if (dstrow) {
#pragma unroll
        for (int j = 0; j < 8; ++j) *(f32x4*)(dstrow + j * 256 + F.lane * 4) = v[j];
    }
    if (modrow) {
#pragma unroll
        for (int j = 0; j < 8; ++j) { const f32x4 sh = *(const f32x4*)(shift + j * 256 + F.lane * 4), sc = *(const f32x4*)(scale + j * 256 + F.lane * 4);
            const f32x4 o = v[j] * (sc + 1.f) + sh; v2u w; w.x = pk2(o[0], o[1]); w.y = pk2(o[2], o[3]);
            *(v2u*)(modrow + j * 256 + F.lane * 4) = w; }
    }
}
__device__ __forceinline__ void phase_pro_c(Frame& F) {
    const int gw = F.bid * NWAVES + F.wave, NGW = F.G * NWAVES;
    for (int row = gw; row < MT; row += NGW) {
        const float* src = row < ML ? F.a->in[I_X] + (size_t)row * DM : F.a->in[I_CTX] + (size_t)(row - ML) * DM;
        const int v = row_var(row);
        row_pass<false>(F, src, nullptr, nullptr, WSP(float, WS_H) + (size_t)row * DM, WSP(bf16, WS_HMOD) + (size_t)row * DM, mvec(F, 0, v, 0), mvec(F, 0, v, 1));
    }
}
__device__ __forceinline__ void phase_ln(Frame& F, const float* g, const float* b, int ml, int js, bool final_out) {
    const int gw = F.bid * NWAVES + F.wave, NGW = F.G * NWAVES;
    const int nrows = final_out ? ML : MT;
    for (int row = gw; row < nrows; row += NGW) {
        const int v = row_var(row);
        float* hrow = WSP(float, WS_H) + (size_t)row * DM;
        if (final_out) row_pass<true>(F, hrow, g, b, F.a->out + (size_t)row * DM, nullptr, nullptr, nullptr);
        else row_pass<true>(F, hrow, g, b, hrow, WSP(bf16, WS_HMOD) + (size_t)row * DM, mvec(F, ml, v, js), mvec(F, ml, v, js + 1));
    }
}

__device__ __forceinline__ void s5_oracle_job(Frame& F, int l, int b, int g) {
    LAS float* hb = (LAS float*)(F.lds);
    LAS float* cs = (LAS float*)(F.lds + 8192);
    const int p = F.lane;
    const bf16* P = WSP(bf16, WS_P);
    float* Y5 = WSP(float, WS_Y5); bf16* Z = WSP(bf16, WS_Z);
    for (int dir = 0; dir < 2; ++dir) {
        const int gi = (l * 2 + dir) * 32 + g;
        const float ar = F.a->in[I_S5ARE][gi * 64 + p], ai = F.a->in[I_S5AIM][gi * 64 + p];
        const float step = expf(F.a->in[I_S5LS][gi]);
        const float e = expf(ar * step); float sn, cn; sincosf(ai * step, &sn, &cn);
        const float abr = e * cn, abi = e * sn;
        const float den = ar * ar + ai * ai;
        const float qr = ((abr - 1.f) * ar + abi * ai) / den, qi = (abi * ar - (abr - 1.f) * ai) / den;
        float bbr[16], bbi[16];
#pragma unroll
        for (int h = 0; h < 16; ++h) { const float br = F.a->in[I_S5BRE][(size_t)(gi * 64 + p) * 16 + h], bi = F.a->in[I_S5BIM][(size_t)(gi * 64 + p) * 16 + h];
            bbr[h] = qr * br - qi * bi; bbi[h] = qr * bi + qi * br; }
        asm volatile("s_waitcnt lgkmcnt(0)" ::: "memory");
#pragma unroll
        for (int ho = 0; ho < 16; ++ho) { cs[(ho * 64 + p) * 2] = F.a->in[I_S5CRE][(size_t)(gi * 16 + ho) * 64 + p]; cs[(ho * 64 + p) * 2 + 1] = F.a->in[I_S5CIM][(size_t)(gi * 16 + ho) * 64 + p]; }
        float hr = 0.f, hi = 0.f;
        for (int blk = 0; blk < (CTXL + SEQL) / 16; ++blk) {
            for (int i = 0; i < 16; ++i) {
                const int row = proc_row(blk * 16 + i, dir, b);
                const v4u u0 = *(const v4u*)(P + (size_t)row * NIN + PC_S5 + g * 16), u1 = *(const v4u*)(P + (size_t)row * NIN + PC_S5 + g * 16 + 8);
                float u[16];
                u[0] = bflo(u0.x); u[1] = bfhi(u0.x); u[2] = bflo(u0.y); u[3] = bfhi(u0.y); u[4] = bflo(u0.z); u[5] = bfhi(u0.z); u[6] = bflo(u0.w); u[7] = bfhi(u0.w);
                u[8] = bflo(u1.x); u[9] = bfhi(u1.x); u[10] = bflo(u1.y); u[11] = bfhi(u1.y); u[12] = bflo(u1.z); u[13] = bfhi(u1.z); u[14] = bflo(u1.w); u[15] = bfhi(u1.w);
                float bur = 0.f, bui = 0.f;
#pragma unroll
                for (int h = 0; h < 16; ++h) { bur += bbr[h] * u[h]; bui += bbi[h] * u[h]; }
                const float nr = abr * hr - abi * hi + bur, ni = abr * hi + abi * hr + bui;
                hr = nr; hi = ni;
                hb[(i * 64 + p) * 2] = hr; hb[(i * 64 + p) * 2 + 1] = hi;
            }
            asm volatile("s_waitcnt lgkmcnt(0)" ::: "memory");
            {
                const int i = F.lane >> 2, ho4 = (F.lane & 3) * 4;
                float y[4] = {0.f, 0.f, 0.f, 0.f};
                for (int pp = 0; pp < 64; ++pp) { const float xr = hb[(i * 64 + pp) * 2], xi = hb[(i * 64 + pp) * 2 + 1];
#pragma unroll
                    for (int j = 0; j < 4; ++j) y[j] += xr * cs[((ho4 + j) * 64 + pp) * 2] - xi * cs[((ho4 + j) * 64 + pp) * 2 + 1]; }
                const int row = proc_row(blk * 16 + i, dir, b);
                float* yp = Y5 + (size_t)row * GW + g * 16 + ho4;
                if (dir == 0) { *(f32x4*)yp = (f32x4){y[0], y[1], y[2], y[3]}; }
                else {
                    const f32x4 yf = *(const f32x4*)yp;
                    const v2u uu = *(const v2u*)(P + (size_t)row * NIN + PC_S5 + g * 16 + ho4);
                    const float* dd = F.a->in[I_S5D] + l * GW + g * 16 + ho4;
                    const float z0 = gelu_tanh(yf[0] + y[0] + dd[0] * bflo(uu.x)), z1 = gelu_tanh(yf[1] + y[1] + dd[1] * bfhi(uu.x));
                    const float z2 = gelu_tanh(yf[2] + y[2] + dd[2] * bflo(uu.y)), z3 = gelu_tanh(yf[3] + y[3] + dd[3] * bfhi(uu.y));
                    v2u w; w.x = pk2(z0, z1); w.y = pk2(z2, z3);
                    *(v2u*)(Z + (size_t)row * GW + g * 16 + ho4) = w;
                }
            }
            asm volatile("s_waitcnt vmcnt(0) lgkmcnt(0)" ::: "memory");
        }
        asm volatile("s_waitcnt vmcnt(0) lgkmcnt(0)" ::: "memory");
    }
}
__device__ __forceinline__ void ssd_prep_oracle(Frame& F, int l) {
    const int gt = F.bid * NTHREADS + F.tid, NGT = F.G * NTHREADS;
    const bf16* P = WSP(bf16, WS_P); float* XC = WSP(float, WS_XC);
    const float* cw = F.a->in[I_M2CW] + (size_t)l * 4 * 1024; const float* cb = F.a->in[I_M2CB] + l * 1024;
    for (int i = gt; i < MT * 1024; i += NGT) {
        const int row = i >> 10, ch = i & 1023; int base, t, len; row_seq(row, base, t, len);
        float a = cb[ch];
#pragma unroll
        for (int k = 0; k < 4; ++k) { const int tt = t - 2 + k; if (tt >= 0 && tt < len) a += cw[k * 1024 + ch] * bf2f(P[(size_t)(base + tt) * NIN + PC_XBC + ch]); }
        XC[i] = siluf_(a);
    }
    const float* dtr = WSP(float, WS_DT); float* dts = WSP(float, WS_DTS);
    for (int i = gt; i < MT * 16; i += NGT) dts[i] = softplusf_(dtr[i] + F.a->in[I_M2DTB][l * 16 + (i & 15)]);
}
__device__ __forceinline__ void ssd_scan_oracle_job(Frame& F, int l, int b, int hd, int dir) {
    LAS float* xs = (LAS float*)(F.lds);
    LAS float* Bs = (LAS float*)(F.lds + 8192);
    LAS float* Cs = (LAS float*)(F.lds + 8192 + 16384);
    LAS float* ds = (LAS float*)(F.lds + 8192 + 32768);
    LAS float* yb = (LAS float*)(F.lds + 8192 + 32768 + 256);
    LAS int* rws = (LAS int*)(F.lds + 8192 + 32768 + 256 + 8192);
    const float* XC = WSP(float, WS_XC); const float* dts = WSP(float, WS_DTS); float* YD = WSP(float, WS_YD) + (size_t)dir * MT * GW;
    const int p = F.tid >> 3, nq = F.tid & 7, n0 = nq * 16, grp = hd >> 2;
    const float a = -expf(F.a->in[I_M2ALOG][l * 16 + dir * 8 + hd]);
    float hs[16];
#pragma unroll
    for (int k = 0; k < 16; ++k) hs[k] = 0.f;
    for (int q0 = 0; q0 < CTXL + SEQL; q0 += 32) {
        __syncthreads();
        for (int idx = F.tid; idx < 32 * 64; idx += NTHREADS) { const int i = idx >> 6, c = idx & 63; const int row = proc_row(q0 + i, dir, b); xs[idx] = XC[(size_t)row * 1024 + hd * 64 + c]; }
        for (int idx = F.tid; idx < 32 * 128; idx += NTHREADS) { const int i = idx >> 7, n = idx & 127; const int row = proc_row(q0 + i, dir, b);
            Bs[idx] = XC[(size_t)row * 1024 + 512 + grp * 128 + n]; Cs[idx] = XC[(size_t)row * 1024 + 768 + grp * 128 + n]; }
        if (F.tid < 32) { const int row = proc_row(q0 + F.tid, dir, b); ds[F.tid] = dts[(size_t)row * 16 + dir * 8 + hd]; rws[F.tid] = row; }
        __syncthreads();
        for (int i = 0; i < 32; ++i) {
            const float dt = ds[i], da = expf(dt * a), xd = xs[i * 64 + p] * dt;
            float part = 0.f;
#pragma unroll
            for (int k = 0; k < 16; ++k) { hs[k] = da * hs[k] + xd * Bs[i * 128 + n0 + k]; part += Cs[i * 128 + n0 + k] * hs[k]; }
            part += __shfl_xor(part, 1); part += __shfl_xor(part, 2); part += __shfl_xor(part, 4);
            if (nq == 0) yb[i * 64 + p] = part;
        }
        __syncthreads();
        for (int idx = F.tid; idx < 32 * 64; idx += NTHREADS) { const int i = idx >> 6, c = idx & 63; YD[(size_t)rws[i] * GW + hd * 64 + c] = yb[idx]; }
    }
    __syncthreads();
}
__device__ __forceinline__ void ssd_finish_oracle(Frame& F, int l) {
    const int gw = F.bid * NWAVES + F.wave, NGW = F.G * NWAVES;
    const float* XC = WSP(float, WS_XC); const float* YD = WSP(float, WS_YD); const bf16* P = WSP(bf16, WS_P); bf16* MIX = WSP(bf16, WS_MIX);
    for (int row = gw; row < MT; row += NGW) {
#pragma unroll
        for (int j = 0; j < 2; ++j) {
            const int ch = j * 256 + F.lane * 4;
            const f32x4 y0 = *(const f32x4*)(YD + (size_t)row * GW + ch), y1 = *(const f32x4*)(YD + (size_t)(MT + row) * GW + ch), xv = *(const f32x4*)(XC + (size_t)row * 1024 + ch);
            const float dh = F.a->in[I_M2D][l * 8 + (ch >> 6)];
            const v2u zz = *(const v2u*)(P + (size_t)row * NIN + PC_Z + ch);
            f32x4 gq; float zf[4] = {bflo(zz.x), bfhi(zz.x), bflo(zz.y), bfhi(zz.y)};
#pragma unroll
            for (int k = 0; k < 4; ++k) gq[k] = (y0[k] + y1[k] + dh * xv[k]) * siluf_(zf[k]);
            const float ss = wave_sum((gq[0] * gq[0] + gq[1] * gq[1]) + (gq[2] * gq[2] + gq[3] * gq[3]));
            const float rs = 1.f / sqrtf(ss * (1.f / 256.f) + RMS_EPS);
            const f32x4 nw = *(const f32x4*)(F.a->in[I_M2NW] + l * GW + ch);
            v2u w; w.x = pk2(gq[0] * rs * nw[0], gq[1] * rs * nw[1]); w.y = pk2(gq[2] * rs * nw[2], gq[3] * rs * nw[3]);
            *(v2u*)(MIX + (size_t)row * DM + MX_SSD + ch) = w;
        }
    }
}
__device__ __forceinline__ void sg_oracle_job(Frame& F, int l, int cj, int hh) {
    LAS float* v = (LAS float*)(F.lds);
    const bf16* P = WSP(bf16, WS_P); bf16* MIX = WSP(bf16, WS_MIX);
    const int r0 = cj * 128;
    __syncthreads();
    for (int j = F.wave; j < 128; j += NWAVES) {
        const unsigned w = *(const unsigned*)(P + (size_t)(r0 + j) * NIN + PC_SGV + hh * 128 + F.lane * 2);
        const float a0 = gelu_tanh(bflo(w)), a1 = gelu_tanh(bfhi(w));
        const float mean = wave_sum(a0 + a1) * (1.f / 128.f);
        const float d0 = a0 - mean, d1 = a1 - mean;
        const float rstd = 1.f / sqrtf(wave_sum(d0 * d0 + d1 * d1) * (1.f / 128.f) + LN_EPS);
        const int d = F.lane * 2;
        v[j * 128 + d] = d0 * rstd * F.a->in[I_SGLNG][l * GW + hh * 128 + d] + F.a->in[I_SGLNB][l * GW + hh * 128 + d];
        v[j * 128 + d + 1] = d1 * rstd * F.a->in[I_SGLNG][l * GW + hh * 128 + d + 1] + F.a->in[I_SGLNB][l * GW + hh * 128 + d + 1];
    }
    __syncthreads();
    const int d = F.tid & 127, ig = F.tid >> 7;
    const float* ws = F.a->in[I_SGW] + (size_t)(l * 4 + hh) * 128 * 128;
    for (int ii = 0; ii < 32; ++ii) {
        const int i = ig * 32 + ii;
        float s = F.a->in[I_SGB][(l * 4 + hh) * 128 + i];
        for (int j = 0; j < 128; ++j) s += ws[i * 128 + j] * v[j * 128 + d];
        const float uu = gelu_tanh(bf2f(P[(size_t)(r0 + i) * NIN + PC_SGU + hh * 128 + d]));
        MIX[(size_t)(r0 + i) * DM + MX_SG + hh * 128 + d] = (bf16)f2bf(uu * s);
    }
    __syncthreads();
}
__device__ __forceinline__ void pool_oracle_job(Frame& F, int l, int tile, int gp) {
    LAS float* m = (LAS float*)(F.lds);
    const bf16* P = WSP(bf16, WS_P); bf16* MIX = WSP(bf16, WS_MIX);
    const int r0 = tile * 32, win = 2 << gp;
    __syncthreads();
    for (int idx = F.tid; idx < 32 * 128; idx += NTHREADS) {
        const int i = idx >> 7, c = idx & 127; int base, t, len; row_seq(r0 + i, base, t, len);
        int lo = t - win / 2; if (lo < 0) lo = 0; int hi = t + win / 2 - 1; if (hi > len - 1) hi = len - 1;
        float s = 0.f;
        for (int k = lo; k <= hi; ++k) s += bf2f(P[(size_t)(base + k) * NIN + PC_POOL + gp * 128 + c]);
        m[idx] = s / (float)(hi - lo + 1) - bf2f(P[(size_t)(r0 + i) * NIN + PC_POOL + gp * 128 + c]);
    }
    __syncthreads();
    const int d = F.tid & 127, ig = F.tid >> 7;
    const float* w = F.a->in[I_POOLW] + (size_t)(l * 4 + gp) * 128 * 128;
    for (int ii = 0; ii < 8; ++ii) {
        const int i = ig * 8 + ii; float s = 0.f;
        for (int c = 0; c < 128; ++c) s += m[i * 128 + c] * w[c * 128 + d];
        s = (s + F.a->in[I_POOLB][l * GW + gp * 128 + d]) * F.a->in[I_POOLS][l * GW + gp * 128 + d];
        MIX[(size_t)(r0 + i) * DM + MX_POOL + gp * 128 + d] = (bf16)f2bf(s);
    }
    __syncthreads();
}
__device__ __forceinline__ void ffn_act_oracle(Frame& F, int l) {
    const int gt = F.bid * NTHREADS + F.tid, NGT = F.G * NTHREADS;
    const bf16* GV = WSP(bf16, WS_GV); bf16* ACT = WSP(bf16, WS_ACT);
    const float* cw = F.a->in[I_FCW] + (size_t)l * 9 * FF; const float* cb = F.a->in[I_FCB] + l * FF;
    constexpr int FV = FF / 8;
    for (int i = gt; i < MT * FV; i += NGT) {
        const int row = i / FV, f0 = (i % FV) * 8;
        float a[8];
#pragma unroll
        for (int k = 0; k < 8; ++k) a[k] = cb[f0 + k];
        if (row < ML) {
            const int b = row >> 12, t = row & 4095, r = t >> 6, c = t & 63;
            for (int dr = -1; dr <= 1; ++dr) for (int dc = -1; dc <= 1; ++dc) {
                const int rr = r + dr, c2 = c + dc; if (rr < 0 || rr > 63 || c2 < 0 || c2 > 63) continue;
                const v4u g = *(const v4u*)(GV + (size_t)(b * SEQL + rr * 64 + c2) * FF2 + f0);
                const float* w = cw + ((dr + 1) * 3 + (dc + 1)) * FF + f0;
                a[0] += w[0] * bflo(g.x); a[1] += w[1] * bfhi(g.x); a[2] += w[2] * bflo(g.y); a[3] += w[3] * bfhi(g.y);
                a[4] += w[4] * bflo(g.z); a[5] += w[5] * bfhi(g.z); a[6] += w[6] * bflo(g.w); a[7] += w[7] * bfhi(g.w);
            }
        } else {
            int base, t, len; row_seq(row, base, t, len);
            for (int k = 0; k < 3; ++k) { const int tt = t + k - 1; if (tt < 0 || tt >= len) continue;
                const v4u g = *(const v4u*)(GV + (size_t)(base + tt) * FF2 + f0);
                const float* w = cw + (3 + k) * FF + f0;
                a[0] += w[0] * bflo(g.x); a[1] += w[1] * bfhi(g.x); a[2] += w[2] * bflo(g.y); a[3] += w[3] * bfhi(g.y);
                a[4] += w[4] * bflo(g.z); a[5] += w[5] * bfhi(g.z); a[6] += w[6] * bflo(g.w); a[7] += w[7] * bfhi(g.w);
            }
        }
        const v4u vv = *(const v4u*)(GV + (size_t)row * FF2 + FF + f0);
        v4u o;
        o.x = pk2(gelu_tanh(a[0]) * bflo(vv.x), gelu_tanh(a[1]) * bfhi(vv.x)); o.y = pk2(gelu_tanh(a[2]) * bflo(vv.y), gelu_tanh(a[3]) * bfhi(vv.y));
        o.z = pk2(gelu_tanh(a[4]) * bflo(vv.z), gelu_tanh(a[5]) * bfhi(vv.z)); o.w = pk2(gelu_tanh(a[6]) * bflo(vv.w), gelu_tanh(a[7]) * bfhi(vv.w));
        *(v4u*)(ACT + (size_t)row * FF + f0) = o;
    }
}

constexpr int PH_PRO_A = 0, PH_PRO_B = 1, PH_PRO_C = 2, PH_L0 = 3, NPH_L = 10, N_PHASES = PH_L0 + DEPTH * NPH_L;


template <int PH>
__device__ __forceinline__ void run_phase(LAS unsigned char* ldsp) {
    Frame F;
    F.lds = ldsp;
    { int t_ = threadIdx.x; asm volatile("" : "+v"(t_)); F.tid = t_; }
    F.lane = F.tid & 63; F.wave = __builtin_amdgcn_readfirstlane(F.tid >> 6);
    { int b_ = blockIdx.x, g_ = gridDim.x; asm volatile("" : "+s"(b_), "+s"(g_)); F.bid = b_; F.G = g_; }
    { const __attribute__((address_space(4))) Args* ap = (const __attribute__((address_space(4))) Args*)__builtin_amdgcn_kernarg_segment_ptr(); asm volatile("" : "+s"(ap)); F.a = ap; }
    if constexpr (PH == PH_PRO_A) phase_pro_a(F);
    else if constexpr (PH == PH_PRO_B) phase_pro_b(F);
    else if constexpr (PH == PH_PRO_C) phase_pro_c(F);
    else {
        constexpr int l = (PH - PH_L0) / NPH_L, sp = (PH - PH_L0) % NPH_L;
        if constexpr (sp == 0) {
            pg8::Gemm g{WSP(bf16, WS_HMOD), WSP(bf16, WS_WIN) + (size_t)l * NIN * DM, MT, NIN, DM}; pg8::StaticOrder S; S.init(MT, NIN, F.G, F.bid);
            pg8::EpiIn E{WSP(bf16, WS_P), WSP(float, WS_DT)};
            pg8::gemm_phase<pg8::EpiIn, pg8::StaticOrder, true, true>(F.lds, g, S, E);
        } else if constexpr (sp == 1) {
            if (F.bid < 64) { if (F.wave == 0) s5_oracle_job(F, l, F.bid >> 5, F.bid & 31); }
            else {
                F.bid -= 64; F.G -= 64;
                ssd_prep_oracle(F, l);
                for (int j = F.bid; j < 68 * 4; j += F.G) sg_oracle_job(F, l, j >> 2, j & 3);
                for (int j = F.bid; j < 272 * 4; j += F.G) pool_oracle_job(F, l, j >> 2, j & 3);
            }
        } else if constexpr (sp == 2) {
            if (F.bid < 32) ssd_scan_oracle_job(F, l, F.bid >> 4, (F.bid >> 1) & 7, F.bid & 1);
        } else if constexpr (sp == 3) {
            ssd_finish_oracle(F, l);
            pg8::Gemm g{WSP(bf16, WS_Z), WSP(bf16, WS_WGLU) + (size_t)l * GW * GW, MT, GW, GW}; pg8::StaticOrder S; S.init(MT, GW, F.G, F.bid);
            pg8::EpiGlu E{WSP(bf16, WS_Z), WSP(bf16, WS_MIX), F.a->in[I_GLUB] + l * GW};
            pg8::gemm_phase<pg8::EpiGlu, pg8::StaticOrder, true, true>(F.lds, g, S, E);
        } else if constexpr (sp == 4) {
            pg8::Gemm g{WSP(bf16, WS_MIX), WSP(bf16, WS_WOUT) + (size_t)l * DM * DM, MT, DM, DM}; pg8::StaticOrder S; S.init(MT, DM, F.G, F.bid);
            pg8::EpiRes E{WSP(float, WS_H), mvec(F, l, 0, 2), 6 * DM};
            pg8::gemm_phase<pg8::EpiRes, pg8::StaticOrder, true, true>(F.lds, g, S, E);
        } else if constexpr (sp == 5) {
            phase_ln(F, F.a->in[I_LN1G] + l * DM, F.a->in[I_LN1B] + l * DM, l, 3, false);
        } else if constexpr (sp == 6) {
            pg8::Gemm g{WSP(bf16, WS_HMOD), WSP(bf16, WS_WUP) + (size_t)l * FF2 * DM, MT, FF2, DM}; pg8::StaticOrder S; S.init(MT, FF2, F.G, F.bid);
            pg8::EpiStore E{WSP(bf16, WS_GV), FF2};
            pg8::gemm_phase<pg8::EpiStore, pg8::StaticOrder, true, true>(F.lds, g, S, E);
        } else if constexpr (sp == 7) {
            ffn_act_oracle(F, l);
        } else if constexpr (sp == 8) {
            pg8::Gemm g{WSP(bf16, WS_ACT), WSP(bf16, WS_WDN) + (size_t)l * DM * FF, MT, DM, FF}; pg8::StaticOrder S; S.init(MT, DM, F.G, F.bid);
            pg8::EpiRes E{WSP(float, WS_H), mvec(F, l, 0, 5), 6 * DM};
            pg8::gemm_phase<pg8::EpiRes, pg8::StaticOrder, true, true>(F.lds, g, S, E);
        } else {
            constexpr bool fin = (l == DEPTH - 1);
            phase_ln(F, F.a->in[I_LN2G] + l * DM, F.a->in[I_LN2B] + l * DM, fin ? l : l + 1, 0, fin);
        }
    }
}
template <int PH, int HI>
__device__ __forceinline__ void run_range(LAS unsigned char* ldsp) {
    run_phase<PH>(ldsp);
    if constexpr (PH + 1 < HI) { cg::this_grid().sync(); run_range<PH + 1, HI>(ldsp); }
}
template <int LO, int HI>
__global__ void __launch_bounds__(NTHREADS, 2) mk_fwd(Args args) {
    extern __shared__ __attribute__((aligned(16))) unsigned char lds[];
    run_range<LO, HI>((LAS unsigned char*)lds);
}

#ifndef MK_ONE_LAUNCH
#define MK_ONE_LAUNCH 1
#endif
template <int PH> static void launch_phases(const Args& a, int grid, hipStream_t stream) {
    hipFuncSetAttribute((const void*)mk_fwd<PH, PH + 1>, hipFuncAttributeMaxDynamicSharedMemorySize, LDS_BYTES);
    hipLaunchKernelGGL((mk_fwd<PH, PH + 1>), dim3(grid), dim3(NTHREADS), LDS_BYTES, stream, a);
    if constexpr (PH + 1 < N_PHASES) launch_phases<PH + 1>(a, grid, stream);
}

extern "C" void kernel_launch(void* const* d_in, const int* in_sizes, int n_in, void* d_out, int out_size, void* d_ws, size_t ws_size, hipStream_t stream) {
    static int grid = 0;
    if (grid == 0) {
        if (n_in != N_IN || out_size != ML * DM || ws_size < WS_END) { fprintf(stderr, "kernel_launch: unexpected shapes n_in %d out %d ws %zu (need %zu)\n", n_in, out_size, ws_size, (size_t)WS_END); grid = -1; return; }
        int dev = 0, cus = 0;
        (void)hipGetDevice(&dev); (void)hipDeviceGetAttribute(&cus, hipDeviceAttributeMultiprocessorCount, dev);
#if MK_ONE_LAUNCH
        int per_cu = 0;
        if (hipFuncSetAttribute((const void*)mk_fwd<0, N_PHASES>, hipFuncAttributeMaxDynamicSharedMemorySize, LDS_BYTES) != hipSuccess) { fprintf(stderr, "hipFuncSetAttribute failed\n"); grid = -1; return; }
        (void)hipOccupancyMaxActiveBlocksPerMultiprocessor(&per_cu, (const void*)mk_fwd<0, N_PHASES>, NTHREADS, LDS_BYTES);
        (void)hipGetLastError();
        fprintf(stderr, "kernel_launch: cus %d per_cu %d\n", cus, per_cu);
        if (per_cu < 1) { grid = -1; return; }
#endif
        grid = cus;
    }
    if (grid < 0) return;
    Args a{};
    for (int i = 0; i < N_IN; ++i) a.in[i] = (const float*)d_in[i];
    a.out = (float*)d_out; a.ws = (unsigned char*)d_ws;
#if MK_ONE_LAUNCH
    void* kargs[] = {&a};
    hipError_t e = hipLaunchCooperativeKernel((const void*)mk_fwd<0, N_PHASES>, dim3(grid), dim3(NTHREADS), kargs, LDS_BYTES, stream);
    if (e != hipSuccess) fprintf(stderr, "cooperative launch failed: %s\n", hipGetErrorString(e));
#else
    launch_phases<0>(a, grid, stream);
#endif
}
```

```cpp
#include <hip/hip_runtime.h>
#include <hip/hip_cooperative_groups.h>
#include <cstdio>
#include <cstdint>
namespace cg = cooperative_groups;
namespace pg8 {
#define PG8_LAS __attribute__((address_space(3)))
typedef unsigned short bf16_t;
typedef short bf16x8 __attribute__((ext_vector_type(8)));
typedef float f32x4 __attribute__((ext_vector_type(4)));
typedef unsigned u32x4 __attribute__((ext_vector_type(4)));
constexpr int BM = 256, BK = 64, HALF = 128, HTB = HALF * BK * 2  , STAGE_BYTES = 8 * HTB, NXCD = 8, WGM = 8;

__host__ __device__ __forceinline__ int lds_byte(int r, int c) { const int st = (r >> 4) * 2 + (c >> 5), rr = r & 15, cc = c & 31, ob = rr * 64 + cc * 2; return st * 1024 + (ob ^ (((ob >> 9) & 1) << 5)); }
__host__ __device__ __forceinline__ void stage_rc(int b, int& R, int& C) { const int st = b / 1024, sb = b % 1024, swz = sb ^ (((sb >> 9) & 1) << 5); R = (st >> 1) * 16 + swz / 64; C = (st & 1) * 32 + (swz % 64) / 2; }
__host__ __device__ __forceinline__ int perm32(int rho) { const int n = rho >> 4, i = rho & 15; return 8 * (i >> 2) + 4 * n + (i & 3); }

struct Unit { int pm, pn; };
struct Gemm { const bf16_t* A; const bf16_t* Bt; int M, N, K; };

struct StaticOrder {
    int nM, nN, nwg, G, c;
    __host__ __device__ void init(int M, int N, int G_, int c_) { nM = M / BM; nN = N / BM; nwg = nM * nN; G = G_; c = c_; }
    __host__ __device__ bool next(int i, Unit& u) const {
        const long L = (long)i * G + c; if (L >= nwg) return false;
        int wgid = (int)L; { const int q = nwg / NXCD, r = nwg % NXCD, xcd = wgid % NXCD, off = wgid / NXCD; wgid = (xcd < r ? xcd * (q + 1) : r * (q + 1) + (xcd - r) * q) + off; }
        const int nig = WGM * nN, gid = wgid / nig, fm = gid * WGM, gsz = (nM - fm) < WGM ? (nM - fm) : WGM;
        u.pm = fm + ((wgid % nig) % gsz); u.pn = (wgid % nig) / gsz; return true;
    }
    __device__ __forceinline__ void a_ready(const Unit&) const {}
    __device__ __forceinline__ void done(const Unit&) const {}
};

__device__ __forceinline__ unsigned cvt_pk_bf16(float lo, float hi) { unsigned r; asm volatile("v_cvt_pk_bf16_f32 %0, %1, %2" : "=v"(r) : "v"(lo), "v"(hi)); return r; }
typedef float f32x2 __attribute__((ext_vector_type(2)));

template <class Epi, class Sched, bool ALIGN_EPI = false, bool SP2 = false>
__device__ __forceinline__ void gemm_phase(PG8_LAS unsigned char* lds, const Gemm g, const Sched& S, const Epi& E) {
    const int tid = threadIdx.x, wid = __builtin_amdgcn_readfirstlane(tid >> 6), lane = tid & 63, wr = wid >> 2, wc = wid & 3, fr = lane & 15, fq = lane >> 4;
    const int K = g.K, nt = K / BK;
    unsigned voffA[2], voffB[2];
#pragma unroll
    for (int i = 0; i < 2; ++i) { int R, C; stage_rc(tid * 16 + i * 8192, R, C); const int Rb = Epi::PERM ? ((R & ~31) + perm32(R & 31)) : R;
        voffA[i] = (unsigned)(R * K + C) * 2u; voffB[i] = (unsigned)(Rb * K + C) * 2u; }
    const size_t kstep = (size_t)(BK * 2);
    const size_t hstep = (size_t)HALF * K * 2;
    const size_t tstep = 2 * hstep;
    const unsigned ldsw = (unsigned)wid * 1024u;
    const int aoff = lds_byte(wr * 64 + fr, fq * 8), boff = lds_byte(wc * 32 + fr, fq * 8);
#define PG8_SA(b, h) (((b) * 2 + (h)) * HTB)
#define PG8_SB(b, h) ((4 + (b) * 2 + (h)) * HTB)
#define PG8_STAGE(bufoff, gbase, voff) do { _Pragma("unroll") for (int _i = 0; _i < 2; ++_i) \
        __builtin_amdgcn_global_load_lds((const unsigned*)((const char*)(gbase) + (voff)[_i]), (PG8_LAS unsigned*)(lds + (bufoff) + ldsw + _i * 8192), 16, 0, 0); } while (0)
#define PG8_LDA(dst, b, h) do { _Pragma("unroll") for (int m = 0; m < 4; ++m) _Pragma("unroll") for (int k = 0; k < 2; ++k) dst[m][k] = *(const PG8_LAS bf16x8*)(lds + PG8_SA(b, h) + aoff + m * 2048 + k * 1024); } while (0)
#define PG8_LDB(dst, b, h) do { _Pragma("unroll") for (int n = 0; n < 2; ++n) _Pragma("unroll") for (int k = 0; k < 2; ++k) dst[n][k] = *(const PG8_LAS bf16x8*)(lds + PG8_SB(b, h) + boff + n * 2048 + k * 1024); } while (0)
#define PG8_MMA(ai, bj, At, Bt) do { __builtin_amdgcn_s_setprio(1); _Pragma("unroll") for (int m = 0; m < 4; ++m) _Pragma("unroll") for (int n = 0; n < 2; ++n) _Pragma("unroll") for (int k = 0; k < 2; ++k) \
        acc[ai][bj][m][n] = __builtin_amdgcn_mfma_f32_16x16x32_bf16(Bt[n][k], At[m][k], acc[ai][bj][m][n], 0, 0, 0); __builtin_amdgcn_s_setprio(0); } while (0)
#define PG8_WAIT_V(n) asm volatile("s_waitcnt vmcnt(" #n ")" ::: "memory")
#define PG8_WAIT_L(n) asm volatile("s_waitcnt lgkmcnt(" #n ")" ::: "memory")
#define PG8_BAR __builtin_amdgcn_s_barrier()
#define PG8_SCHED __builtin_amdgcn_sched_barrier(0)
    Unit cur, nxt; int ui = 0;
    if (!S.next(0, cur)) return;
    f32x4 acc[2][2][4][2];
#pragma unroll
    for (int a = 0; a < 2; ++a)
#pragma unroll
        for (int b = 0; b < 2; ++b)
#pragma unroll
            for (int m = 0; m < 4; ++m)
#pragma unroll
                for (int n = 0; n < 2; ++n) acc[a][b][m][n] = (f32x4){0.f, 0.f, 0.f, 0.f};
    bf16x8 At[4][2], B0[2][2], B1[2][2];
    const char* cA = (const char*)g.A + (size_t)cur.pm * tstep; const char* cB = (const char*)g.Bt + (size_t)cur.pn * tstep;
    S.a_ready(cur);
    if constexpr (SP2) {
        PG8_STAGE(PG8_SB(0, 0), cB, voffB); PG8_STAGE(PG8_SB(0, 1), cB + hstep, voffB); PG8_STAGE(PG8_SA(0, 0), cA, voffA); PG8_STAGE(PG8_SA(0, 1), cA + hstep, voffA);
        if (wr == 1) PG8_BAR;
        PG8_WAIT_V(2); PG8_BAR;
        PG8_STAGE(PG8_SB(1, 0), cB + kstep, voffB); PG8_STAGE(PG8_SA(1, 0), cA + kstep, voffA); PG8_STAGE(PG8_SB(1, 1), cB + hstep + kstep, voffB);
        PG8_WAIT_V(6); PG8_BAR;
    } else {
        PG8_STAGE(PG8_SB(0, 0), cB, voffB); PG8_STAGE(PG8_SA(0, 0), cA, voffA); PG8_STAGE(PG8_SB(0, 1), cB + hstep, voffB); PG8_STAGE(PG8_SA(0, 1), cA + hstep, voffA);
        if (wr == 1) PG8_BAR;
        PG8_WAIT_V(4); PG8_BAR;
        PG8_STAGE(PG8_SB(1, 0), cB + kstep, voffB); PG8_STAGE(PG8_SA(1, 0), cA + kstep, voffA); PG8_STAGE(PG8_SB(1, 1), cB + hstep + kstep, voffB);
        PG8_WAIT_V(6); PG8_BAR;
    }
    for (;;) {
        const bool has_next = S.next(ui + 1, nxt);
        const char* nA = has_next ? (const char*)g.A + (size_t)nxt.pm * tstep : cA; const char* nB = has_next ? (const char*)g.Bt + (size_t)nxt.pn * tstep : cB;
        for (int t = 0; t < nt; t += 2) {
            const bool last = (t == nt - 2);
            const char* a1 = cA + (size_t)(t + 1) * kstep;
            const char* a2 = last ? nA : cA + (size_t)(t + 2) * kstep; const char* b2 = last ? nB : cB + (size_t)(t + 2) * kstep;
            const char* a3 = a2 + kstep; const char* b3 = b2 + kstep;
            if (last && has_next) S.a_ready(nxt);
            if constexpr (SP2) {
            PG8_LDB(B0, 0, 0); PG8_LDB(B1, 0, 1); PG8_SCHED; PG8_LDA(At, 0, 0); PG8_STAGE(PG8_SA(1, 1), a1 + hstep, voffA);
            PG8_WAIT_V(8); PG8_WAIT_L(0); PG8_BAR; PG8_MMA(0, 0, At, B0); PG8_MMA(0, 1, At, B1); PG8_BAR; PG8_SCHED;
            PG8_LDA(At, 0, 1); PG8_STAGE(PG8_SB(0, 0), b2, voffB); PG8_STAGE(PG8_SB(0, 1), b2 + hstep, voffB); PG8_STAGE(PG8_SA(0, 0), a2, voffA);
            PG8_WAIT_V(8); PG8_WAIT_L(0); PG8_BAR; PG8_MMA(1, 0, At, B0); PG8_MMA(1, 1, At, B1); PG8_BAR; PG8_SCHED;
            PG8_LDB(B0, 1, 0); PG8_LDB(B1, 1, 1); PG8_SCHED; PG8_LDA(At, 1, 0); PG8_STAGE(PG8_SA(0, 1), a2 + hstep, voffA);
            PG8_WAIT_V(8); PG8_WAIT_L(0); PG8_BAR; PG8_MMA(0, 0, At, B0); PG8_MMA(0, 1, At, B1); PG8_BAR; PG8_SCHED;
            PG8_LDA(At, 1, 1); PG8_STAGE(PG8_SB(1, 0), b3, voffB); PG8_STAGE(PG8_SB(1, 1), b3 + hstep, voffB); PG8_STAGE(PG8_SA(1, 0), a3, voffA);
            PG8_WAIT_V(8); PG8_WAIT_L(0); PG8_BAR; PG8_MMA(1, 0, At, B0); PG8_MMA(1, 1, At, B1); PG8_BAR; PG8_SCHED;
            } else {
            PG8_LDB(B0, 0, 0); PG8_SCHED; PG8_LDA(At, 0, 0); PG8_STAGE(PG8_SA(1, 1), a1 + hstep, voffA);
            PG8_WAIT_L(8); PG8_BAR; PG8_WAIT_L(0); PG8_MMA(0, 0, At, B0); PG8_BAR; PG8_SCHED;
            PG8_LDB(B1, 0, 1); PG8_STAGE(PG8_SB(0, 0), b2, voffB);
            PG8_BAR; PG8_WAIT_L(0); PG8_MMA(0, 1, At, B1); PG8_BAR;
            PG8_LDA(At, 0, 1); PG8_STAGE(PG8_SA(0, 0), a2, voffA);
            PG8_BAR; PG8_WAIT_L(0); PG8_MMA(1, 0, At, B0); PG8_BAR; PG8_SCHED;
            PG8_STAGE(PG8_SB(0, 1), b2 + hstep, voffB);
            PG8_WAIT_V(6); PG8_BAR; PG8_MMA(1, 1, At, B1); PG8_BAR;
            PG8_LDB(B0, 1, 0); PG8_SCHED; PG8_LDA(At, 1, 0); PG8_STAGE(PG8_SA(0, 1), a2 + hstep, voffA);
            PG8_WAIT_L(8); PG8_BAR; PG8_WAIT_L(0); PG8_MMA(0, 0, At, B0); PG8_BAR; PG8_SCHED;
            PG8_LDB(B1, 1, 1); PG8_STAGE(PG8_SB(1, 0), b3, voffB);
            PG8_BAR; PG8_WAIT_L(0); PG8_MMA(0, 1, At, B1); PG8_BAR;
            PG8_LDA(At, 1, 1); PG8_STAGE(PG8_SA(1, 0), a3, voffA);
            PG8_BAR; PG8_WAIT_L(0); PG8_MMA(1, 0, At, B0); PG8_BAR; PG8_SCHED;
            PG8_STAGE(PG8_SB(1, 1), b3 + hstep, voffB);
            PG8_WAIT_V(6); PG8_BAR; PG8_MMA(1, 1, At, B1); PG8_BAR;
            }
        }
        if constexpr (ALIGN_EPI) { if (wr == 0) PG8_BAR; }
        if constexpr (!Epi::AFTER_DRAIN) { E(acc, cur, wr, wc, fr, fq); S.done(cur); }
        if (!has_next) break;
#pragma unroll
        for (int a = 0; a < 2; ++a)
#pragma unroll
            for (int b = 0; b < 2; ++b)
#pragma unroll
                for (int m = 0; m < 4; ++m)
#pragma unroll
                    for (int n = 0; n < 2; ++n) acc[a][b][m][n] = (f32x4){0.f, 0.f, 0.f, 0.f};
        cur = nxt; cA = nA; cB = nB; ++ui;
        if constexpr (ALIGN_EPI) { if (wr == 1) PG8_BAR; }
    }
    PG8_WAIT_V(0);
    if constexpr (!ALIGN_EPI) { if (wr == 0) PG8_BAR; }
    PG8_BAR;
    if constexpr (Epi::AFTER_DRAIN) { E.fused(acc, cur, wr, wc, fr, fq, lds, wid, lane); S.done(cur); }
#undef PG8_SA
#undef PG8_SB
#undef PG8_STAGE
#undef PG8_LDA
#undef PG8_LDB
#undef PG8_MMA
#undef PG8_WAIT_V
#undef PG8_WAIT_L
#undef PG8_BAR
#undef PG8_SCHED
}
}


constexpr int DM = 2048, NB = 2, SEQL = 4096, CTXL = 256, DEPTH = 2;
constexpr int ML = NB * SEQL, MC = NB * CTXL, MT = ML + MC;
constexpr int NIN = 3840, NINR = 3600;
constexpr int FF = 5632, FF2 = 11264;
constexpr int GW = 512;
constexpr float ALPHA = 1.4142135623730951f;
constexpr float LN_EPS = 1e-5f, RMS_EPS = 1e-5f;
constexpr int ADA_KS = 16;
constexpr int PC_S5 = 0, PC_SGU = 512, PC_SGV = 1024, PC_POOL = 1536, PC_Z = 2048, PC_XBC = 2560, PC_DT = 3584;
constexpr int MX_S5 = 0, MX_SG = 512, MX_POOL = 1024, MX_SSD = 1536;

enum { I_X = 0, I_C, I_CTX, I_CCTX, I_WADA, I_BADA, I_WIN, I_WOUT, I_LN1G, I_LN1B, I_LN2G, I_LN2B,
       I_S5ARE, I_S5AIM, I_S5BRE, I_S5BIM, I_S5CRE, I_S5CIM, I_S5LS, I_S5D, I_GLUW, I_GLUB,
       I_SGLNG, I_SGLNB, I_SGW, I_SGB, I_POOLW, I_POOLB, I_POOLS,
       I_M2CW, I_M2CB, I_M2DTB, I_M2ALOG, I_M2D, I_M2NW,
       I_WUP, I_FCW, I_FCB, I_WDN, N_IN };

constexpr size_t MiB = 1u << 20;
constexpr size_t WS_CTL = 0;
constexpr size_t WS_MADA = 1 * MiB;
constexpr size_t WS_MPART = 2 * MiB;
constexpr size_t WS_WIN = 8 * MiB;
constexpr size_t WS_WOUT = 40 * MiB;
constexpr size_t WS_WUP = 56 * MiB;
constexpr size_t WS_WDN = 144 * MiB;
constexpr size_t WS_WGLU = 188 * MiB;
constexpr size_t WS_H = 190 * MiB;
constexpr size_t WS_HMOD = 258 * MiB;
constexpr size_t WS_P = 292 * MiB;
constexpr size_t WS_DT = 356 * MiB;
constexpr size_t WS_DTS = 357 * MiB;
constexpr size_t WS_MIX = 358 * MiB;
constexpr size_t WS_Z = 392 * MiB;
constexpr size_t WS_Y5 = 401 * MiB;
constexpr size_t WS_XC = 418 * MiB;
constexpr size_t WS_YD = 452 * MiB;
constexpr size_t WS_GV = 486 * MiB;
constexpr size_t WS_ACT = WS_P;
constexpr size_t WS_S5KT = 673 * MiB;
constexpr size_t WS_S5WS = 676 * MiB;
constexpr size_t WS_S5WC = 692 * MiB;
constexpr size_t WS_S5AQ = 708 * MiB;
constexpr size_t WS_S5S = WS_Y5;
constexpr size_t WS_S5HIN = WS_Y5 + 10 * MiB;
constexpr size_t WS_SST = 709 * MiB;
constexpr size_t WS_SHIN = 743 * MiB;
constexpr size_t WS_SDEC = 760 * MiB;
constexpr size_t WS_END = 767 * MiB;
constexpr int S5Q = 32, S5NCH = MT / S5Q;

constexpr int NWAVES = 8, NTHREADS = 512;
constexpr int LDS_BYTES = 163840;

#define GAS __attribute__((address_space(1)))
#define LAS __attribute__((address_space(3)))
typedef unsigned short bf16;
typedef unsigned v4u __attribute__((ext_vector_type(4)));
typedef unsigned v2u __attribute__((ext_vector_type(2)));
typedef float f32x4 __attribute__((ext_vector_type(4)));

__device__ __forceinline__ unsigned f2bf(float f) { unsigned u = __builtin_bit_cast(unsigned, f); return (u + 0x7fffu + ((u >> 16) & 1u)) >> 16; }
__device__ __forceinline__ unsigned pk2(float lo, float hi) { return f2bf(lo) | (f2bf(hi) << 16); }
__device__ __forceinline__ float bf2f(unsigned short h) { return __builtin_bit_cast(float, (unsigned)h << 16); }
__device__ __forceinline__ float bflo(unsigned w) { return __builtin_bit_cast(float, w << 16); }
__device__ __forceinline__ float bfhi(unsigned w) { return __builtin_bit_cast(float, w & 0xffff0000u); }
__device__ __forceinline__ float sigmoidf_(float x) { return 1.f / (1.f + __expf(-x)); }
__device__ __forceinline__ float siluf_(float x) { return x * sigmoidf_(x); }
__device__ __forceinline__ float gelu_tanh(float x) {
    const float u = 0.7978845608028654f * (x + 0.044715f * x * x * x);
    const float t = 1.f - 2.f / (1.f + __expf(2.f * u));
    return 0.5f * x * (1.f + t);
}
__device__ __forceinline__ float softplusf_(float x) { return x > 20.f ? x : log1pf(expf(x)); }
__device__ __forceinline__ float wave_sum(float v) {
#pragma unroll
    for (int o = 1; o < 64; o <<= 1) v += __shfl_xor(v, o);
    return v;
}

namespace pg8 {
struct EpiIn {
    static constexpr bool PERM = true, AFTER_DRAIN = false;
    bf16_t* P; float* DT;
    __device__ __forceinline__ void operator()(const f32x4 (&acc)[2][2][4][2], const Unit& u, int wr, int wc, int fr, int fq) const {
        const int row0 = u.pm * BM + wr * 64 + fr;
        if (u.pn == 14) {
            if (wc == 0 && fq < 2) {
#pragma unroll
                for (int ai = 0; ai < 2; ++ai)
#pragma unroll
                    for (int m = 0; m < 4; ++m) { float* d = DT + (size_t)(row0 + ai * HALF + m * 16) * 16 + 8 * fq;
                        *(f32x4*)(d) = acc[ai][0][m][0]; *(f32x4*)(d + 4) = acc[ai][0][m][1]; }
            }
            return;
        }
        const int col0 = u.pn * BM + wc * 32 + 8 * fq;
#pragma unroll
        for (int ai = 0; ai < 2; ++ai)
#pragma unroll
            for (int m = 0; m < 4; ++m) { bf16_t* rowp = P + (size_t)(row0 + ai * HALF + m * 16) * NIN + col0;
#pragma unroll
                for (int bj = 0; bj < 2; ++bj) { const f32x4 v0 = acc[ai][bj][m][0], v1 = acc[ai][bj][m][1];
                    u32x4 w; w.x = cvt_pk_bf16(v0[0], v0[1]); w.y = cvt_pk_bf16(v0[2], v0[3]); w.z = cvt_pk_bf16(v1[0], v1[1]); w.w = cvt_pk_bf16(v1[2], v1[3]);
                    *(u32x4*)(rowp + bj * HALF) = w; } }
    }
};
struct EpiStore {
    static constexpr bool PERM = true, AFTER_DRAIN = false;
    bf16_t* O; int ldc;
    __device__ __forceinline__ void operator()(const f32x4 (&acc)[2][2][4][2], const Unit& u, int wr, int wc, int fr, int fq) const {
        const int row0 = u.pm * BM + wr * 64 + fr, col0 = u.pn * BM + wc * 32 + 8 * fq;
#pragma unroll
        for (int ai = 0; ai < 2; ++ai)
#pragma unroll
            for (int m = 0; m < 4; ++m) { bf16_t* rowp = O + (size_t)(row0 + ai * HALF + m * 16) * ldc + col0;
#pragma unroll
                for (int bj = 0; bj < 2; ++bj) { const f32x4 v0 = acc[ai][bj][m][0], v1 = acc[ai][bj][m][1];
                    u32x4 w; w.x = cvt_pk_bf16(v0[0], v0[1]); w.y = cvt_pk_bf16(v0[2], v0[3]); w.z = cvt_pk_bf16(v1[0], v1[1]); w.w = cvt_pk_bf16(v1[2], v1[3]);
                    *(u32x4*)(rowp + bj * HALF) = w; } }
    }
};
struct EpiGlu {
    static constexpr bool PERM = true, AFTER_DRAIN = false;
    const bf16_t* Z; bf16_t* O; const float* bias;
    __device__ __forceinline__ void operator()(const f32x4 (&acc)[2][2][4][2], const Unit& u, int wr, int wc, int fr, int fq) const {
        const int row0 = u.pm * BM + wr * 64 + fr, col0 = u.pn * BM + wc * 32 + 8 * fq;
#pragma unroll
        for (int ai = 0; ai < 2; ++ai)
#pragma unroll
            for (int m = 0; m < 4; ++m) { const int row = row0 + ai * HALF + m * 16;
#pragma unroll
                for (int bj = 0; bj < 2; ++bj) { const int col = col0 + bj * HALF;
                    const u32x4 zz = *(const u32x4*)(Z + (size_t)row * GW + col);
                    const f32x4 b0 = *(const f32x4*)(bias + col), b1 = *(const f32x4*)(bias + col + 4);
                    const f32x4 v0 = acc[ai][bj][m][0] + b0, v1 = acc[ai][bj][m][1] + b1;
                    float o[8];
                    o[0] = bflo(zz.x) * sigmoidf_(v0[0]); o[1] = bfhi(zz.x) * sigmoidf_(v0[1]); o[2] = bflo(zz.y) * sigmoidf_(v0[2]); o[3] = bfhi(zz.y) * sigmoidf_(v0[3]);
                    o[4] = bflo(zz.z) * sigmoidf_(v1[0]); o[5] = bfhi(zz.z) * sigmoidf_(v1[1]); o[6] = bflo(zz.w) * sigmoidf_(v1[2]); o[7] = bfhi(zz.w) * sigmoidf_(v1[3]);
                    u32x4 w; w.x = cvt_pk_bf16(o[0], o[1]); w.y = cvt_pk_bf16(o[2], o[3]); w.z = cvt_pk_bf16(o[4], o[5]); w.w = cvt_pk_bf16(o[6], o[7]);
                    *(u32x4*)(O + (size_t)row * DM + col) = w; } }
    }
};
struct EpiRes {
    static constexpr bool PERM = false, AFTER_DRAIN = false;
    float* H; const float* gate; int vstride;
    __device__ __forceinline__ void operator()(const f32x4 (&acc)[2][2][4][2], const Unit& u, int wr, int wc, int fr, int fq) const {
        const int row0 = u.pm * BM + wr * 64 + fr, col0 = u.pn * BM + wc * 32 + 4 * fq;
        const int var = u.pm < 16 ? 0 : (u.pm < 32 ? 1 : 2);
        const float* gv = gate + (size_t)var * vstride;
#pragma unroll
        for (int bj = 0; bj < 2; ++bj)
#pragma unroll
            for (int n = 0; n < 2; ++n) { const int col = col0 + bj * HALF + n * 16; const f32x4 g4 = *(const f32x4*)(gv + col);
#pragma unroll
                for (int ai = 0; ai < 2; ++ai)
#pragma unroll
                    for (int m = 0; m < 4; ++m) { float* p = H + (size_t)(row0 + ai * HALF + m * 16) * DM + col;
                        const f32x4 hv = *(const f32x4*)p; *(f32x4*)p = hv * ALPHA + g4 * acc[ai][bj][m][n]; } }
    }
};
}

struct Args { const float* in[N_IN]; float* out; unsigned char* ws; };

struct Frame {
    LAS unsigned char* lds;
    int tid, lane, wave, bid, G;
    const __attribute__((address_space(4))) Args* a;
};
#define WSP(T, off) ((T*)(F.a->ws + (off)))

__device__ __forceinline__ void row_seq(int row, int& base, int& t, int& len) {
    if (row < ML) { base = row & ~(SEQL - 1); t = row & (SEQL - 1); len = SEQL; }
    else { base = ML + ((row - ML) & ~(CTXL - 1)); t = (row - ML) & (CTXL - 1); len = CTXL; }
}
__device__ __forceinline__ int proc_row(int q, int dir, int b) {
    if (q < CTXL) { const int t = dir ? (CTXL - 1 - q) : q; return ML + b * CTXL + t; }
    const int ql = q - CTXL; const int t = dir ? (SEQL - 1 - ql) : ql; return b * SEQL + t;
}

__device__ __forceinline__ void transpose_item(const float* W, int K, int N, bf16* WT, LAS float* scr, int item, int nblk, int lane) {
    const int kb = item / nblk, nb = item % nblk, k0 = 64 * kb, n0 = 32 * nb;
    const int nn = n0 + (lane & 31);
#pragma unroll 8
    for (int i = 0; i < 32; ++i) { const int kk = 2 * i + (lane >> 5); scr[kk * 33 + (lane & 31)] = (nn < N) ? W[(size_t)(k0 + kk) * N + nn] : 0.f; }
    asm volatile("s_waitcnt lgkmcnt(0)" ::: "memory");
    const int c = lane & 7;
#pragma unroll
    for (int j = 0; j < 4; ++j) { const int n = (lane >> 3) + 8 * j; const LAS float* s = scr + (8 * c) * 33 + n;
        v4u o; o.x = pk2(s[0 * 33], s[1 * 33]); o.y = pk2(s[2 * 33], s[3 * 33]); o.z = pk2(s[4 * 33], s[5 * 33]); o.w = pk2(s[6 * 33], s[7 * 33]);
        *(v4u*)(WT + (size_t)(n0 + n) * K + k0 + 8 * c) = o; }
    asm volatile("s_waitcnt lgkmcnt(0)" ::: "memory");
}

__device__ __forceinline__ void phase_pro_a(Frame& F) {
    LAS float* scr = (LAS float*)(F.lds + F.wave * 16384);
    const int gw = F.bid * NWAVES + F.wave, NGW = F.G * NWAVES;
    constexpr int I_IN = (DM / 64) * (NIN / 32), I_OUT = (DM / 64) * (DM / 32), I_UP = (DM / 64) * (FF2 / 32), I_DN = (FF / 64) * (DM / 32), I_GL = (GW / 64) * (GW / 32);
    constexpr int PER_L = I_IN + I_OUT + I_UP + I_DN + I_GL;
    for (int it = gw; it < DEPTH * PER_L; it += NGW) {
        const int l = it / PER_L; int r = it % PER_L;
        if (r < I_IN) { transpose_item(F.a->in[I_WIN] + (size_t)l * DM * NINR, DM, NINR, WSP(bf16, WS_WIN) + (size_t)l * NIN * DM, scr, r, NIN / 32, F.lane); continue; } r -= I_IN;
        if (r < I_OUT) { transpose_item(F.a->in[I_WOUT] + (size_t)l * DM * DM, DM, DM, WSP(bf16, WS_WOUT) + (size_t)l * DM * DM, scr, r, DM / 32, F.lane); continue; } r -= I_OUT;
        if (r < I_UP) { transpose_item(F.a->in[I_WUP] + (size_t)l * DM * FF2, DM, FF2, WSP(bf16, WS_WUP) + (size_t)l * FF2 * DM, scr, r, FF2 / 32, F.lane); continue; } r -= I_UP;
        if (r < I_DN) { transpose_item(F.a->in[I_WDN] + (size_t)l * FF * DM, FF, DM, WSP(bf16, WS_WDN) + (size_t)l * DM * FF, scr, r, DM / 32, F.lane); continue; } r -= I_DN;
        transpose_item(F.a->in[I_GLUW] + (size_t)l * GW * GW, GW, GW, WSP(bf16, WS_WGLU) + (size_t)l * GW * GW, scr, r, GW / 32, F.lane);
    }
    constexpr int NCB = 6 * DM / 256, KSL = DM / ADA_KS;
    const float* c = F.a->in[I_C]; const float* cc = F.a->in[I_CCTX];
    for (int job = gw; job < DEPTH * NCB * ADA_KS; job += NGW) {
        const int l = job / (NCB * ADA_KS), r = job % (NCB * ADA_KS), cb = r / ADA_KS, ks = r % ADA_KS;
        const float* W = F.a->in[I_WADA] + (size_t)l * DM * 6 * DM + cb * 256 + F.lane * 4;
        f32x4 a0 = {0.f, 0.f, 0.f, 0.f}, a1 = a0, a2 = a0;
#pragma unroll 4
        for (int k = ks * KSL; k < (ks + 1) * KSL; ++k) {
            const f32x4 w = *(const f32x4*)(W + (size_t)k * 6 * DM);
            const float s0 = siluf_(c[k]), s1 = siluf_(c[DM + k]), s2 = siluf_(cc[k]);
            a0 += w * s0; a1 += w * s1; a2 += w * s2;
        }
        float* mp = WSP(float, WS_MPART) + ((size_t)(l * ADA_KS + ks) * 3) * 6 * DM + cb * 256 + F.lane * 4;
        *(f32x4*)(mp) = a0; *(f32x4*)(mp + 6 * DM) = a1; *(f32x4*)(mp + 2 * 6 * DM) = a2;
    }
}

__device__ __forceinline__ void phase_pro_b(Frame& F) {
    const int gt = F.bid * NTHREADS + F.tid, NGT = F.G * NTHREADS;
    for (int i = gt; i < DEPTH * 3 * 6 * DM; i += NGT) {
        const int l = i / (3 * 6 * DM), r = i % (3 * 6 * DM), v = r / (6 * DM), n = r % (6 * DM);
        float s = F.a->in[I_BADA][l * 6 * DM + n];
        const float* mp = WSP(float, WS_MPART) + ((size_t)(l * ADA_KS) * 3 + v) * 6 * DM + n;
#pragma unroll
        for (int ks = 0; ks < ADA_KS; ++ks) s += mp[(size_t)ks * 3 * 6 * DM];
        WSP(float, WS_MADA)[i] = s;
    }
}
__device__ __forceinline__ const float* mvec(Frame& F, int l, int v, int j) { return WSP(float, WS_MADA) + ((size_t)(l * 3 + v) * 6 + j) * DM; }
__device__ __forceinline__ int row_var(int row) { return row < SEQL ? 0 : (row < ML ? 1 : 2); }

template <bool DO_LN>
__device__ __forceinline__ void row_pass(Frame& F, const float* srcrow, const float* g, const float* b, float* dstrow, bf16* modrow, const float* shift, const float* scale) {
    f32x4 v[8];
#pragma unroll
    for (int j = 0; j < 8; ++j) v[j] = *(const f32x4*)(srcrow + j * 256 + F.lane * 4);
    if (DO_LN) {
        float s = 0.f;
#pragma unroll
        for (int j = 0; j < 8; ++j) s += (v[j][0] + v[j][1]) + (v[j][2] + v[j][3]);
        const float mean = wave_sum(s) * (1.f / DM); float s2 = 0.f;
#pragma unroll
        for (int j = 0; j < 8; ++j) { v[j] = v[j] - mean; s2 += (v[j][0] * v[j][0] + v[j][1] * v[j][1]) + (v[j][2] * v[j][2] + v[j][3] * v[j][3]); }
        const float rstd = 1.f / sqrtf(wave_sum(s2) * (1.f / DM) + LN_EPS);
#pragma unroll
        for (int j = 0; j < 8; ++j) { const f32x4 gg = *(const f32x4*)(g + j * 256 + F.lane * 4), bb = *(const f32x4*)(b + j * 256 + F.lane * 4); v[j] = v[j] * rstd * gg + bb; }
    }
    if (dstrow) {
#pragma unroll
        for (int j = 0; j < 8; ++j) *(f32x4*)(dstrow + j * 256 + F.lane * 4) = v[j];
    }
    if (modrow) {
#pragma unroll
        for (int j = 0; j < 8; ++j) { const f32x4 sh = *(const f32x4*)(shift + j * 256 + F.lane * 4), sc = *(const f32x4*)(scale + j * 256 + F.lane * 4);
            const f32x4 o = v[j] * (sc + 1.f) + sh; v2u w; w.x = pk2(o[0], o[1]); w.y = pk2(o[2], o[3]);
            *(v2u*)(modrow + j * 256 + F.lane * 4) = w; }
    }
}
__device__ __forceinline__ void phase_pro_c(Frame& F) {
    const int gw = F.bid * NWAVES + F.wave, NGW = F.G * NWAVES;
    for (int row = gw; row < MT; row += NGW) {
        const float* src = row < ML ? F.a->in[I_X] + (size_t)row * DM : F.a->in[I_CTX] + (size_t)(row - ML) * DM;
        const int v = row_var(row);
        row_pass<false>(F, src, nullptr, nullptr, WSP(float, WS_H) + (size_t)row * DM, WSP(bf16, WS_HMOD) + (size_t)row * DM, mvec(F, 0, v, 0), mvec(F, 0, v, 1));
    }
}
__device__ __forceinline__ void phase_ln(Frame& F, const float* g, const float* b, int ml, int js, bool final_out) {
    const int gw = F.bid * NWAVES + F.wave, NGW = F.G * NWAVES;
    const int nrows = final_out ? ML : MT;
    for (int row = gw; row < nrows; row += NGW) {
        const int v = row_var(row);
        float* hrow = WSP(float, WS_H) + (size_t)row * DM;
        if (final_out) row_pass<true>(F, hrow, g, b, F.a->out + (size_t)row * DM, nullptr, nullptr, nullptr);
        else row_pass<true>(F, hrow, g, b, hrow, WSP(bf16, WS_HMOD) + (size_t)row * DM, mvec(F, ml, v, js), mvec(F, ml, v, js + 1));
    }
}

__device__ __forceinline__ void s5_oracle_job(Frame& F, int l, int b, int g) {
    LAS float* hb = (LAS float*)(F.lds);
    LAS float* cs = (LAS float*)(F.lds + 8192);
    const int p = F.lane;
    const bf16* P = WSP(bf16, WS_P);
    float* Y5 = WSP(float, WS_Y5); bf16* Z = WSP(bf16, WS_Z);
    for (int dir = 0; dir < 2; ++dir) {
        const int gi = (l * 2 + dir) * 32 + g;
        const float ar = F.a->in[I_S5ARE][gi * 64 + p], ai = F.a->in[I_S5AIM][gi * 64 + p];
        const float step = expf(F.a->in[I_S5LS][gi]);
        const float e = expf(ar * step); float sn, cn; sincosf(ai * step, &sn, &cn);
        const float abr = e * cn, abi = e * sn;
        const float den = ar * ar + ai * ai;
        const float qr = ((abr - 1.f) * ar + abi * ai) / den, qi = (abi * ar - (abr - 1.f) * ai) / den;
        float bbr[16], bbi[16];
#pragma unroll
        for (int h = 0; h < 16; ++h) { const float br = F.a->in[I_S5BRE][(size_t)(gi * 64 + p) * 16 + h], bi = F.a->in[I_S5BIM][(size_t)(gi * 64 + p) * 16 + h];
            bbr[h] = qr * br - qi * bi; bbi[h] = qr * bi + qi * br; }
        asm volatile("s_waitcnt lgkmcnt(0)" ::: "memory");
#pragma unroll
        for (int ho = 0; ho < 16; ++ho) { cs[(ho * 64 + p) * 2] = F.a->in[I_S5CRE][(size_t)(gi * 16 + ho) * 64 + p]; cs[(ho * 64 + p) * 2 + 1] = F.a->in[I_S5CIM][(size_t)(gi * 16 + ho) * 64 + p]; }
        float hr = 0.f, hi = 0.f;
        for (int blk = 0; blk < (CTXL + SEQL) / 16; ++blk) {
            for (int i = 0; i < 16; ++i) {
                const int row = proc_row(blk * 16 + i, dir, b);
                const v4u u0 = *(const v4u*)(P + (size_t)row * NIN + PC_S5 + g * 16), u1 = *(const v4u*)(P + (size_t)row * NIN + PC_S5 + g * 16 + 8);
                float u[16];
                u[0] = bflo(u0.x); u[1] = bfhi(u0.x); u[2] = bflo(u0.y); u[3] = bfhi(u0.y); u[4] = bflo(u0.z); u[5] = bfhi(u0.z); u[6] = bflo(u0.w); u[7] = bfhi(u0.w);
                u[8] = bflo(u1.x); u[9] = bfhi(u1.x); u[10] = bflo(u1.y); u[11] = bfhi(u1.y); u[12] = bflo(u1.z); u[13] = bfhi(u1.z); u[14] = bflo(u1.w); u[15] = bfhi(u1.w);
                float bur = 0.f, bui = 0.f;
#pragma unroll
                for (int h = 0; h < 16; ++h) { bur += bbr[h] * u[h]; bui += bbi[h] * u[h]; }
                const float nr = abr * hr - abi * hi + bur, ni = abr * hi + abi * hr + bui;
                hr = nr; hi = ni;
                hb[(i * 64 + p) * 2] = hr; hb[(i * 64 + p) * 2 + 1] = hi;
            }
            asm volatile("s_waitcnt lgkmcnt(0)" ::: "memory");
            {
                const int i = F.lane >> 2, ho4 = (F.lane & 3) * 4;
                float y[4] = {0.f, 0.f, 0.f, 0.f};
                for (int pp = 0; pp < 64; ++pp) { const float xr = hb[(i * 64 + pp) * 2], xi = hb[(i * 64 + pp) * 2 + 1];
#pragma unroll
                    for (int j = 0; j < 4; ++j) y[j] += xr * cs[((ho4 + j) * 64 + pp) * 2] - xi * cs[((ho4 + j) * 64 + pp) * 2 + 1]; }
                const int row = proc_row(blk * 16 + i, dir, b);
                float* yp = Y5 + (size_t)row * GW + g * 16 + ho4;
                if (dir == 0) { *(f32x4*)yp = (f32x4){y[0], y[1], y[2], y[3]}; }
                else {
                    const f32x4 yf = *(const f32x4*)yp;
                    const v2u uu = *(const v2u*)(P + (size_t)row * NIN + PC_S5 + g * 16 + ho4);
                    const float* dd = F.a->in[I_S5D] + l * GW + g * 16 + ho4;
                    const float z0 = gelu_tanh(yf[0] + y[0] + dd[0] * bflo(uu.x)), z1 = gelu_tanh(yf[1] + y[1] + dd[1] * bfhi(uu.x));
                    const float z2 = gelu_tanh(yf[2] + y[2] + dd[2] * bflo(uu.y)), z3 = gelu_tanh(yf[3] + y[3] + dd[3] * bfhi(uu.y));
                    v2u w; w.x = pk2(z0, z1); w.y = pk2(z2, z3);
                    *(v2u*)(Z + (size_t)row * GW + g * 16 + ho4) = w;
                }
            }
            asm volatile("s_waitcnt vmcnt(0) lgkmcnt(0)" ::: "memory");
        }
        asm volatile("s_waitcnt vmcnt(0) lgkmcnt(0)" ::: "memory");
    }
}

typedef short bf16x8v __attribute__((ext_vector_type(8)));
__device__ __forceinline__ size_t s5_gi(int l, int dir, int g) { return (size_t)((l * 2 + dir) * 32 + g); }
__device__ __forceinline__ void s5_tables_job(Frame& F, int l, int dir, int g) {
    LAS float* pw = (LAS float*)(F.lds);
    LAS float* bb = (LAS float*)(F.lds + 33 * 64 * 8);
    LAS float* cc = (LAS float*)(F.lds + 33 * 64 * 8 + 8192);
    const size_t gi = s5_gi(l, dir, g);
    __syncthreads();
    if (F.tid < 64) {
        const int p = F.tid;
        const float ar = F.a->in[I_S5ARE][gi * 64 + p], ai = F.a->in[I_S5AIM][gi * 64 + p];
        const float step = expf(F.a->in[I_S5LS][gi]);
        for (int n = 0; n <= S5Q; ++n) { const float e = expf(ar * step * (float)n); float sn, cn; sincosf(ai * step * (float)n, &sn, &cn); pw[(n * 64 + p) * 2] = e * cn; pw[(n * 64 + p) * 2 + 1] = e * sn; }
        const float e = expf(ar * step); float sn, cn; sincosf(ai * step, &sn, &cn);
        const float abr = e * cn, abi = e * sn, den = ar * ar + ai * ai;
        const float qr = ((abr - 1.f) * ar + abi * ai) / den, qi = (abi * ar - (abr - 1.f) * ai) / den;
        for (int h = 0; h < 16; ++h) { const float br = F.a->in[I_S5BRE][(gi * 64 + p) * 16 + h], bi = F.a->in[I_S5BIM][(gi * 64 + p) * 16 + h];
            bb[(p * 16 + h) * 2] = qr * br - qi * bi; bb[(p * 16 + h) * 2 + 1] = qr * bi + qi * br; }
        for (int ho = 0; ho < 16; ++ho) { cc[(ho * 64 + p) * 2] = F.a->in[I_S5CRE][(gi * 16 + ho) * 64 + p]; cc[(ho * 64 + p) * 2 + 1] = F.a->in[I_S5CIM][(gi * 16 + ho) * 64 + p]; }
        float* aq = WSP(float, WS_S5AQ) + (gi * 64 + p) * 2;
        const float eq = expf(ar * step * (float)S5Q); float snq, cnq; sincosf(ai * step * (float)S5Q, &snq, &cnq);
        aq[0] = eq * cnq; aq[1] = eq * snq;
    }
    __syncthreads();
    bf16* KT = WSP(bf16, WS_S5KT) + gi * 33 * 256;
    for (int e = F.tid; e < 33 * 256; e += NTHREADS) {
        const int tau = e / 256 - 1, ho = (e >> 4) & 15, hi = e & 15;
        float v = 0.f;
        if (tau >= 0) {
            for (int p = 0; p < 64; ++p) {
                const float cr = cc[(ho * 64 + p) * 2], ci = cc[(ho * 64 + p) * 2 + 1], pr = pw[(tau * 64 + p) * 2], pi = pw[(tau * 64 + p) * 2 + 1];
                const float xr = cr * pr - ci * pi, xi = cr * pi + ci * pr;
                v += xr * bb[(p * 16 + hi) * 2] - xi * bb[(p * 16 + hi) * 2 + 1];
            }
            if (dir == 0 && tau == 0 && ho == hi) v += F.a->in[I_S5D][l * GW + g * 16 + ho];
        }
        KT[e] = (bf16)f2bf(v);
    }
    bf16* WSt = WSP(bf16, WS_S5WS) + gi * 128 * 512;
    for (int e = F.tid; e < 128 * 512; e += NTHREADS) {
        const int p2 = e >> 9, sh = e & 511, sidx = sh >> 4, hi = sh & 15, p = p2 & 63;
        const int n = dir ? sidx : (S5Q - 1 - sidx);
        const float pr = pw[(n * 64 + p) * 2], pi = pw[(n * 64 + p) * 2 + 1], br = bb[(p * 16 + hi) * 2], bi = bb[(p * 16 + hi) * 2 + 1];
        const float v = (p2 < 64) ? (pr * br - pi * bi) : (pr * bi + pi * br);
        WSt[e] = (bf16)f2bf(v);
    }
    bf16* WCt = WSP(bf16, WS_S5WC) + gi * 512 * 128;
    for (int e = F.tid; e < 512 * 128; e += NTHREADS) {
        const int th = e >> 7, p2 = e & 127, t = th >> 4, ho = th & 15, p = p2 & 63;
        const int n = dir ? (S5Q - t) : (t + 1);
        const float pr = pw[(n * 64 + p) * 2], pi = pw[(n * 64 + p) * 2 + 1], cr = cc[(ho * 64 + p) * 2], ci = cc[(ho * 64 + p) * 2 + 1];
        const float v = (p2 < 64) ? (cr * pr - ci * pi) : -(cr * pi + ci * pr);
        WCt[e] = (bf16)f2bf(v);
    }
    __syncthreads();
}
__device__ __forceinline__ void s5_state_job(Frame& F, int l, int g, int cs) {
    const int col = F.lane & 15, kq = F.lane >> 4, mq = F.wave & 3, dir = F.wave >> 2;
    const int ch = cs * 16 + col; const size_t row0 = (size_t)ch * S5Q;
    const bf16* P = WSP(bf16, WS_P);
    bf16x8v U[16];
#pragma unroll
    for (int ks = 0; ks < 16; ++ks) U[ks] = *(const bf16x8v*)(P + (row0 + 2 * ks + (kq >> 1)) * NIN + PC_S5 + g * 16 + 8 * (kq & 1));
    const bf16* WSt = WSP(bf16, WS_S5WS) + s5_gi(l, dir, g) * 128 * 512;
    float* S = WSP(float, WS_S5S);
#pragma unroll
    for (int mt = 0; mt < 2; ++mt) {
        const int mtile = mq * 2 + mt;
        f32x4 acc = {0.f, 0.f, 0.f, 0.f};
        const bf16* ap = WSt + (size_t)(mtile * 16 + col) * 512 + kq * 8;
#pragma unroll
        for (int ks = 0; ks < 16; ++ks) { const bf16x8v A = *(const bf16x8v*)(ap + ks * 32); acc = __builtin_amdgcn_mfma_f32_16x16x32_bf16(A, U[ks], acc, 0, 0, 0); }
        *(f32x4*)(S + (((size_t)ch * 2 + dir) * 32 + g) * 128 + mtile * 16 + 4 * kq) = acc;
    }
}
__device__ __forceinline__ void s5_scan(Frame& F, int l, int idx) {
    const int p = idx & 63, g = (idx >> 6) & 31, dir = (idx >> 11) & 1, b = idx >> 12;
    const float* aq = WSP(float, WS_S5AQ) + (s5_gi(l, dir, g) * 64 + p) * 2;
    const float qr = aq[0], qi = aq[1];
    const float* S = WSP(float, WS_S5S); bf16* HIN = WSP(bf16, WS_S5HIN);
    float hr = 0.f, hi = 0.f;
    constexpr int NC = CTXL / S5Q, NL = SEQL / S5Q;
#pragma unroll 8
    for (int st = 0; st < NC + NL; ++st) {
        int ch;
        if (st < NC) ch = 256 + b * NC + (dir ? NC - 1 - st : st); else ch = b * NL + (dir ? NL - 1 - (st - NC) : (st - NC));
        const size_t o = (((size_t)ch * 2 + dir) * 32 + g) * 128 + p;
        const float sr = S[o], si = S[o + 64];
        HIN[o] = (bf16)f2bf(hr); HIN[o + 64] = (bf16)f2bf(hi);
        const float nr = qr * hr - qi * hi + sr, ni = qr * hi + qi * hr + si;
        hr = nr; hi = ni;
    }
}
__device__ __forceinline__ void s5_out_job(Frame& F, int l, int g, int cs) {
    const int col = F.lane & 15, kq = F.lane >> 4;
    const int ch = cs * 16 + col; const size_t row0 = (size_t)ch * S5Q;
    const bf16* P = WSP(bf16, WS_P);
    bf16x8v U[16], Hf[4], Hb[4];
#pragma unroll
    for (int ks = 0; ks < 16; ++ks) U[ks] = *(const bf16x8v*)(P + (row0 + 2 * ks + (kq >> 1)) * NIN + PC_S5 + g * 16 + 8 * (kq & 1));
    const bf16* HIN = WSP(bf16, WS_S5HIN);
#pragma unroll
    for (int k4 = 0; k4 < 4; ++k4) { Hf[k4] = *(const bf16x8v*)(HIN + (((size_t)ch * 2 + 0) * 32 + g) * 128 + k4 * 32 + kq * 8); Hb[k4] = *(const bf16x8v*)(HIN + (((size_t)ch * 2 + 1) * 32 + g) * 128 + k4 * 32 + kq * 8); }
    const bf16* KTf = WSP(bf16, WS_S5KT) + s5_gi(l, 0, g) * 33 * 256 + col * 16 + 8 * (kq & 1);
    const bf16* KTb = WSP(bf16, WS_S5KT) + s5_gi(l, 1, g) * 33 * 256 + col * 16 + 8 * (kq & 1);
    const bf16* WCf = WSP(bf16, WS_S5WC) + s5_gi(l, 0, g) * 512 * 128 + (size_t)col * 128 + kq * 8;
    const bf16* WCb = WSP(bf16, WS_S5WC) + s5_gi(l, 1, g) * 512 * 128 + (size_t)col * 128 + kq * 8;
    bf16* Z = WSP(bf16, WS_Z);
#pragma unroll 1
    for (int tt = 0; tt < 4; ++tt) {
        const int t = F.wave * 4 + tt;
        f32x4 acc = {0.f, 0.f, 0.f, 0.f};
#pragma unroll
        for (int ks = 0; ks < 16; ++ks) {
            const int sidx = 2 * ks + (kq >> 1);
            if (2 * ks <= t) { int tau = t - sidx; tau = tau < 0 ? -1 : tau; const bf16x8v A = *(const bf16x8v*)(KTf + (tau + 1) * 256); acc = __builtin_amdgcn_mfma_f32_16x16x32_bf16(A, U[ks], acc, 0, 0, 0); }
            if (2 * ks + 1 >= t) { int tau = sidx - t; tau = tau < 0 ? -1 : tau; const bf16x8v A = *(const bf16x8v*)(KTb + (tau + 1) * 256); acc = __builtin_amdgcn_mfma_f32_16x16x32_bf16(A, U[ks], acc, 0, 0, 0); }
        }
#pragma unroll
        for (int k4 = 0; k4 < 4; ++k4) {
            const bf16x8v A0 = *(const bf16x8v*)(WCf + (size_t)t * 16 * 128 + k4 * 32); acc = __builtin_amdgcn_mfma_f32_16x16x32_bf16(A0, Hf[k4], acc, 0, 0, 0);
            const bf16x8v A1 = *(const bf16x8v*)(WCb + (size_t)t * 16 * 128 + k4 * 32); acc = __builtin_amdgcn_mfma_f32_16x16x32_bf16(A1, Hb[k4], acc, 0, 0, 0);
        }
        v2u w; w.x = pk2(gelu_tanh(acc[0]), gelu_tanh(acc[1])); w.y = pk2(gelu_tanh(acc[2]), gelu_tanh(acc[3]));
        *(v2u*)(Z + (row0 + t) * GW + g * 16 + 4 * kq) = w;
    }
}

constexpr int SPITCH = 136;
constexpr int L_XT = 0, L_B = 256 * SPITCH * 2, L_C = L_B + 128 * SPITCH * 2, L_DTV = L_C + 128 * SPITCH * 2, L_CUM = L_DTV + 4096, L_E = L_CUM + 4096;
static_assert(L_E + 64 <= LDS_BYTES, "SSD LDS map");

template <bool TR>
__device__ __forceinline__ void ssd_stage(Frame& F, int l, int cj, int xch0, int nch, LAS bf16* dst) {
    const bf16* P = WSP(bf16, WS_P);
    const int r0 = cj * 128; int base, t0, len; row_seq(r0, base, t0, len);
    const int ncv = nch >> 3;
    const float* cw = F.a->in[I_M2CW] + (size_t)l * 4 * 1024 + xch0; const float* cb = F.a->in[I_M2CB] + l * 1024 + xch0;
    for (int item = F.tid; item < ncv * 16; item += NTHREADS) {
        const int cv = item % ncv, ts = item / ncv, c8 = cv * 8, tq = ts * 8;
        float w[4][8], bsv[8];
#pragma unroll
        for (int k = 0; k < 4; ++k) { const f32x4 a = *(const f32x4*)(cw + k * 1024 + c8), b = *(const f32x4*)(cw + k * 1024 + c8 + 4);
            w[k][0] = a[0]; w[k][1] = a[1]; w[k][2] = a[2]; w[k][3] = a[3]; w[k][4] = b[0]; w[k][5] = b[1]; w[k][6] = b[2]; w[k][7] = b[3]; }
        { const f32x4 a = *(const f32x4*)(cb + c8), b = *(const f32x4*)(cb + c8 + 4); bsv[0] = a[0]; bsv[1] = a[1]; bsv[2] = a[2]; bsv[3] = a[3]; bsv[4] = b[0]; bsv[5] = b[1]; bsv[6] = b[2]; bsv[7] = b[3]; }
        v4u raw[11];
#pragma unroll
        for (int i = 0; i < 11; ++i) { const int t = t0 + tq - 2 + i;
            raw[i] = (t >= 0 && t < len) ? *(const v4u*)(P + (size_t)(base + t) * NIN + PC_XBC + xch0 + c8) : (v4u){0u, 0u, 0u, 0u}; }
        unsigned pk[8][4];
#pragma unroll
        for (int i = 0; i < 8; ++i) {
            float o[8];
#pragma unroll
            for (int e = 0; e < 8; ++e) o[e] = bsv[e];
#pragma unroll
            for (int k = 0; k < 4; ++k) { const v4u r = raw[i + k];
                o[0] += w[k][0] * bflo(r.x); o[1] += w[k][1] * bfhi(r.x); o[2] += w[k][2] * bflo(r.y); o[3] += w[k][3] * bfhi(r.y);
                o[4] += w[k][4] * bflo(r.z); o[5] += w[k][5] * bfhi(r.z); o[6] += w[k][6] * bflo(r.w); o[7] += w[k][7] * bfhi(r.w); }
#pragma unroll
            for (int e = 0; e < 8; ++e) o[e] = siluf_(o[e]);
            if (TR) {
#pragma unroll
                for (int e = 0; e < 8; ++e) { const unsigned hb = f2bf(o[e]); if (i & 1) pk[e][i >> 1] |= hb << 16; else pk[e][i >> 1] = hb; }
            } else {
                v4u q; q.x = pk2(o[0], o[1]); q.y = pk2(o[2], o[3]); q.z = pk2(o[4], o[5]); q.w = pk2(o[6], o[7]);
                *(LAS v4u*)(dst + (tq + i) * SPITCH + c8) = q;
            }
        }
        if (TR) {
#pragma unroll
            for (int e = 0; e < 8; ++e) { v4u q; q.x = pk[e][0]; q.y = pk[e][1]; q.z = pk[e][2]; q.w = pk[e][3]; *(LAS v4u*)(dst + (c8 + e) * SPITCH + tq) = q; }
        }
    }
}
__device__ __forceinline__ void ssd_dt_cum(Frame& F, int l, int cj, int gi) {
    LAS float* dtv = (LAS float*)(F.lds + L_DTV); LAS float* cum = (LAS float*)(F.lds + L_CUM); LAS float* Ea = (LAS float*)(F.lds + L_E);
    const int hd = F.wave, dir = hd >> 2, h = gi * 4 + (hd & 3);
    const float* DT = WSP(float, WS_DT);
    const float bias = F.a->in[I_M2DTB][l * 16 + dir * 8 + h];
    const float a = -expf(F.a->in[I_M2ALOG][l * 16 + dir * 8 + h]);
    const int q0 = 2 * F.lane;
    const float dt0 = softplusf_(DT[(size_t)(cj * 128 + q0) * 16 + dir * 8 + h] + bias), dt1 = softplusf_(DT[(size_t)(cj * 128 + q0 + 1) * 16 + dir * 8 + h] + bias);
    const float da0 = dt0 * a, da1 = dt1 * a;
    float ps = da0 + da1;
#pragma unroll
    for (int o = 1; o < 64; o <<= 1) { const float t = __shfl_up(ps, o); if (F.lane >= o) ps += t; }
    const float tot = __shfl(ps, 63);
    float c0, c1;
    if (dir == 0) { c0 = ps - da1; c1 = ps; } else { c0 = tot - (ps - da0 - da1); c1 = tot - (ps - da1); }
    dtv[hd * 128 + q0] = dt0; dtv[hd * 128 + q0 + 1] = dt1; cum[hd * 128 + q0] = c0; cum[hd * 128 + q0 + 1] = c1;
    if (F.lane == 0) Ea[hd] = tot;
}
__device__ __forceinline__ void unpack8(const bf16x8v v, float (&o)[8]) {
    const v4u u = __builtin_bit_cast(v4u, v);
    o[0] = bflo(u.x); o[1] = bfhi(u.x); o[2] = bflo(u.y); o[3] = bfhi(u.y); o[4] = bflo(u.z); o[5] = bfhi(u.z); o[6] = bflo(u.w); o[7] = bfhi(u.w);
}
__device__ __forceinline__ bf16x8v pack8(const float (&o)[8]) {
    v4u u; u.x = pk2(o[0], o[1]); u.y = pk2(o[2], o[3]); u.z = pk2(o[4], o[5]); u.w = pk2(o[6], o[7]);
    return __builtin_bit_cast(bf16x8v, u);
}
__device__ __forceinline__ void ssd_state_job(Frame& F, int l, int cj, int gi) {
    LAS bf16* XT = (LAS bf16*)(F.lds + L_XT); LAS bf16* BT = (LAS bf16*)(F.lds + L_B);
    LAS float* dtv = (LAS float*)(F.lds + L_DTV); LAS float* cum = (LAS float*)(F.lds + L_CUM); LAS float* Ea = (LAS float*)(F.lds + L_E);
    __syncthreads();
    ssd_stage<true>(F, l, cj, gi * 256, 256, XT);
    ssd_stage<true>(F, l, cj, 512 + gi * 128, 128, BT);
    ssd_dt_cum(F, l, cj, gi);
    __syncthreads();
    const int fr = F.lane & 15, kq = F.lane >> 4, nt = F.wave;
    bf16x8v BTf[4];
#pragma unroll
    for (int ks = 0; ks < 4; ++ks) BTf[ks] = *(const LAS bf16x8v*)(BT + (16 * nt + fr) * SPITCH + ks * 32 + kq * 8);
    float* SST = WSP(float, WS_SST); float* DEC = WSP(float, WS_SDEC);
#pragma unroll 1
    for (int hd = 0; hd < 8; ++hd) {
        const int hl = hd & 3; const float E = Ea[hd];
        float wq[4][8];
#pragma unroll
        for (int ks = 0; ks < 4; ++ks)
#pragma unroll
            for (int e = 0; e < 8; ++e) { const int q = ks * 32 + kq * 8 + e; wq[ks][e] = dtv[hd * 128 + q] * __expf(E - cum[hd * 128 + q]); }
#pragma unroll
        for (int pt = 0; pt < 4; ++pt) {
            f32x4 acc = {0.f, 0.f, 0.f, 0.f};
#pragma unroll
            for (int ks = 0; ks < 4; ++ks) {
                const bf16x8v raw = *(const LAS bf16x8v*)(XT + (hl * 64 + pt * 16 + fr) * SPITCH + ks * 32 + kq * 8);
                float xv[8]; unpack8(raw, xv);
#pragma unroll
                for (int e = 0; e < 8; ++e) xv[e] *= wq[ks][e];
                acc = __builtin_amdgcn_mfma_f32_16x16x32_bf16(BTf[ks], pack8(xv), acc, 0, 0, 0);
            }
            *(f32x4*)(SST + ((size_t)((cj * 2 + gi) * 8 + hd) * 64 + pt * 16 + fr) * 128 + 16 * nt + 4 * kq) = acc;
        }
        if (F.tid == 0) DEC[(cj * 2 + gi) * 8 + hd] = __expf(E);
    }
}
__device__ __forceinline__ void ssd_scan(Frame& F, int idx) {
    const int n4 = idx & 31, p = (idx >> 5) & 63, hdg = (idx >> 11) & 15, b = idx >> 15;
    const int dir = (hdg >> 2) & 1;
    const float* SST = WSP(float, WS_SST); const float* DEC = WSP(float, WS_SDEC); bf16* HIN = WSP(bf16, WS_SHIN);
    f32x4 h = {0.f, 0.f, 0.f, 0.f};
#pragma unroll 2
    for (int st = 0; st < 34; ++st) {
        const int cj = st < 2 ? 64 + b * 2 + (dir ? 1 - st : st) : b * 32 + (dir ? 31 - (st - 2) : st - 2);
        const size_t o = ((size_t)(cj * 16 + hdg) * 64 + p) * 128 + n4 * 4;
        const f32x4 sv = *(const f32x4*)(SST + o); const float d = DEC[cj * 16 + hdg];
        v2u w; w.x = pk2(h[0], h[1]); w.y = pk2(h[2], h[3]);
        *(v2u*)(HIN + o) = w;
        h = h * d + sv;
    }
}
__device__ __forceinline__ void ssd_y_job(Frame& F, int l, int cj, int gi) {
    LAS bf16* XT = (LAS bf16*)(F.lds + L_XT); LAS bf16* BM = (LAS bf16*)(F.lds + L_B); LAS bf16* CM = (LAS bf16*)(F.lds + L_C);
    LAS float* dtv = (LAS float*)(F.lds + L_DTV); LAS float* cum = (LAS float*)(F.lds + L_CUM);
    __syncthreads();
    ssd_stage<true>(F, l, cj, gi * 256, 256, XT);
    ssd_stage<false>(F, l, cj, 512 + gi * 128, 128, BM);
    ssd_stage<false>(F, l, cj, 768 + gi * 128, 128, CM);
    ssd_dt_cum(F, l, cj, gi);
    __syncthreads();
    const int fr = F.lane & 15, kq = F.lane >> 4, w = F.wave, i = 16 * w + fr;
    bf16x8v Cf[4];
#pragma unroll
    for (int ks = 0; ks < 4; ++ks) Cf[ks] = *(const LAS bf16x8v*)(CM + i * SPITCH + ks * 32 + kq * 8);
    f32x4 GT[8];
#pragma unroll
    for (int jt = 0; jt < 8; ++jt) { f32x4 a = {0.f, 0.f, 0.f, 0.f};
#pragma unroll
        for (int ks = 0; ks < 4; ++ks) { const bf16x8v A = *(const LAS bf16x8v*)(BM + (16 * jt + fr) * SPITCH + ks * 32 + kq * 8); a = __builtin_amdgcn_mfma_f32_16x16x32_bf16(A, Cf[ks], a, 0, 0, 0); }
        GT[jt] = a; }
    const bf16* P = WSP(bf16, WS_P); const bf16* HIN = WSP(bf16, WS_SHIN);
    const size_t row = (size_t)cj * 128 + i;
    f32x4 gq[4][4]; float ss = 0.f;
#pragma unroll
    for (int hl = 0; hl < 4; ++hl) {
        f32x4 accY[4];
#pragma unroll
        for (int pt = 0; pt < 4; ++pt) accY[pt] = (f32x4){0.f, 0.f, 0.f, 0.f};
        const float dh = F.a->in[I_M2D][l * 8 + gi * 4 + hl];
#pragma unroll 1
        for (int dir = 0; dir < 2; ++dir) {
            const int hd = dir * 4 + hl;
            int io = i; asm volatile("" : "+v"(io));
            const float ci = cum[hd * 128 + i];
#pragma unroll
            for (int kk = 0; kk < 4; ++kk) {
                const bool rel = dir == 0 ? (32 * kk <= 16 * w + 15) : (32 * kk + 31 >= 16 * w);
                if (rel) {
                    float sv[8];
#pragma unroll
                    for (int e = 0; e < 8; ++e) {
                        const int j = 32 * kk + 16 * (e >> 2) + 4 * kq + (e & 3);
                        const float g = GT[2 * kk + (e >> 2)][e & 3];
                        const bool valid = dir == 0 ? (j <= io) : (j >= io);
                        float v = valid ? g * __expf(ci - cum[hd * 128 + j]) * dtv[hd * 128 + j] : 0.f;
                        if (dir == 0 && j == io) v += dh;
                        sv[e] = v;
                    }
                    const bf16x8v Bf = pack8(sv);
#pragma unroll
                    for (int pt = 0; pt < 4; ++pt) {
                        const LAS bf16* xp = XT + (hl * 64 + pt * 16 + fr) * SPITCH + 32 * kk + 4 * kq;
                        const v2u a0 = *(const LAS v2u*)(xp), a1 = *(const LAS v2u*)(xp + 16);
                        v4u au; au.x = a0.x; au.y = a0.y; au.z = a1.x; au.w = a1.y;
                        accY[pt] = __builtin_amdgcn_mfma_f32_16x16x32_bf16(__builtin_bit_cast(bf16x8v, au), Bf, accY[pt], 0, 0, 0);
                    }
                }
            }
            const float ei = __expf(ci);
            const bf16* hp = HIN + ((size_t)((cj * 2 + gi) * 8 + hd) * 64 + fr) * 128 + kq * 8;
#pragma unroll
            for (int pt = 0; pt < 4; ++pt) {
                f32x4 tmp = {0.f, 0.f, 0.f, 0.f};
#pragma unroll
                for (int ks = 0; ks < 4; ++ks) { const bf16x8v A = *(const bf16x8v*)(hp + (size_t)(pt * 16) * 128 + ks * 32); tmp = __builtin_amdgcn_mfma_f32_16x16x32_bf16(A, Cf[ks], tmp, 0, 0, 0); }
                accY[pt] += tmp * ei;
            }
        }
#pragma unroll
        for (int pt = 0; pt < 4; ++pt) {
            const v2u zz = *(const v2u*)(P + row * NIN + PC_Z + gi * 256 + hl * 64 + pt * 16 + 4 * kq);
            f32x4 gv; gv[0] = accY[pt][0] * siluf_(bflo(zz.x)); gv[1] = accY[pt][1] * siluf_(bfhi(zz.x)); gv[2] = accY[pt][2] * siluf_(bflo(zz.y)); gv[3] = accY[pt][3] * siluf_(bfhi(zz.y));
            ss += (gv[0] * gv[0] + gv[1] * gv[1]) + (gv[2] * gv[2] + gv[3] * gv[3]);
            gq[hl][pt] = gv;
        }
    }
    ss += __shfl_xor(ss, 16); ss += __shfl_xor(ss, 32);
    const float rs = 1.f / sqrtf(ss * (1.f / 256.f) + RMS_EPS);
    bf16* MIX = WSP(bf16, WS_MIX);
#pragma unroll
    for (int hl = 0; hl < 4; ++hl)
#pragma unroll
        for (int pt = 0; pt < 4; ++pt) {
            const int ch = gi * 256 + hl * 64 + pt * 16 + 4 * kq;
            const f32x4 nw = *(const f32x4*)(F.a->in[I_M2NW] + l * GW + ch);
            const f32x4 o = gq[hl][pt] * rs * nw;
            v2u wv; wv.x = pk2(o[0], o[1]); wv.y = pk2(o[2], o[3]);
            *(v2u*)(MIX + row * DM + MX_SSD + ch) = wv;
        }
}
__device__ __forceinline__ void ssd_prep_oracle(Frame& F, int l) {
    const int gt = F.bid * NTHREADS + F.tid, NGT = F.G * NTHREADS;
    const bf16* P = WSP(bf16, WS_P); float* XC = WSP(float, WS_XC);
    const float* cw = F.a->in[I_M2CW] + (size_t)l * 4 * 1024; const float* cb = F.a->in[I_M2CB] + l * 1024;
    for (int i = gt; i < MT * 1024; i += NGT) {
        const int row = i >> 10, ch = i & 1023; int base, t, len; row_seq(row, base, t, len);
        float a = cb[ch];
#pragma unroll
        for (int k = 0; k < 4; ++k) { const int tt = t - 2 + k; if (tt >= 0 && tt < len) a += cw[k * 1024 + ch] * bf2f(P[(size_t)(base + tt) * NIN + PC_XBC + ch]); }
        XC[i] = siluf_(a);
    }
    const float* dtr = WSP(float, WS_DT); float* dts = WSP(float, WS_DTS);
    for (int i = gt; i < MT * 16; i += NGT) dts[i] = softplusf_(dtr[i] + F.a->in[I_M2DTB][l * 16 + (i & 15)]);
}
__device__ __forceinline__ void ssd_scan_oracle_job(Frame& F, int l, int b, int hd, int dir) {
    LAS float* xs = (LAS float*)(F.lds);
    LAS float* Bs = (LAS float*)(F.lds + 8192);
    LAS float* Cs = (LAS float*)(F.lds + 8192 + 16384);
    LAS float* ds = (LAS float*)(F.lds + 8192 + 32768);
    LAS float* yb = (LAS float*)(F.lds + 8192 + 32768 + 256);
    LAS int* rws = (LAS int*)(F.lds + 8192 + 32768 + 256 + 8192);
    const float* XC = WSP(float, WS_XC); const float* dts = WSP(float, WS_DTS); float* YD = WSP(float, WS_YD) + (size_t)dir * MT * GW;
    const int p = F.tid >> 3, nq = F.tid & 7, n0 = nq * 16, grp = hd >> 2;
    const float a = -expf(F.a->in[I_M2ALOG][l * 16 + dir * 8 + hd]);
    float hs[16];
#pragma unroll
    for (int k = 0; k < 16; ++k) hs[k] = 0.f;
    for (int q0 = 0; q0 < CTXL + SEQL; q0 += 32) {
        __syncthreads();
        for (int idx = F.tid; idx < 32 * 64; idx += NTHREADS) { const int i = idx >> 6, c = idx & 63; const int row = proc_row(q0 + i, dir, b); xs[idx] = XC[(size_t)row * 1024 + hd * 64 + c]; }
        for (int idx = F.tid; idx < 32 * 128; idx += NTHREADS) { const int i = idx >> 7, n = idx & 127; const int row = proc_row(q0 + i, dir, b);
            Bs[idx] = XC[(size_t)row * 1024 + 512 + grp * 128 + n]; Cs[idx] = XC[(size_t)row * 1024 + 768 + grp * 128 + n]; }
        if (F.tid < 32) { const int row = proc_row(q0 + F.tid, dir, b); ds[F.tid] = dts[(size_t)row * 16 + dir * 8 + hd]; rws[F.tid] = row; }
        __syncthreads();
        for (int i = 0; i < 32; ++i) {
            const float dt = ds[i], da = expf(dt * a), xd = xs[i * 64 + p] * dt;
            float part = 0.f;
#pragma unroll
            for (int k = 0; k < 16; ++k) { hs[k] = da * hs[k] + xd * Bs[i * 128 + n0 + k]; part += Cs[i * 128 + n0 + k] * hs[k]; }
            part += __shfl_xor(part, 1); part += __shfl_xor(part, 2); part += __shfl_xor(part, 4);
            if (nq == 0) yb[i * 64 + p] = part;
        }
        __syncthreads();
        for (int idx = F.tid; idx < 32 * 64; idx += NTHREADS) { const int i = idx >> 6, c = idx & 63; YD[(size_t)rws[i] * GW + hd * 64 + c] = yb[idx]; }
    }
    __syncthreads();
}
__device__ __forceinline__ void ssd_finish_oracle(Frame& F, int l) {
    const int gw = F.bid * NWAVES + F.wave, NGW = F.G * NWAVES;
    const float* XC = WSP(float, WS_XC); const float* YD = WSP(float, WS_YD); const bf16* P = WSP(bf16, WS_P); bf16* MIX = WSP(bf16, WS_MIX);
    for (int row = gw; row < MT; row += NGW) {
#pragma unroll
        for (int j = 0; j < 2; ++j) {
            const int ch = j * 256 + F.lane * 4;
            const f32x4 y0 = *(const f32x4*)(YD + (size_t)row * GW + ch), y1 = *(const f32x4*)(YD + (size_t)(MT + row) * GW + ch), xv = *(const f32x4*)(XC + (size_t)row * 1024 + ch);
            const float dh = F.a->in[I_M2D][l * 8 + (ch >> 6)];
            const v2u zz = *(const v2u*)(P + (size_t)row * NIN + PC_Z + ch);
            f32x4 gq; float zf[4] = {bflo(zz.x), bfhi(zz.x), bflo(zz.y), bfhi(zz.y)};
#pragma unroll
            for (int k = 0; k < 4; ++k) gq[k] = (y0[k] + y1[k] + dh * xv[k]) * siluf_(zf[k]);
            const float ss = wave_sum((gq[0] * gq[0] + gq[1] * gq[1]) + (gq[2] * gq[2] + gq[3] * gq[3]));
            const float rs = 1.f / sqrtf(ss * (1.f / 256.f) + RMS_EPS);
            const f32x4 nw = *(const f32x4*)(F.a->in[I_M2NW] + l * GW + ch);
            v2u w; w.x = pk2(gq[0] * rs * nw[0], gq[1] * rs * nw[1]); w.y = pk2(gq[2] * rs * nw[2], gq[3] * rs * nw[3]);
            *(v2u*)(MIX + (size_t)row * DM + MX_SSD + ch) = w;
        }
    }
}
__device__ __forceinline__ void sg_oracle_job(Frame& F, int l, int cj, int hh) {
    LAS float* v = (LAS float*)(F.lds);
    const bf16* P = WSP(bf16, WS_P); bf16* MIX = WSP(bf16, WS_MIX);
    const int r0 = cj * 128;
    __syncthreads();
    for (int j = F.wave; j < 128; j += NWAVES) {
        const unsigned w = *(const unsigned*)(P + (size_t)(r0 + j) * NIN + PC_SGV + hh * 128 + F.lane * 2);
        const float a0 = gelu_tanh(bflo(w)), a1 = gelu_tanh(bfhi(w));
        const float mean = wave_sum(a0 + a1) * (1.f / 128.f);
        const float d0 = a0 - mean, d1 = a1 - mean;
        const float rstd = 1.f / sqrtf(wave_sum(d0 * d0 + d1 * d1) * (1.f / 128.f) + LN_EPS);
        const int d = F.lane * 2;
        v[j * 128 + d] = d0 * rstd * F.a->in[I_SGLNG][l * GW + hh * 128 + d] + F.a->in[I_SGLNB][l * GW + hh * 128 + d];
        v[j * 128 + d + 1] = d1 * rstd * F.a->in[I_SGLNG][l * GW + hh * 128 + d + 1] + F.a->in[I_SGLNB][l * GW + hh * 128 + d + 1];
    }
    __syncthreads();
    const int d = F.tid & 127, ig = F.tid >> 7;
    const float* ws = F.a->in[I_SGW] + (size_t)(l * 4 + hh) * 128 * 128;
    for (int ii = 0; ii < 32; ++ii) {
        const int i = ig * 32 + ii;
        float s = F.a->in[I_SGB][(l * 4 + hh) * 128 + i];
        for (int j = 0; j < 128; ++j) s += ws[i * 128 + j] * v[j * 128 + d];
        const float uu = gelu_tanh(bf2f(P[(size_t)(r0 + i) * NIN + PC_SGU + hh * 128 + d]));
        MIX[(size_t)(r0 + i) * DM + MX_SG + hh * 128 + d] = (bf16)f2bf(uu * s);
    }
    __syncthreads();
}
__device__ __forceinline__ void pool_oracle_job(Frame& F, int l, int tile, int gp) {
    LAS float* m = (LAS float*)(F.lds);
    const bf16* P = WSP(bf16, WS_P); bf16* MIX = WSP(bf16, WS_MIX);
    const int r0 = tile * 32, win = 2 << gp;
    __syncthreads();
    for (int idx = F.tid; idx < 32 * 128; idx += NTHREADS) {
        const int i = idx >> 7, c = idx & 127; int base, t, len; row_seq(r0 + i, base, t, len);
        int lo = t - win / 2; if (lo < 0) lo = 0; int hi = t + win / 2 - 1; if (hi > len - 1) hi = len - 1;
        float s = 0.f;
        for (int k = lo; k <= hi; ++k) s += bf2f(P[(size_t)(base + k) * NIN + PC_POOL + gp * 128 + c]);
        m[idx] = s / (float)(hi - lo + 1) - bf2f(P[(size_t)(r0 + i) * NIN + PC_POOL + gp * 128 + c]);
    }
    __syncthreads();
    const int d = F.tid & 127, ig = F.tid >> 7;
    const float* w = F.a->in[I_POOLW] + (size_t)(l * 4 + gp) * 128 * 128;
    for (int ii = 0; ii < 8; ++ii) {
        const int i = ig * 8 + ii; float s = 0.f;
        for (int c = 0; c < 128; ++c) s += m[i * 128 + c] * w[c * 128 + d];
        s = (s + F.a->in[I_POOLB][l * GW + gp * 128 + d]) * F.a->in[I_POOLS][l * GW + gp * 128 + d];
        MIX[(size_t)(r0 + i) * DM + MX_POOL + gp * 128 + d] = (bf16)f2bf(s);
    }
    __syncthreads();
}
__device__ __forceinline__ void ffn_act_oracle(Frame& F, int l) {
    const int gt = F.bid * NTHREADS + F.tid, NGT = F.G * NTHREADS;
    const bf16* GV = WSP(bf16, WS_GV); bf16* ACT = WSP(bf16, WS_ACT);
    const float* cw = F.a->in[I_FCW] + (size_t)l * 9 * FF; const float* cb = F.a->in[I_FCB] + l * FF;
    constexpr int FV = FF / 8;
    for (int i = gt; i < MT * FV; i += NGT) {
        const int row = i / FV, f0 = (i % FV) * 8;
        float a[8];
#pragma unroll
        for (int k = 0; k < 8; ++k) a[k] = cb[f0 + k];
        if (row < ML) {
            const int b = row >> 12, t = row & 4095, r = t >> 6, c = t & 63;
            for (int dr = -1; dr <= 1; ++dr) for (int dc = -1; dc <= 1; ++dc) {
                const int rr = r + dr, c2 = c + dc; if (rr < 0 || rr > 63 || c2 < 0 || c2 > 63) continue;
                const v4u g = *(const v4u*)(GV + (size_t)(b * SEQL + rr * 64 + c2) * FF2 + f0);
                const float* w = cw + ((dr + 1) * 3 + (dc + 1)) * FF + f0;
                a[0] += w[0] * bflo(g.x); a[1] += w[1] * bfhi(g.x); a[2] += w[2] * bflo(g.y); a[3] += w[3] * bfhi(g.y);
                a[4] += w[4] * bflo(g.z); a[5] += w[5] * bfhi(g.z); a[6] += w[6] * bflo(g.w); a[7] += w[7] * bfhi(g.w);
            }
        } else {
            int base, t, len; row_seq(row, base, t, len);
            for (int k = 0; k < 3; ++k) { const int tt = t + k - 1; if (tt < 0 || tt >= len) continue;
                const v4u g = *(const v4u*)(GV + (size_t)(base + tt) * FF2 + f0);
                const float* w = cw + (3 + k) * FF + f0;
                a[0] += w[0] * bflo(g.x); a[1] += w[1] * bfhi(g.x); a[2] += w[2] * bflo(g.y); a[3] += w[3] * bfhi(g.y);
                a[4] += w[4] * bflo(g.z); a[5] += w[5] * bfhi(g.z); a[6] += w[6] * bflo(g.w); a[7] += w[7] * bfhi(g.w);
            }
        }
        const v4u vv = *(const v4u*)(GV + (size_t)row * FF2 + FF + f0);
        v4u o;
        o.x = pk2(gelu_tanh(a[0]) * bflo(vv.x), gelu_tanh(a[1]) * bfhi(vv.x)); o.y = pk2(gelu_tanh(a[2]) * bflo(vv.y), gelu_tanh(a[3]) * bfhi(vv.y));
        o.z = pk2(gelu_tanh(a[4]) * bflo(vv.z), gelu_tanh(a[5]) * bfhi(vv.z)); o.w = pk2(gelu_tanh(a[6]) * bflo(vv.w), gelu_tanh(a[7]) * bfhi(vv.w));
        *(v4u*)(ACT + (size_t)row * FF + f0) = o;
    }
}

constexpr int PH_PRO_A = 0, PH_PRO_B = 1, PH_PRO_C = 2, PH_L0 = 3, NPH_L = 11, N_PHASES = PH_L0 + DEPTH * NPH_L;


template <int PH>
__device__ __forceinline__ void run_phase(LAS unsigned char* ldsp) {
    Frame F;
    F.lds = ldsp;
    { int t_ = threadIdx.x; asm volatile("" : "+v"(t_)); F.tid = t_; }
    F.lane = F.tid & 63; F.wave = __builtin_amdgcn_readfirstlane(F.tid >> 6);
    { int b_ = blockIdx.x, g_ = gridDim.x; asm volatile("" : "+s"(b_), "+s"(g_)); F.bid = b_; F.G = g_; }
    { const __attribute__((address_space(4))) Args* ap = (const __attribute__((address_space(4))) Args*)__builtin_amdgcn_kernarg_segment_ptr(); asm volatile("" : "+s"(ap)); F.a = ap; }
    if constexpr (PH == PH_PRO_A) { phase_pro_a(F); for (int j = F.bid; j < DEPTH * 2 * 32; j += F.G) s5_tables_job(F, j >> 6, (j >> 5) & 1, j & 31); }
    else if constexpr (PH == PH_PRO_B) phase_pro_b(F);
    else if constexpr (PH == PH_PRO_C) phase_pro_c(F);
    else {
        constexpr int l = (PH - PH_L0) / NPH_L, sp = (PH - PH_L0) % NPH_L;
        if constexpr (sp == 0) {
            pg8::Gemm g{WSP(bf16, WS_HMOD), WSP(bf16, WS_WIN) + (size_t)l * NIN * DM, MT, NIN, DM}; pg8::StaticOrder S; S.init(MT, NIN, F.G, F.bid);
            pg8::EpiIn E{WSP(bf16, WS_P), WSP(float, WS_DT)};
            pg8::gemm_phase<pg8::EpiIn, pg8::StaticOrder, true, true>(F.lds, g, S, E);
        } else if constexpr (sp == 1) {
            for (int j = F.bid; j < 136 + 32 * 17; j += F.G) { if (j < 136) ssd_state_job(F, l, j >> 1, j & 1); else s5_state_job(F, l, (j - 136) % 32, (j - 136) / 32); }
            for (int j = F.bid; j < 68 * 4; j += F.G) sg_oracle_job(F, l, j >> 2, j & 3);
            for (int j = F.bid; j < 272 * 4; j += F.G) pool_oracle_job(F, l, j >> 2, j & 3);
        } else if constexpr (sp == 2) {
            if (F.bid < 128) ssd_scan(F, F.bid * NTHREADS + F.tid);
            else if (F.bid < 144) s5_scan(F, l, (F.bid - 128) * NTHREADS + F.tid);
        } else if constexpr (sp == 3) {
            constexpr int NSSD = (l == DEPTH - 1) ? 128 : 136, NS5 = 32 * ((l == DEPTH - 1) ? 16 : 17);
            for (int j = F.bid; j < NSSD + NS5; j += F.G) { if (j < NSSD) ssd_y_job(F, l, j >> 1, j & 1); else s5_out_job(F, l, (j - NSSD) % 32, (j - NSSD) / 32); }
        } else if constexpr (sp == 4) {
            pg8::Gemm g{WSP(bf16, WS_Z), WSP(bf16, WS_WGLU) + (size_t)l * GW * GW, MT, GW, GW}; pg8::StaticOrder S; S.init(MT, GW, F.G, F.bid);
            pg8::EpiGlu E{WSP(bf16, WS_Z), WSP(bf16, WS_MIX), F.a->in[I_GLUB] + l * GW};
            pg8::gemm_phase<pg8::EpiGlu, pg8::StaticOrder, true, true>(F.lds, g, S, E);
        } else if constexpr (sp == 5) {
            pg8::Gemm g{WSP(bf16, WS_MIX), WSP(bf16, WS_WOUT) + (size_t)l * DM * DM, MT, DM, DM}; pg8::StaticOrder S; S.init(MT, DM, F.G, F.bid);
            pg8::EpiRes E{WSP(float, WS_H), mvec(F, l, 0, 2), 6 * DM};
            pg8::gemm_phase<pg8::EpiRes, pg8::StaticOrder, true, true>(F.lds, g, S, E);
        } else if constexpr (sp == 6) {
            phase_ln(F, F.a->in[I_LN1G] + l * DM, F.a->in[I_LN1B] + l * DM, l, 3, false);
        } else if constexpr (sp == 7) {
            pg8::Gemm g{WSP(bf16, WS_HMOD), WSP(bf16, WS_WUP) + (size_t)l * FF2 * DM, MT, FF2, DM}; pg8::StaticOrder S; S.init(MT, FF2, F.G, F.bid);
            pg8::EpiStore E{WSP(bf16, WS_GV), FF2};
            pg8::gemm_phase<pg8::EpiStore, pg8::StaticOrder, true, true>(F.lds, g, S, E);
        } else if constexpr (sp == 8) {
            ffn_act_oracle(F, l);
        } else if constexpr (sp == 9) {
            pg8::Gemm g{WSP(bf16, WS_ACT), WSP(bf16, WS_WDN) + (size_t)l * DM * FF, MT, DM, FF}; pg8::StaticOrder S; S.init(MT, DM, F.G, F.bid);
            pg8::EpiRes E{WSP(float, WS_H), mvec(F, l, 0, 5), 6 * DM};
            pg8::gemm_phase<pg8::EpiRes, pg8::StaticOrder, true, true>(F.lds, g, S, E);
        } else {
            constexpr bool fin = (l == DEPTH - 1);
            phase_ln(F, F.a->in[I_LN2G] + l * DM, F.a->in[I_LN2B] + l * DM, fin ? l : l + 1, 0, fin);
        }
    }
}
template <int PH, int HI>
__device__ __forceinline__ void run_range(LAS unsigned char* ldsp) {
    run_phase<PH>(ldsp);
    if constexpr (PH + 1 < HI) { cg::this_grid().sync(); run_range<PH + 1, HI>(ldsp); }
}
template <int LO, int HI>
__global__ void __launch_bounds__(NTHREADS, 2) mk_fwd(Args args) {
    extern __shared__ __attribute__((aligned(16))) unsigned char lds[];
    run_range<LO, HI>((LAS unsigned char*)lds);
}

#ifndef MK_ONE_LAUNCH
#define MK_ONE_LAUNCH 1
#endif
template <int PH> static void launch_phases(const Args& a, int grid, hipStream_t stream) {
    hipFuncSetAttribute((const void*)mk_fwd<PH, PH + 1>, hipFuncAttributeMaxDynamicSharedMemorySize, LDS_BYTES);
    hipLaunchKernelGGL((mk_fwd<PH, PH + 1>), dim3(grid), dim3(NTHREADS), LDS_BYTES, stream, a);
    if constexpr (PH + 1 < N_PHASES) launch_phases<PH + 1>(a, grid, stream);
}

extern "C" void kernel_launch(void* const* d_in, const int* in_sizes, int n_in, void* d_out, int out_size, void* d_ws, size_t ws_size, hipStream_t stream) {
    static int grid = 0;
    if (grid == 0) {
        if (n_in != N_IN || out_size != ML * DM || ws_size < WS_END) { fprintf(stderr, "kernel_launch: unexpected shapes n_in %d out %d ws %zu (need %zu)\n", n_in, out_size, ws_size, (size_t)WS_END); grid = -1; return; }
        int dev = 0, cus = 0;
        (void)hipGetDevice(&dev); (void)hipDeviceGetAttribute(&cus, hipDeviceAttributeMultiprocessorCount, dev);
#if MK_ONE_LAUNCH
        int per_cu = 0;
        if (hipFuncSetAttribute((const void*)mk_fwd<0, N_PHASES>, hipFuncAttributeMaxDynamicSharedMemorySize, LDS_BYTES) != hipSuccess) { fprintf(stderr, "hipFuncSetAttribute failed\n"); grid = -1; return; }
        (void)hipOccupancyMaxActiveBlocksPerMultiprocessor(&per_cu, (const void*)mk_fwd<0, N_PHASES>, NTHREADS, LDS_BYTES);
        (void)hipGetLastError();
        fprintf(stderr, "kernel_launch: cus %d per_cu %d\n", cus, per_cu);
        if (per_cu < 1) { grid = -1; return; }
#endif
        grid = cus;
    }
    if (grid < 0) return;
    Args a{};
    for (int i = 0; i < N_IN; ++i) a.in[i] = (const float*)d_in[i];
    a.out = (float*)d_out; a.ws = (unsigned char*)d_ws;
#if MK_ONE_LAUNCH
    void* kargs[] = {&a};
    hipError_t e = hipLaunchCooperativeKernel((const void*)mk_fwd<0, N_PHASES>, dim3(grid), dim3(NTHREADS), kargs, LDS_BYTES, stream);
    if (e != hipSuccess) fprintf(stderr, "cooperative launch failed: %s\n", hipGetErrorString(e));
#else
    launch_phases<0>(a, grid, stream);
#endif
}
```

```cpp
#include <hip/hip_runtime.h>
#include <hip/hip_cooperative_groups.h>
#include <cstdio>
#include <cstdint>
namespace cg = cooperative_groups;
namespace pg8 {
#define PG8_LAS __attribute__((address_space(3)))
typedef unsigned short bf16_t;
typedef short bf16x8 __attribute__((ext_vector_type(8)));
typedef float f32x4 __attribute__((ext_vector_type(4)));
typedef unsigned u32x4 __attribute__((ext_vector_type(4)));
constexpr int BM = 256, BK = 64, HALF = 128, HTB = HALF * BK * 2  , STAGE_BYTES = 8 * HTB, NXCD = 8, WGM = 8;

__host__ __device__ __forceinline__ int lds_byte(int r, int c) { const int st = (r >> 4) * 2 + (c >> 5), rr = r & 15, cc = c & 31, ob = rr * 64 + cc * 2; return st * 1024 + (ob ^ (((ob >> 9) & 1) << 5)); }
__host__ __device__ __forceinline__ void stage_rc(int b, int& R, int& C) { const int st = b / 1024, sb = b % 1024, swz = sb ^ (((sb >> 9) & 1) << 5); R = (st >> 1) * 16 + swz / 64; C = (st & 1) * 32 + (swz % 64) / 2; }
__host__ __device__ __forceinline__ int perm32(int rho) { const int n = rho >> 4, i = rho & 15; return 8 * (i >> 2) + 4 * n + (i & 3); }

struct Unit { int pm, pn; };
struct Gemm { const bf16_t* A; const bf16_t* Bt; int M, N, K; };

struct StaticOrder {
    int nM, nN, nwg, G, c;
    __host__ __device__ void init(int M, int N, int G_, int c_) { nM = M / BM; nN = N / BM; nwg = nM * nN; G = G_; c = c_; }
    __host__ __device__ bool next(int i, Unit& u) const {
        const long L = (long)i * G + c; if (L >= nwg) return false;
        int wgid = (int)L; { const int q = nwg / NXCD, r = nwg % NXCD, xcd = wgid % NXCD, off = wgid / NXCD; wgid = (xcd < r ? xcd * (q + 1) : r * (q + 1) + (xcd - r) * q) + off; }
        const int nig = WGM * nN, gid = wgid / nig, fm = gid * WGM, gsz = (nM - fm) < WGM ? (nM - fm) : WGM;
        u.pm = fm + ((wgid % nig) % gsz); u.pn = (wgid % nig) / gsz; return true;
    }
    __device__ __forceinline__ void a_ready(const Unit&) const {}
    __device__ __forceinline__ void done(const Unit&) const {}
};

__device__ __forceinline__ unsigned cvt_pk_bf16(float lo, float hi) { unsigned r; asm volatile("v_cvt_pk_bf16_f32 %0, %1, %2" : "=v"(r) : "v"(lo), "v"(hi)); return r; }
typedef float f32x2 __attribute__((ext_vector_type(2)));

template <class Epi, class Sched, bool ALIGN_EPI = false, bool SP2 = false>
__device__ __forceinline__ void gemm_phase(PG8_LAS unsigned char* lds, const Gemm g, const Sched& S, const Epi& E) {
    const int tid = threadIdx.x, wid = __builtin_amdgcn_readfirstlane(tid >> 6), lane = tid & 63, wr = wid >> 2, wc = wid & 3, fr = lane & 15, fq = lane >> 4;
    const int K = g.K, nt = K / BK;
    unsigned voffA[2], voffB[2];
#pragma unroll
    for (int i = 0; i < 2; ++i) { int R, C; stage_rc(tid * 16 + i * 8192, R, C); const int Rb = Epi::PERM ? ((R & ~31) + perm32(R & 31)) : R;
        voffA[i] = (unsigned)(R * K + C) * 2u; voffB[i] = (unsigned)(Rb * K + C) * 2u; }
    const size_t kstep = (size_t)(BK * 2);
    const size_t hstep = (size_t)HALF * K * 2;
    const size_t tstep = 2 * hstep;
    const unsigned ldsw = (unsigned)wid * 1024u;
    const int aoff = lds_byte(wr * 64 + fr, fq * 8), boff = lds_byte(wc * 32 + fr, fq * 8);
#define PG8_SA(b, h) (((b) * 2 + (h)) * HTB)
#define PG8_SB(b, h) ((4 + (b) * 2 + (h)) * HTB)
#define PG8_STAGE(bufoff, gbase, voff) do { _Pragma("unroll") for (int _i = 0; _i < 2; ++_i) \
        __builtin_amdgcn_global_load_lds((const unsigned*)((const char*)(gbase) + (voff)[_i]), (PG8_LAS unsigned*)(lds + (bufoff) + ldsw + _i * 8192), 16, 0, 0); } while (0)
#define PG8_LDA(dst, b, h) do { _Pragma("unroll") for (int m = 0; m < 4; ++m) _Pragma("unroll") for (int k = 0; k < 2; ++k) dst[m][k] = *(const PG8_LAS bf16x8*)(lds + PG8_SA(b, h) + aoff + m * 2048 + k * 1024); } while (0)
#define PG8_LDB(dst, b, h) do { _Pragma("unroll") for (int n = 0; n < 2; ++n) _Pragma("unroll") for (int k = 0; k < 2; ++k) dst[n][k] = *(const PG8_LAS bf16x8*)(lds + PG8_SB(b, h) + boff + n * 2048 + k * 1024); } while (0)
#define PG8_MMA(ai, bj, At, Bt) do { __builtin_amdgcn_s_setprio(1); _Pragma("unroll") for (int m = 0; m < 4; ++m) _Pragma("unroll") for (int n = 0; n < 2; ++n) _Pragma("unroll") for (int k = 0; k < 2; ++k) \
        acc[ai][bj][m][n] = __builtin_amdgcn_mfma_f32_16x16x32_bf16(Bt[n][k], At[m][k], acc[ai][bj][m][n], 0, 0, 0); __builtin_amdgcn_s_setprio(0); } while (0)
#define PG8_WAIT_V(n) asm volatile("s_waitcnt vmcnt(" #n ")" ::: "memory")
#define PG8_WAIT_L(n) asm volatile("s_waitcnt lgkmcnt(" #n ")" ::: "memory")
#define PG8_BAR __builtin_amdgcn_s_barrier()
#define PG8_SCHED __builtin_amdgcn_sched_barrier(0)
    Unit cur, nxt; int ui = 0;
    if (!S.next(0, cur)) return;
    f32x4 acc[2][2][4][2];
#pragma unroll
    for (int a = 0; a < 2; ++a)
#pragma unroll
        for (int b = 0; b < 2; ++b)
#pragma unroll
            for (int m = 0; m < 4; ++m)
#pragma unroll
                for (int n = 0; n < 2; ++n) acc[a][b][m][n] = (f32x4){0.f, 0.f, 0.f, 0.f};
    bf16x8 At[4][2], B0[2][2], B1[2][2];
    const char* cA = (const char*)g.A + (size_t)cur.pm * tstep; const char* cB = (const char*)g.Bt + (size_t)cur.pn * tstep;
    S.a_ready(cur);
    if constexpr (SP2) {
        PG8_STAGE(PG8_SB(0, 0), cB, voffB); PG8_STAGE(PG8_SB(0, 1), cB + hstep, voffB); PG8_STAGE(PG8_SA(0, 0), cA, voffA); PG8_STAGE(PG8_SA(0, 1), cA + hstep, voffA);
        if (wr == 1) PG8_BAR;
        PG8_WAIT_V(2); PG8_BAR;
        PG8_STAGE(PG8_SB(1, 0), cB + kstep, voffB); PG8_STAGE(PG8_SA(1, 0), cA + kstep, voffA); PG8_STAGE(PG8_SB(1, 1), cB + hstep + kstep, voffB);
        PG8_WAIT_V(6); PG8_BAR;
    } else {
        PG8_STAGE(PG8_SB(0, 0), cB, voffB); PG8_STAGE(PG8_SA(0, 0), cA, voffA); PG8_STAGE(PG8_SB(0, 1), cB + hstep, voffB); PG8_STAGE(PG8_SA(0, 1), cA + hstep, voffA);
        if (wr == 1) PG8_BAR;
        PG8_WAIT_V(4); PG8_BAR;
        PG8_STAGE(PG8_SB(1, 0), cB + kstep, voffB); PG8_STAGE(PG8_SA(1, 0), cA + kstep, voffA); PG8_STAGE(PG8_SB(1, 1), cB + hstep + kstep, voffB);
        PG8_WAIT_V(6); PG8_BAR;
    }
    for (;;) {
        const bool has_next = S.next(ui + 1, nxt);
        const char* nA = has_next ? (const char*)g.A + (size_t)nxt.pm * tstep : cA; const char* nB = has_next ? (const char*)g.Bt + (size_t)nxt.pn * tstep : cB;
        for (int t = 0; t < nt; t += 2) {
            const bool last = (t == nt - 2);
            const char* a1 = cA + (size_t)(t + 1) * kstep;
            const char* a2 = last ? nA : cA + (size_t)(t + 2) * kstep; const char* b2 = last ? nB : cB + (size_t)(t + 2) * kstep;
            const char* a3 = a2 + kstep; const char* b3 = b2 + kstep;
            if (last && has_next) S.a_ready(nxt);
            if constexpr (SP2) {
            PG8_LDB(B0, 0, 0); PG8_LDB(B1, 0, 1); PG8_SCHED; PG8_LDA(At, 0, 0); PG8_STAGE(PG8_SA(1, 1), a1 + hstep, voffA);
            PG8_WAIT_V(8); PG8_WAIT_L(0); PG8_BAR; PG8_MMA(0, 0, At, B0); PG8_MMA(0, 1, At, B1); PG8_BAR; PG8_SCHED;
            PG8_LDA(At, 0, 1); PG8_STAGE(PG8_SB(0, 0), b2, voffB); PG8_STAGE(PG8_SB(0, 1), b2 + hstep, voffB); PG8_STAGE(PG8_SA(0, 0), a2, voffA);
            PG8_WAIT_V(8); PG8_WAIT_L(0); PG8_BAR; PG8_MMA(1, 0, At, B0); PG8_MMA(1, 1, At, B1); PG8_BAR; PG8_SCHED;
            PG8_LDB(B0, 1, 0); PG8_LDB(B1, 1, 1); PG8_SCHED; PG8_LDA(At, 1, 0); PG8_STAGE(PG8_SA(0, 1), a2 + hstep, voffA);
            PG8_WAIT_V(8); PG8_WAIT_L(0); PG8_BAR; PG8_MMA(0, 0, At, B0); PG8_MMA(0, 1, At, B1); PG8_BAR; PG8_SCHED;
            PG8_LDA(At, 1, 1); PG8_STAGE(PG8_SB(1, 0), b3, voffB); PG8_STAGE(PG8_SB(1, 1), b3 + hstep, voffB); PG8_STAGE(PG8_SA(1, 0), a3, voffA);
            PG8_WAIT_V(8); PG8_WAIT_L(0); PG8_BAR; PG8_MMA(1, 0, At, B0); PG8_MMA(1, 1, At, B1); PG8_BAR; PG8_SCHED;
            } else {
            PG8_LDB(B0, 0, 0); PG8_SCHED; PG8_LDA(At, 0, 0); PG8_STAGE(PG8_SA(1, 1), a1 + hstep, voffA);
            PG8_WAIT_L(8); PG8_BAR; PG8_WAIT_L(0); PG8_MMA(0, 0, At, B0); PG8_BAR; PG8_SCHED;
            PG8_LDB(B1, 0, 1); PG8_STAGE(PG8_SB(0, 0), b2, voffB);
            PG8_BAR; PG8_WAIT_L(0); PG8_MMA(0, 1, At, B1); PG8_BAR;
            PG8_LDA(At, 0, 1); PG8_STAGE(PG8_SA(0, 0), a2, voffA);
            PG8_BAR; PG8_WAIT_L(0); PG8_MMA(1, 0, At, B0); PG8_BAR; PG8_SCHED;
            PG8_STAGE(PG8_SB(0, 1), b2 + hstep, voffB);
            PG8_WAIT_V(6); PG8_BAR; PG8_MMA(1, 1, At, B1); PG8_BAR;
            PG8_LDB(B0, 1, 0); PG8_SCHED; PG8_LDA(At, 1, 0); PG8_STAGE(PG8_SA(0, 1), a2 + hstep, voffA);
            PG8_WAIT_L(8); PG8_BAR; PG8_WAIT_L(0); PG8_MMA(0, 0, At, B0); PG8_BAR; PG8_SCHED;
            PG8_LDB(B1, 1, 1); PG8_STAGE(PG8_SB(1, 0), b3, voffB);
            PG8_BAR; PG8_WAIT_L(0); PG8_MMA(0, 1, At, B1); PG8_BAR;
            PG8_LDA(At, 1, 1); PG8_STAGE(PG8_SA(1, 0), a3, voffA);
            PG8_BAR; PG8_WAIT_L(0); PG8_MMA(1, 0, At, B0); PG8_BAR; PG8_SCHED;
            PG8_STAGE(PG8_SB(1, 1), b3 + hstep, voffB);
            PG8_WAIT_V(6); PG8_BAR; PG8_MMA(1, 1, At, B1); PG8_BAR;
            }
        }
        if constexpr (ALIGN_EPI) { if (wr == 0) PG8_BAR; }
        if constexpr (!Epi::AFTER_DRAIN) { E(acc, cur, wr, wc, fr, fq); S.done(cur); }
        if (!has_next) break;
#pragma unroll
        for (int a = 0; a < 2; ++a)
#pragma unroll
            for (int b = 0; b < 2; ++b)
#pragma unroll
                for (int m = 0; m < 4; ++m)
#pragma unroll
                    for (int n = 0; n < 2; ++n) acc[a][b][m][n] = (f32x4){0.f, 0.f, 0.f, 0.f};
        cur = nxt; cA = nA; cB = nB; ++ui;
        if constexpr (ALIGN_EPI) { if (wr == 1) PG8_BAR; }
    }
    PG8_WAIT_V(0);
    if constexpr (!ALIGN_EPI) { if (wr == 0) PG8_BAR; }
    PG8_BAR;
    if constexpr (Epi::AFTER_DRAIN) { E.fused(acc, cur, wr, wc, fr, fq, lds, wid, lane); S.done(cur); }
#undef PG8_SA
#undef PG8_SB
#undef PG8_STAGE
#undef PG8_LDA
#undef PG8_LDB
#undef PG8_MMA
#undef PG8_WAIT_V
#undef PG8_WAIT_L
#undef PG8_BAR
#undef PG8_SCHED
}
}


constexpr int DM = 2048, NB = 2, SEQL = 4096, CTXL = 256, DEPTH = 2;
constexpr int ML = NB * SEQL, MC = NB * CTXL, MT = ML + MC;
constexpr int NIN = 3840, NINR = 3600;
constexpr int FF = 5632, FF2 = 11264;
constexpr int GW = 512;
constexpr float ALPHA = 1.4142135623730951f;
constexpr float LN_EPS = 1e-5f, RMS_EPS = 1e-5f;
constexpr int ADA_KS = 16;
constexpr int PC_S5 = 0, PC_SGU = 512, PC_SGV = 1024, PC_POOL = 1536, PC_Z = 2048, PC_XBC = 2560, PC_DT = 3584;
constexpr int MX_S5 = 0, MX_SG = 512, MX_POOL = 1024, MX_SSD = 1536;

enum { I_X = 0, I_C, I_CTX, I_CCTX, I_WADA, I_BADA, I_WIN, I_WOUT, I_LN1G, I_LN1B, I_LN2G, I_LN2B,
       I_S5ARE, I_S5AIM, I_S5BRE, I_S5BIM, I_S5CRE, I_S5CIM, I_S5LS, I_S5D, I_GLUW, I_GLUB,
       I_SGLNG, I_SGLNB, I_SGW, I_SGB, I_POOLW, I_POOLB, I_POOLS,
       I_M2CW, I_M2CB, I_M2DTB, I_M2ALOG, I_M2D, I_M2NW,
       I_WUP, I_FCW, I_FCB, I_WDN, N_IN };

constexpr size_t MiB = 1u << 20;
constexpr size_t WS_CTL = 0;
constexpr size_t WS_MADA = 1 * MiB;
constexpr size_t WS_MPART = 2 * MiB;
constexpr size_t WS_SGWB = 7 * MiB;
constexpr size_t WS_POOLWT = 7 * MiB + 512 * 1024;
constexpr size_t WS_WIN = 8 * MiB;
constexpr size_t WS_WOUT = 40 * MiB;
constexpr size_t WS_WUP = 56 * MiB;
constexpr size_t WS_WDN = 144 * MiB;
constexpr size_t WS_WGLU = 188 * MiB;
constexpr size_t WS_H = 190 * MiB;
constexpr size_t WS_HMOD = 258 * MiB;
constexpr size_t WS_P = 292 * MiB;
constexpr size_t WS_DT = 356 * MiB;
constexpr size_t WS_DTS = 357 * MiB;
constexpr size_t WS_MIX = 358 * MiB;
constexpr size_t WS_Z = 392 * MiB;
constexpr size_t WS_Y5 = 401 * MiB;
constexpr size_t WS_XC = 418 * MiB;
constexpr size_t WS_YD = 452 * MiB;
constexpr size_t WS_GV = 486 * MiB;
constexpr size_t WS_ACT = WS_P;
constexpr size_t WS_S5KT = 673 * MiB;
constexpr size_t WS_S5WS = 676 * MiB;
constexpr size_t WS_S5WC = 692 * MiB;
constexpr size_t WS_S5AQ = 708 * MiB;
constexpr size_t WS_S5S = WS_Y5;
constexpr size_t WS_S5HIN = WS_Y5 + 10 * MiB;
constexpr size_t WS_SST = 709 * MiB;
constexpr size_t WS_SHIN = 743 * MiB;
constexpr size_t WS_SDEC = 760 * MiB;
constexpr size_t WS_END = 767 * MiB;
constexpr int S5Q = 32, S5NCH = MT / S5Q;

constexpr int NWAVES = 8, NTHREADS = 512;
constexpr int LDS_BYTES = 163840;

#define GAS __attribute__((address_space(1)))
#define LAS __attribute__((address_space(3)))
typedef unsigned short bf16;
typedef unsigned v4u __attribute__((ext_vector_type(4)));
typedef unsigned v2u __attribute__((ext_vector_type(2)));
typedef float f32x4 __attribute__((ext_vector_type(4)));

__device__ __forceinline__ unsigned f2bf(float f) { unsigned u = __builtin_bit_cast(unsigned, f); return (u + 0x7fffu + ((u >> 16) & 1u)) >> 16; }
__device__ __forceinline__ unsigned pk2(float lo, float hi) { return f2bf(lo) | (f2bf(hi) << 16); }
__device__ __forceinline__ float bf2f(unsigned short h) { return __builtin_bit_cast(float, (unsigned)h << 16); }
__device__ __forceinline__ float bflo(unsigned w) { return __builtin_bit_cast(float, w << 16); }
__device__ __forceinline__ float bfhi(unsigned w) { return __builtin_bit_cast(float, w & 0xffff0000u); }
__device__ __forceinline__ float sigmoidf_(float x) { return 1.f / (1.f + __expf(-x)); }
__device__ __forceinline__ float siluf_(float x) { return x * sigmoidf_(x); }
__device__ __forceinline__ float gelu_tanh(float x) {
    const float u = 0.7978845608028654f * (x + 0.044715f * x * x * x);
    const float t = 1.f - 2.f / (1.f + __expf(2.f * u));
    return 0.5f * x * (1.f + t);
}
__device__ __forceinline__ float softplusf_(float x) { return x > 20.f ? x : log1pf(expf(x)); }
__device__ __forceinline__ float wave_sum(float v) {
#pragma unroll
    for (int o = 1; o < 64; o <<= 1) v += __shfl_xor(v, o);
    return v;
}

namespace pg8 {
struct EpiIn {
    static constexpr bool PERM = true, AFTER_DRAIN = false;
    bf16_t* P; float* DT;
    __device__ __forceinline__ void operator()(const f32x4 (&acc)[2][2][4][2], const Unit& u, int wr, int wc, int fr, int fq) const {
        const int row0 = u.pm * BM + wr * 64 + fr;
        if (u.pn == 14) {
            if (wc == 0 && fq < 2) {
#pragma unroll
                for (int ai = 0; ai < 2; ++ai)
#pragma unroll
                    for (int m = 0; m < 4; ++m) { float* d = DT + (size_t)(row0 + ai * HALF + m * 16) * 16 + 8 * fq;
                        *(f32x4*)(d) = acc[ai][0][m][0]; *(f32x4*)(d + 4) = acc[ai][0][m][1]; }
            }
            return;
        }
        const int col0 = u.pn * BM + wc * 32 + 8 * fq;
#pragma unroll
        for (int ai = 0; ai < 2; ++ai)
#pragma unroll
            for (int m = 0; m < 4; ++m) { bf16_t* rowp = P + (size_t)(row0 + ai * HALF + m * 16) * NIN + col0;
#pragma unroll
                for (int bj = 0; bj < 2; ++bj) { const f32x4 v0 = acc[ai][bj][m][0], v1 = acc[ai][bj][m][1];
                    u32x4 w; w.x = cvt_pk_bf16(v0[0], v0[1]); w.y = cvt_pk_bf16(v0[2], v0[3]); w.z = cvt_pk_bf16(v1[0], v1[1]); w.w = cvt_pk_bf16(v1[2], v1[3]);
                    *(u32x4*)(rowp + bj * HALF) = w; } }
    }
};
struct EpiStore {
    static constexpr bool PERM = true, AFTER_DRAIN = false;
    bf16_t* O; int ldc;
    __device__ __forceinline__ void operator()(const f32x4 (&acc)[2][2][4][2], const Unit& u, int wr, int wc, int fr, int fq) const {
        const int row0 = u.pm * BM + wr * 64 + fr, col0 = u.pn * BM + wc * 32 + 8 * fq;
#pragma unroll
        for (int ai = 0; ai < 2; ++ai)
#pragma unroll
            for (int m = 0; m < 4; ++m) { bf16_t* rowp = O + (size_t)(row0 + ai * HALF + m * 16) * ldc + col0;
#pragma unroll
                for (int bj = 0; bj < 2; ++bj) { const f32x4 v0 = acc[ai][bj][m][0], v1 = acc[ai][bj][m][1];
                    u32x4 w; w.x = cvt_pk_bf16(v0[0], v0[1]); w.y = cvt_pk_bf16(v0[2], v0[3]); w.z = cvt_pk_bf16(v1[0], v1[1]); w.w = cvt_pk_bf16(v1[2], v1[3]);
                    *(u32x4*)(rowp + bj * HALF) = w; } }
    }
};
struct EpiGlu {
    static constexpr bool PERM = true, AFTER_DRAIN = false;
    const bf16_t* Z; bf16_t* O; const float* bias;
    __device__ __forceinline__ void operator()(const f32x4 (&acc)[2][2][4][2], const Unit& u, int wr, int wc, int fr, int fq) const {
        const int row0 = u.pm * BM + wr * 64 + fr, col0 = u.pn * BM + wc * 32 + 8 * fq;
#pragma unroll
        for (int ai = 0; ai < 2; ++ai)
#pragma unroll
            for (int m = 0; m < 4; ++m) { const int row = row0 + ai * HALF + m * 16;
#pragma unroll
                for (int bj = 0; bj < 2; ++bj) { const int col = col0 + bj * HALF;
                    const u32x4 zz = *(const u32x4*)(Z + (size_t)row * GW + col);
                    const f32x4 b0 = *(const f32x4*)(bias + col), b1 = *(const f32x4*)(bias + col + 4);
                    const f32x4 v0 = acc[ai][bj][m][0] + b0, v1 = acc[ai][bj][m][1] + b1;
                    float o[8];
                    o[0] = bflo(zz.x) * sigmoidf_(v0[0]); o[1] = bfhi(zz.x) * sigmoidf_(v0[1]); o[2] = bflo(zz.y) * sigmoidf_(v0[2]); o[3] = bfhi(zz.y) * sigmoidf_(v0[3]);
                    o[4] = bflo(zz.z) * sigmoidf_(v1[0]); o[5] = bfhi(zz.z) * sigmoidf_(v1[1]); o[6] = bflo(zz.w) * sigmoidf_(v1[2]); o[7] = bfhi(zz.w) * sigmoidf_(v1[3]);
                    u32x4 w; w.x = cvt_pk_bf16(o[0], o[1]); w.y = cvt_pk_bf16(o[2], o[3]); w.z = cvt_pk_bf16(o[4], o[5]); w.w = cvt_pk_bf16(o[6], o[7]);
                    *(u32x4*)(O + (size_t)row * DM + col) = w; } }
    }
};
struct EpiRes {
    static constexpr bool PERM = false, AFTER_DRAIN = false;
    float* H; const float* gate; int vstride;
    __device__ __forceinline__ void operator()(const f32x4 (&acc)[2][2][4][2], const Unit& u, int wr, int wc, int fr, int fq) const {
        const int row0 = u.pm * BM + wr * 64 + fr, col0 = u.pn * BM + wc * 32 + 4 * fq;
        const int var = u.pm < 16 ? 0 : (u.pm < 32 ? 1 : 2);
        const float* gv = gate + (size_t)var * vstride;
#pragma unroll
        for (int bj = 0; bj < 2; ++bj)
#pragma unroll
            for (int n = 0; n < 2; ++n) { const int col = col0 + bj * HALF + n * 16; const f32x4 g4 = *(const f32x4*)(gv + col);
#pragma unroll
                for (int ai = 0; ai < 2; ++ai)
#pragma unroll
                    for (int m = 0; m < 4; ++m) { float* p = H + (size_t)(row0 + ai * HALF + m * 16) * DM + col;
                        const f32x4 hv = *(const f32x4*)p; *(f32x4*)p = hv * ALPHA + g4 * acc[ai][bj][m][n]; } }
    }
};
}

struct Args { const float* in[N_IN]; float* out; unsigned char* ws; };

struct Frame {
    LAS unsigned char* lds;
    int tid, lane, wave, bid, G;
    const __attribute__((address_space(4))) Args* a;
};
#define WSP(T, off) ((T*)(F.a->ws + (off)))

__device__ __forceinline__ void row_seq(int row, int& base, int& t, int& len) {
    if (row < ML) { base = row & ~(SEQL - 1); t = row & (SEQL - 1); len = SEQL; }
    else { base = ML + ((row - ML) & ~(CTXL - 1)); t = (row - ML) & (CTXL - 1); len = CTXL; }
}
__device__ __forceinline__ int proc_row(int q, int dir, int b) {
    if (q < CTXL) { const int t = dir ? (CTXL - 1 - q) : q; return ML + b * CTXL + t; }
    const int ql = q - CTXL; const int t = dir ? (SEQL - 1 - ql) : ql; return b * SEQL + t;
}

__device__ __forceinline__ void transpose_item(const float* W, int K, int N, bf16* WT, LAS float* scr, int item, int nblk, int lane) {
    const int kb = item / nblk, nb = item % nblk, k0 = 64 * kb, n0 = 32 * nb;
    const int nn = n0 + (lane & 31);
#pragma unroll 8
    for (int i = 0; i < 32; ++i) { const int kk = 2 * i + (lane >> 5); scr[kk * 33 + (lane & 31)] = (nn < N) ? W[(size_t)(k0 + kk) * N + nn] : 0.f; }
    asm volatile("s_waitcnt lgkmcnt(0)" ::: "memory");
    const int c = lane & 7;
#pragma unroll
    for (int j = 0; j < 4; ++j) { const int n = (lane >> 3) + 8 * j; const LAS float* s = scr + (8 * c) * 33 + n;
        v4u o; o.x = pk2(s[0 * 33], s[1 * 33]); o.y = pk2(s[2 * 33], s[3 * 33]); o.z = pk2(s[4 * 33], s[5 * 33]); o.w = pk2(s[6 * 33], s[7 * 33]);
        *(v4u*)(WT + (size_t)(n0 + n) * K + k0 + 8 * c) = o; }
    asm volatile("s_waitcnt lgkmcnt(0)" ::: "memory");
}

__device__ __forceinline__ void phase_pro_a(Frame& F) {
    LAS float* scr = (LAS float*)(F.lds + F.wave * 16384);
    const int gw = F.bid * NWAVES + F.wave, NGW = F.G * NWAVES;
    constexpr int I_IN = (DM / 64) * (NIN / 32), I_OUT = (DM / 64) * (DM / 32), I_UP = (DM / 64) * (FF2 / 32), I_DN = (FF / 64) * (DM / 32), I_GL = (GW / 64) * (GW / 32);
    constexpr int PER_L = I_IN + I_OUT + I_UP + I_DN + I_GL;
    for (int it = gw; it < DEPTH * PER_L; it += NGW) {
        const int l = it / PER_L; int r = it % PER_L;
        if (r < I_IN) { transpose_item(F.a->in[I_WIN] + (size_t)l * DM * NINR, DM, NINR, WSP(bf16, WS_WIN) + (size_t)l * NIN * DM, scr, r, NIN / 32, F.lane); continue; } r -= I_IN;
        if (r < I_OUT) { transpose_item(F.a->in[I_WOUT] + (size_t)l * DM * DM, DM, DM, WSP(bf16, WS_WOUT) + (size_t)l * DM * DM, scr, r, DM / 32, F.lane); continue; } r -= I_OUT;
        if (r < I_UP) { transpose_item(F.a->in[I_WUP] + (size_t)l * DM * FF2, DM, FF2, WSP(bf16, WS_WUP) + (size_t)l * FF2 * DM, scr, r, FF2 / 32, F.lane); continue; } r -= I_UP;
        if (r < I_DN) { transpose_item(F.a->in[I_WDN] + (size_t)l * FF * DM, FF, DM, WSP(bf16, WS_WDN) + (size_t)l * DM * FF, scr, r, DM / 32, F.lane); continue; } r -= I_DN;
        transpose_item(F.a->in[I_GLUW] + (size_t)l * GW * GW, GW, GW, WSP(bf16, WS_WGLU) + (size_t)l * GW * GW, scr, r, GW / 32, F.lane);
    }
    constexpr int NCB = 6 * DM / 256, KSL = DM / ADA_KS;
    const float* c = F.a->in[I_C]; const float* cc = F.a->in[I_CCTX];
    for (int job = gw; job < DEPTH * NCB * ADA_KS; job += NGW) {
        const int l = job / (NCB * ADA_KS), r = job % (NCB * ADA_KS), cb = r / ADA_KS, ks = r % ADA_KS;
        const float* W = F.a->in[I_WADA] + (size_t)l * DM * 6 * DM + cb * 256 + F.lane * 4;
        f32x4 a0 = {0.f, 0.f, 0.f, 0.f}, a1 = a0, a2 = a0;
#pragma unroll 4
        for (int k = ks * KSL; k < (ks + 1) * KSL; ++k) {
            const f32x4 w = *(const f32x4*)(W + (size_t)k * 6 * DM);
            const float s0 = siluf_(c[k]), s1 = siluf_(c[DM + k]), s2 = siluf_(cc[k]);
            a0 += w * s0; a1 += w * s1; a2 += w * s2;
        }
        float* mp = WSP(float, WS_MPART) + ((size_t)(l * ADA_KS + ks) * 3) * 6 * DM + cb * 256 + F.lane * 4;
        *(f32x4*)(mp) = a0; *(f32x4*)(mp + 6 * DM) = a1; *(f32x4*)(mp + 2 * 6 * DM) = a2;
    }
}

__device__ __forceinline__ void phase_pro_b(Frame& F) {
    const int gt = F.bid * NTHREADS + F.tid, NGT = F.G * NTHREADS;
    for (int i = gt; i < DEPTH * 3 * 6 * DM; i += NGT) {
        const int l = i / (3 * 6 * DM), r = i % (3 * 6 * DM), v = r / (6 * DM), n = r % (6 * DM);
        float s = F.a->in[I_BADA][l * 6 * DM + n];
        const float* mp = WSP(float, WS_MPART) + ((size_t)(l * ADA_KS) * 3 + v) * 6 * DM + n;
#pragma unroll
        for (int ks = 0; ks < ADA_KS; ++ks) s += mp[(size_t)ks * 3 * 6 * DM];
        WSP(float, WS_MADA)[i] = s;
    }
}
__device__ __forceinline__ const float* mvec(Frame& F, int l, int v, int j) { return WSP(float, WS_MADA) + ((size_t)(l * 3 + v) * 6 + j) * DM; }
__device__ __forceinline__ int row_var(int row) { return row < SEQL ? 0 : (row < ML ? 1 : 2); }

template <bool DO_LN>
__device__ __forceinline__ void row_pass(Frame& F, const float* srcrow, const float* g, const float* b, float* dstrow, bf16* modrow, const float* shift, const float* scale) {
    f32x4 v[8];
#pragma unroll
    for (int j = 0; j < 8; ++j) v[j] = *(const f32x4*)(srcrow + j * 256 + F.lane * 4);
    if (DO_LN) {
        float s = 0.f;
#pragma unroll
        for (int j = 0; j < 8; ++j) s += (v[j][0] + v[j][1]) + (v[j][2] + v[j][3]);
        const float mean = wave_sum(s) * (1.f / DM); float s2 = 0.f;
#pragma unroll
        for (int j = 0; j < 8; ++j) { v[j] = v[j] - mean; s2 += (v[j][0] * v[j][0] + v[j][1] * v[j][1]) + (v[j][2] * v[j][2] + v[j][3] * v[j][3]); }
        const float rstd = 1.f / sqrtf(wave_sum(s2) * (1.f / DM) + LN_EPS);
#pragma unroll
        for (int j = 0; j < 8; ++j) { const f32x4 gg = *(const f32x4*)(g + j * 256 + F.lane * 4), bb = *(const f32x4*)(b + j * 256 + F.lane * 4); v[j] = v[j] * rstd * gg + bb; }
    }
    if (dstrow) {
#pragma unroll
        for (int j = 0; j < 8; ++j) *(f32x4*)(dstrow + j * 256 + F.lane * 4) = v[j];
    }
    if (modrow) {
#pragma unroll
        for (int j = 0; j < 8; ++j) { const f32x4 sh = *(const f32x4*)(shift + j * 256 + F.lane * 4), sc = *(const f32x4*)(scale + j * 256 + F.lane * 4);
            const f32x4 o = v[j] * (sc + 1.f) + sh; v2u w; w.x = pk2(o[0], o[1]); w.y = pk2(o[2], o[3]);
            *(v2u*)(modrow + j * 256 + F.lane * 4) = w; }
    }
}
__device__ __forceinline__ void phase_pro_c(Frame& F) {
    const int gw = F.bid * NWAVES + F.wave, NGW = F.G * NWAVES;
    for (int row = gw; row < MT; row += NGW) {
        const float* src = row < ML ? F.a->in[I_X] + (size_t)row * DM : F.a->in[I_CTX] + (size_t)(row - ML) * DM;
        const int v = row_var(row);
        row_pass<false>(F, src, nullptr, nullptr, WSP(float, WS_H) + (size_t)row * DM, WSP(bf16, WS_HMOD) + (size_t)row * DM, mvec(F, 0, v, 0), mvec(F, 0, v, 1));
    }
}
__device__ __forceinline__ void phase_ln(Frame& F, const float* g, const float* b, int ml, int js, bool final_out, int nrows) {
    const int gw = F.bid * NWAVES + F.wave, NGW = F.G * NWAVES;
    for (int row = gw; row < nrows; row += NGW) {
        const int v = row_var(row);
        float* hrow = WSP(float, WS_H) + (size_t)row * DM;
        if (final_out) row_pass<true>(F, hrow, g, b, F.a->out + (size_t)row * DM, nullptr, nullptr, nullptr);
        else row_pass<true>(F, hrow, g, b, hrow, WSP(bf16, WS_HMOD) + (size_t)row * DM, mvec(F, ml, v, js), mvec(F, ml, v, js + 1));
    }
}

__device__ __forceinline__ void s5_oracle_job(Frame& F, int l, int b, int g) {
    LAS float* hb = (LAS float*)(F.lds);
    LAS float* cs = (LAS float*)(F.lds + 8192);
    const int p = F.lane;
    const bf16* P = WSP(bf16, WS_P);
    float* Y5 = WSP(float, WS_Y5); bf16* Z = WSP(bf16, WS_Z);
    for (int dir = 0; dir < 2; ++dir) {
        const int gi = (l * 2 + dir) * 32 + g;
        const float ar = F.a->in[I_S5ARE][gi * 64 + p], ai = F.a->in[I_S5AIM][gi * 64 + p];
        const float step = expf(F.a->in[I_S5LS][gi]);
        const float e = expf(ar * step); float sn, cn; sincosf(ai * step, &sn, &cn);
        const float abr = e * cn, abi = e * sn;
        const float den = ar * ar + ai * ai;
        const float qr = ((abr - 1.f) * ar + abi * ai) / den, qi = (abi * ar - (abr - 1.f) * ai) / den;
        float bbr[16], bbi[16];
#pragma unroll
        for (int h = 0; h < 16; ++h) { const float br = F.a->in[I_S5BRE][(size_t)(gi * 64 + p) * 16 + h], bi = F.a->in[I_S5BIM][(size_t)(gi * 64 + p) * 16 + h];
            bbr[h] = qr * br - qi * bi; bbi[h] = qr * bi + qi * br; }
        asm volatile("s_waitcnt lgkmcnt(0)" ::: "memory");
#pragma unroll
        for (int ho = 0; ho < 16; ++ho) { cs[(ho * 64 + p) * 2] = F.a->in[I_S5CRE][(size_t)(gi * 16 + ho) * 64 + p]; cs[(ho * 64 + p) * 2 + 1] = F.a->in[I_S5CIM][(size_t)(gi * 16 + ho) * 64 + p]; }
        float hr = 0.f, hi = 0.f;
        for (int blk = 0; blk < (CTXL + SEQL) / 16; ++blk) {
            for (int i = 0; i < 16; ++i) {
                const int row = proc_row(blk * 16 + i, dir, b);
                const v4u u0 = *(const v4u*)(P + (size_t)row * NIN + PC_S5 + g * 16), u1 = *(const v4u*)(P + (size_t)row * NIN + PC_S5 + g * 16 + 8);
                float u[16];
                u[0] = bflo(u0.x); u[1] = bfhi(u0.x); u[2] = bflo(u0.y); u[3] = bfhi(u0.y); u[4] = bflo(u0.z); u[5] = bfhi(u0.z); u[6] = bflo(u0.w); u[7] = bfhi(u0.w);
                u[8] = bflo(u1.x); u[9] = bfhi(u1.x); u[10] = bflo(u1.y); u[11] = bfhi(u1.y); u[12] = bflo(u1.z); u[13] = bfhi(u1.z); u[14] = bflo(u1.w); u[15] = bfhi(u1.w);
                float bur = 0.f, bui = 0.f;
#pragma unroll
                for (int h = 0; h < 16; ++h) { bur += bbr[h] * u[h]; bui += bbi[h] * u[h]; }
                const float nr = abr * hr - abi * hi + bur, ni = abr * hi + abi * hr + bui;
                hr = nr; hi = ni;
                hb[(i * 64 + p) * 2] = hr; hb[(i * 64 + p) * 2 + 1] = hi;
            }
            asm volatile("s_waitcnt lgkmcnt(0)" ::: "memory");
            {
                const int i = F.lane >> 2, ho4 = (F.lane & 3) * 4;
                float y[4] = {0.f, 0.f, 0.f, 0.f};
                for (int pp = 0; pp < 64; ++pp) { const float xr = hb[(i * 64 + pp) * 2], xi = hb[(i * 64 + pp) * 2 + 1];
#pragma unroll
                    for (int j = 0; j < 4; ++j) y[j] += xr * cs[((ho4 + j) * 64 + pp) * 2] - xi * cs[((ho4 + j) * 64 + pp) * 2 + 1]; }
                const int row = proc_row(blk * 16 + i, dir, b);
                float* yp = Y5 + (size_t)row * GW + g * 16 + ho4;
                if (dir == 0) { *(f32x4*)yp = (f32x4){y[0], y[1], y[2], y[3]}; }
                else {
                    const f32x4 yf = *(const f32x4*)yp;
                    const v2u uu = *(const v2u*)(P + (size_t)row * NIN + PC_S5 + g * 16 + ho4);
                    const float* dd = F.a->in[I_S5D] + l * GW + g * 16 + ho4;
                    const float z0 = gelu_tanh(yf[0] + y[0] + dd[0] * bflo(uu.x)), z1 = gelu_tanh(yf[1] + y[1] + dd[1] * bfhi(uu.x));
                    const float z2 = gelu_tanh(yf[2] + y[2] + dd[2] * bflo(uu.y)), z3 = gelu_tanh(yf[3] + y[3] + dd[3] * bfhi(uu.y));
                    v2u w; w.x = pk2(z0, z1); w.y = pk2(z2, z3);
                    *(v2u*)(Z + (size_t)row * GW + g * 16 + ho4) = w;
                }
            }
            asm volatile("s_waitcnt vmcnt(0) lgkmcnt(0)" ::: "memory");
        }
        asm volatile("s_waitcnt vmcnt(0) lgkmcnt(0)" ::: "memory");
    }
}

typedef short bf16x8v __attribute__((ext_vector_type(8)));
__device__ __forceinline__ size_t s5_gi(int l, int dir, int g) { return (size_t)((l * 2 + dir) * 32 + g); }
__device__ __forceinline__ void s5_tables_job(Frame& F, int l, int dir, int g) {
    LAS float* pw = (LAS float*)(F.lds);
    LAS float* bb = (LAS float*)(F.lds + 33 * 64 * 8);
    LAS float* cc = (LAS float*)(F.lds + 33 * 64 * 8 + 8192);
    const size_t gi = s5_gi(l, dir, g);
    __syncthreads();
    if (F.tid < 64) {
        const int p = F.tid;
        const float ar = F.a->in[I_S5ARE][gi * 64 + p], ai = F.a->in[I_S5AIM][gi * 64 + p];
        const float step = expf(F.a->in[I_S5LS][gi]);
        for (int n = 0; n <= S5Q; ++n) { const float e = expf(ar * step * (float)n); float sn, cn; sincosf(ai * step * (float)n, &sn, &cn); pw[(n * 64 + p) * 2] = e * cn; pw[(n * 64 + p) * 2 + 1] = e * sn; }
        const float e = expf(ar * step); float sn, cn; sincosf(ai * step, &sn, &cn);
        const float abr = e * cn, abi = e * sn, den = ar * ar + ai * ai;
        const float qr = ((abr - 1.f) * ar + abi * ai) / den, qi = (abi * ar - (abr - 1.f) * ai) / den;
        for (int h = 0; h < 16; ++h) { const float br = F.a->in[I_S5BRE][(gi * 64 + p) * 16 + h], bi = F.a->in[I_S5BIM][(gi * 64 + p) * 16 + h];
            bb[(p * 16 + h) * 2] = qr * br - qi * bi; bb[(p * 16 + h) * 2 + 1] = qr * bi + qi * br; }
        for (int ho = 0; ho < 16; ++ho) { cc[(ho * 64 + p) * 2] = F.a->in[I_S5CRE][(gi * 16 + ho) * 64 + p]; cc[(ho * 64 + p) * 2 + 1] = F.a->in[I_S5CIM][(gi * 16 + ho) * 64 + p]; }
        float* aq = WSP(float, WS_S5AQ) + (gi * 64 + p) * 2;
        const float eq = expf(ar * step * (float)S5Q); float snq, cnq; sincosf(ai * step * (float)S5Q, &snq, &cnq);
        aq[0] = eq * cnq; aq[1] = eq * snq;
    }
    __syncthreads();
    bf16* KT = WSP(bf16, WS_S5KT) + gi * 33 * 256;
    for (int e = F.tid; e < 33 * 256; e += NTHREADS) {
        const int tau = e / 256 - 1, ho = (e >> 4) & 15, hi = e & 15;
        float v = 0.f;
        if (tau >= 0) {
            for (int p = 0; p < 64; ++p) {
                const float cr = cc[(ho * 64 + p) * 2], ci = cc[(ho * 64 + p) * 2 + 1], pr = pw[(tau * 64 + p) * 2], pi = pw[(tau * 64 + p) * 2 + 1];
                const float xr = cr * pr - ci * pi, xi = cr * pi + ci * pr;
                v += xr * bb[(p * 16 + hi) * 2] - xi * bb[(p * 16 + hi) * 2 + 1];
            }
            if (dir == 0 && tau == 0 && ho == hi) v += F.a->in[I_S5D][l * GW + g * 16 + ho];
        }
        KT[e] = (bf16)f2bf(v);
    }
    bf16* WSt = WSP(bf16, WS_S5WS) + gi * 128 * 512;
    for (int e = F.tid; e < 128 * 512; e += NTHREADS) {
        const int p2 = e >> 9, sh = e & 511, sidx = sh >> 4, hi = sh & 15, p = p2 & 63;
        const int n = dir ? sidx : (S5Q - 1 - sidx);
        const float pr = pw[(n * 64 + p) * 2], pi = pw[(n * 64 + p) * 2 + 1], br = bb[(p * 16 + hi) * 2], bi = bb[(p * 16 + hi) * 2 + 1];
        const float v = (p2 < 64) ? (pr * br - pi * bi) : (pr * bi + pi * br);
        WSt[e] = (bf16)f2bf(v);
    }
    bf16* WCt = WSP(bf16, WS_S5WC) + gi * 512 * 128;
    for (int e = F.tid; e < 512 * 128; e += NTHREADS) {
        const int th = e >> 7, p2 = e & 127, t = th >> 4, ho = th & 15, p = p2 & 63;
        const int n = dir ? (S5Q - t) : (t + 1);
        const float pr = pw[(n * 64 + p) * 2], pi = pw[(n * 64 + p) * 2 + 1], cr = cc[(ho * 64 + p) * 2], ci = cc[(ho * 64 + p) * 2 + 1];
        const float v = (p2 < 64) ? (cr * pr - ci * pi) : -(cr * pi + ci * pr);
        WCt[e] = (bf16)f2bf(v);
    }
    __syncthreads();
}
__device__ __forceinline__ void s5_state_job(Frame& F, int l, int g, int cs) {
    const int col = F.lane & 15, kq = F.lane >> 4, mq = F.wave & 3, dir = F.wave >> 2;
    const int ch = cs * 16 + col; const size_t row0 = (size_t)ch * S5Q;
    const bf16* P = WSP(bf16, WS_P);
    bf16x8v U[16];
#pragma unroll
    for (int ks = 0; ks < 16; ++ks) U[ks] = *(const bf16x8v*)(P + (row0 + 2 * ks + (kq >> 1)) * NIN + PC_S5 + g * 16 + 8 * (kq & 1));
    const bf16* WSt = WSP(bf16, WS_S5WS) + s5_gi(l, dir, g) * 128 * 512;
    float* S = WSP(float, WS_S5S);
#pragma unroll
    for (int mt = 0; mt < 2; ++mt) {
        const int mtile = mq * 2 + mt;
        f32x4 acc = {0.f, 0.f, 0.f, 0.f};
        const bf16* ap = WSt + (size_t)(mtile * 16 + col) * 512 + kq * 8;
#pragma unroll
        for (int ks = 0; ks < 16; ++ks) { const bf16x8v A = *(const bf16x8v*)(ap + ks * 32); acc = __builtin_amdgcn_mfma_f32_16x16x32_bf16(A, U[ks], acc, 0, 0, 0); }
        *(f32x4*)(S + (((size_t)ch * 2 + dir) * 32 + g) * 128 + mtile * 16 + 4 * kq) = acc;
    }
}
__device__ __forceinline__ void s5_scan(Frame& F, int l, int idx) {
    const int p = idx & 63, g = (idx >> 6) & 31, dir = (idx >> 11) & 1, b = idx >> 12;
    const float* aq = WSP(float, WS_S5AQ) + (s5_gi(l, dir, g) * 64 + p) * 2;
    const float qr = aq[0], qi = aq[1];
    const float* S = WSP(float, WS_S5S); bf16* HIN = WSP(bf16, WS_S5HIN);
    float hr = 0.f, hi = 0.f;
    constexpr int NC = CTXL / S5Q, NL = SEQL / S5Q;
#pragma unroll 8
    for (int st = 0; st < NC + NL; ++st) {
        int ch;
        if (st < NC) ch = 256 + b * NC + (dir ? NC - 1 - st : st); else ch = b * NL + (dir ? NL - 1 - (st - NC) : (st - NC));
        const size_t o = (((size_t)ch * 2 + dir) * 32 + g) * 128 + p;
        const float sr = S[o], si = S[o + 64];
        HIN[o] = (bf16)f2bf(hr); HIN[o + 64] = (bf16)f2bf(hi);
        const float nr = qr * hr - qi * hi + sr, ni = qr * hi + qi * hr + si;
        hr = nr; hi = ni;
    }
}
__device__ __forceinline__ void s5_out_job(Frame& F, int l, int g, int cs) {
    const int col = F.lane & 15, kq = F.lane >> 4;
    const int ch = cs * 16 + col; const size_t row0 = (size_t)ch * S5Q;
    const bf16* P = WSP(bf16, WS_P);
    bf16x8v U[16], Hf[4], Hb[4];
#pragma unroll
    for (int ks = 0; ks < 16; ++ks) U[ks] = *(const bf16x8v*)(P + (row0 + 2 * ks + (kq >> 1)) * NIN + PC_S5 + g * 16 + 8 * (kq & 1));
    const bf16* HIN = WSP(bf16, WS_S5HIN);
#pragma unroll
    for (int k4 = 0; k4 < 4; ++k4) { Hf[k4] = *(const bf16x8v*)(HIN + (((size_t)ch * 2 + 0) * 32 + g) * 128 + k4 * 32 + kq * 8); Hb[k4] = *(const bf16x8v*)(HIN + (((size_t)ch * 2 + 1) * 32 + g) * 128 + k4 * 32 + kq * 8); }
    const bf16* KTf = WSP(bf16, WS_S5KT) + s5_gi(l, 0, g) * 33 * 256 + col * 16 + 8 * (kq & 1);
    const bf16* KTb = WSP(bf16, WS_S5KT) + s5_gi(l, 1, g) * 33 * 256 + col * 16 + 8 * (kq & 1);
    const bf16* WCf = WSP(bf16, WS_S5WC) + s5_gi(l, 0, g) * 512 * 128 + (size_t)col * 128 + kq * 8;
    const bf16* WCb = WSP(bf16, WS_S5WC) + s5_gi(l, 1, g) * 512 * 128 + (size_t)col * 128 + kq * 8;
    bf16* Z = WSP(bf16, WS_Z);
#pragma unroll 1
    for (int tt = 0; tt < 4; ++tt) {
        const int t = F.wave * 4 + tt;
        f32x4 acc = {0.f, 0.f, 0.f, 0.f};
#pragma unroll
        for (int ks = 0; ks < 16; ++ks) {
            const int sidx = 2 * ks + (kq >> 1);
            if (2 * ks <= t) { int tau = t - sidx; tau = tau < 0 ? -1 : tau; const bf16x8v A = *(const bf16x8v*)(KTf + (tau + 1) * 256); acc = __builtin_amdgcn_mfma_f32_16x16x32_bf16(A, U[ks], acc, 0, 0, 0); }
            if (2 * ks + 1 >= t) { int tau = sidx - t; tau = tau < 0 ? -1 : tau; const bf16x8v A = *(const bf16x8v*)(KTb + (tau + 1) * 256); acc = __builtin_amdgcn_mfma_f32_16x16x32_bf16(A, U[ks], acc, 0, 0, 0); }
        }
#pragma unroll
        for (int k4 = 0; k4 < 4; ++k4) {
            const bf16x8v A0 = *(const bf16x8v*)(WCf + (size_t)t * 16 * 128 + k4 * 32); acc = __builtin_amdgcn_mfma_f32_16x16x32_bf16(A0, Hf[k4], acc, 0, 0, 0);
            const bf16x8v A1 = *(const bf16x8v*)(WCb + (size_t)t * 16 * 128 + k4 * 32); acc = __builtin_amdgcn_mfma_f32_16x16x32_bf16(A1, Hb[k4], acc, 0, 0, 0);
        }
        v2u w; w.x = pk2(gelu_tanh(acc[0]), gelu_tanh(acc[1])); w.y = pk2(gelu_tanh(acc[2]), gelu_tanh(acc[3]));
        *(v2u*)(Z + (row0 + t) * GW + g * 16 + 4 * kq) = w;
    }
}

constexpr int SPITCH = 136;
constexpr int L_XT = 0, L_B = 256 * SPITCH * 2, L_C = L_B + 128 * SPITCH * 2, L_DTV = L_C + 128 * SPITCH * 2, L_CUM = L_DTV + 4096, L_E = L_CUM + 4096;
static_assert(L_E + 64 <= LDS_BYTES, "SSD LDS map");

template <bool TR>
__device__ __forceinline__ void ssd_stage(Frame& F, int l, int cj, int xch0, int nch, LAS bf16* dst) {
    const bf16* P = WSP(bf16, WS_P);
    const int r0 = cj * 128; int base, t0, len; row_seq(r0, base, t0, len);
    const int ncv = nch >> 3;
    const float* cw = F.a->in[I_M2CW] + (size_t)l * 4 * 1024 + xch0; const float* cb = F.a->in[I_M2CB] + l * 1024 + xch0;
    for (int item = F.tid; item < ncv * 16; item += NTHREADS) {
        const int cv = item % ncv, ts = item / ncv, c8 = cv * 8, tq = ts * 8;
        float w[4][8], bsv[8];
#pragma unroll
        for (int k = 0; k < 4; ++k) { const f32x4 a = *(const f32x4*)(cw + k * 1024 + c8), b = *(const f32x4*)(cw + k * 1024 + c8 + 4);
            w[k][0] = a[0]; w[k][1] = a[1]; w[k][2] = a[2]; w[k][3] = a[3]; w[k][4] = b[0]; w[k][5] = b[1]; w[k][6] = b[2]; w[k][7] = b[3]; }
        { const f32x4 a = *(const f32x4*)(cb + c8), b = *(const f32x4*)(cb + c8 + 4); bsv[0] = a[0]; bsv[1] = a[1]; bsv[2] = a[2]; bsv[3] = a[3]; bsv[4] = b[0]; bsv[5] = b[1]; bsv[6] = b[2]; bsv[7] = b[3]; }
        v4u raw[11];
#pragma unroll
        for (int i = 0; i < 11; ++i) { const int t = t0 + tq - 2 + i;
            raw[i] = (t >= 0 && t < len) ? *(const v4u*)(P + (size_t)(base + t) * NIN + PC_XBC + xch0 + c8) : (v4u){0u, 0u, 0u, 0u}; }
        unsigned pk[8][4];
#pragma unroll
        for (int i = 0; i < 8; ++i) {
            float o[8];
#pragma unroll
            for (int e = 0; e < 8; ++e) o[e] = bsv[e];
#pragma unroll
            for (int k = 0; k < 4; ++k) { const v4u r = raw[i + k];
                o[0] += w[k][0] * bflo(r.x); o[1] += w[k][1] * bfhi(r.x); o[2] += w[k][2] * bflo(r.y); o[3] += w[k][3] * bfhi(r.y);
                o[4] += w[k][4] * bflo(r.z); o[5] += w[k][5] * bfhi(r.z); o[6] += w[k][6] * bflo(r.w); o[7] += w[k][7] * bfhi(r.w); }
#pragma unroll
            for (int e = 0; e < 8; ++e) o[e] = siluf_(o[e]);
            if (TR) {
#pragma unroll
                for (int e = 0; e < 8; ++e) { const unsigned hb = f2bf(o[e]); if (i & 1) pk[e][i >> 1] |= hb << 16; else pk[e][i >> 1] = hb; }
            } else {
                v4u q; q.x = pk2(o[0], o[1]); q.y = pk2(o[2], o[3]); q.z = pk2(o[4], o[5]); q.w = pk2(o[6], o[7]);
                *(LAS v4u*)(dst + (tq + i) * SPITCH + c8) = q;
            }
        }
        if (TR) {
#pragma unroll
            for (int e = 0; e < 8; ++e) { v4u q; q.x = pk[e][0]; q.y = pk[e][1]; q.z = pk[e][2]; q.w = pk[e][3]; *(LAS v4u*)(dst + (c8 + e) * SPITCH + tq) = q; }
        }
    }
}
__device__ __forceinline__ void ssd_dt_cum(Frame& F, int l, int cj, int gi) {
    LAS float* dtv = (LAS float*)(F.lds + L_DTV); LAS float* cum = (LAS float*)(F.lds + L_CUM); LAS float* Ea = (LAS float*)(F.lds + L_E);
    const int hd = F.wave, dir = hd >> 2, h = gi * 4 + (hd & 3);
    const float* DT = WSP(float, WS_DT);
    const float bias = F.a->in[I_M2DTB][l * 16 + dir * 8 + h];
    const float a = -expf(F.a->in[I_M2ALOG][l * 16 + dir * 8 + h]);
    const int q0 = 2 * F.lane;
    const float dt0 = softplusf_(DT[(size_t)(cj * 128 + q0) * 16 + dir * 8 + h] + bias), dt1 = softplusf_(DT[(size_t)(cj * 128 + q0 + 1) * 16 + dir * 8 + h] + bias);
    const float da0 = dt0 * a, da1 = dt1 * a;
    float ps = da0 + da1;
#pragma unroll
    for (int o = 1; o < 64; o <<= 1) { const float t = __shfl_up(ps, o); if (F.lane >= o) ps += t; }
    const float tot = __shfl(ps, 63);
    float c0, c1;
    if (dir == 0) { c0 = ps - da1; c1 = ps; } else { c0 = tot - (ps - da0 - da1); c1 = tot - (ps - da1); }
    dtv[hd * 128 + q0] = dt0; dtv[hd * 128 + q0 + 1] = dt1; cum[hd * 128 + q0] = c0; cum[hd * 128 + q0 + 1] = c1;
    if (F.lane == 0) Ea[hd] = tot;
}
__device__ __forceinline__ void unpack8(const bf16x8v v, float (&o)[8]) {
    const v4u u = __builtin_bit_cast(v4u, v);
    o[0] = bflo(u.x); o[1] = bfhi(u.x); o[2] = bflo(u.y); o[3] = bfhi(u.y); o[4] = bflo(u.z); o[5] = bfhi(u.z); o[6] = bflo(u.w); o[7] = bfhi(u.w);
}
__device__ __forceinline__ bf16x8v pack8(const float (&o)[8]) {
    v4u u; u.x = pk2(o[0], o[1]); u.y = pk2(o[2], o[3]); u.z = pk2(o[4], o[5]); u.w = pk2(o[6], o[7]);
    return __builtin_bit_cast(bf16x8v, u);
}
__device__ __forceinline__ void ssd_state_job(Frame& F, int l, int cj, int gi) {
    LAS bf16* XT = (LAS bf16*)(F.lds + L_XT); LAS bf16* BT = (LAS bf16*)(F.lds + L_B);
    LAS float* dtv = (LAS float*)(F.lds + L_DTV); LAS float* cum = (LAS float*)(F.lds + L_CUM); LAS float* Ea = (LAS float*)(F.lds + L_E);
    __syncthreads();
    ssd_stage<true>(F, l, cj, gi * 256, 256, XT);
    ssd_stage<true>(F, l, cj, 512 + gi * 128, 128, BT);
    ssd_dt_cum(F, l, cj, gi);
    __syncthreads();
    const int fr = F.lane & 15, kq = F.lane >> 4, nt = F.wave;
    bf16x8v BTf[4];
#pragma unroll
    for (int ks = 0; ks < 4; ++ks) BTf[ks] = *(const LAS bf16x8v*)(BT + (16 * nt + fr) * SPITCH + ks * 32 + kq * 8);
    float* SST = WSP(float, WS_SST); float* DEC = WSP(float, WS_SDEC);
#pragma unroll 1
    for (int hd = 0; hd < 8; ++hd) {
        const int hl = hd & 3; const float E = Ea[hd];
        float wq[4][8];
#pragma unroll
        for (int ks = 0; ks < 4; ++ks)
#pragma unroll
            for (int e = 0; e < 8; ++e) { const int q = ks * 32 + kq * 8 + e; wq[ks][e] = dtv[hd * 128 + q] * __expf(E - cum[hd * 128 + q]); }
#pragma unroll
        for (int pt = 0; pt < 4; ++pt) {
            f32x4 acc = {0.f, 0.f, 0.f, 0.f};
#pragma unroll
            for (int ks = 0; ks < 4; ++ks) {
                const bf16x8v raw = *(const LAS bf16x8v*)(XT + (hl * 64 + pt * 16 + fr) * SPITCH + ks * 32 + kq * 8);
                float xv[8]; unpack8(raw, xv);
#pragma unroll
                for (int e = 0; e < 8; ++e) xv[e] *= wq[ks][e];
                acc = __builtin_amdgcn_mfma_f32_16x16x32_bf16(BTf[ks], pack8(xv), acc, 0, 0, 0);
            }
            *(f32x4*)(SST + ((size_t)((cj * 2 + gi) * 8 + hd) * 64 + pt * 16 + fr) * 128 + 16 * nt + 4 * kq) = acc;
        }
        if (F.tid == 0) DEC[(cj * 2 + gi) * 8 + hd] = __expf(E);
    }
}
__device__ __forceinline__ void ssd_scan(Frame& F, int idx) {
    const int n4 = idx & 31, p = (idx >> 5) & 63, hdg = (idx >> 11) & 15, b = idx >> 15;
    const int dir = (hdg >> 2) & 1;
    const float* SST = WSP(float, WS_SST); const float* DEC = WSP(float, WS_SDEC); bf16* HIN = WSP(bf16, WS_SHIN);
    f32x4 h = {0.f, 0.f, 0.f, 0.f};
#pragma unroll 2
    for (int st = 0; st < 34; ++st) {
        const int cj = st < 2 ? 64 + b * 2 + (dir ? 1 - st : st) : b * 32 + (dir ? 31 - (st - 2) : st - 2);
        const size_t o = ((size_t)(cj * 16 + hdg) * 64 + p) * 128 + n4 * 4;
        const f32x4 sv = *(const f32x4*)(SST + o); const float d = DEC[cj * 16 + hdg];
        v2u w; w.x = pk2(h[0], h[1]); w.y = pk2(h[2], h[3]);
        *(v2u*)(HIN + o) = w;
        h = h * d + sv;
    }
}
__device__ __forceinline__ void ssd_y_job(Frame& F, int l, int cj, int gi) {
    LAS bf16* XT = (LAS bf16*)(F.lds + L_XT); LAS bf16* BM = (LAS bf16*)(F.lds + L_B); LAS bf16* CM = (LAS bf16*)(F.lds + L_C);
    LAS float* dtv = (LAS float*)(F.lds + L_DTV); LAS float* cum = (LAS float*)(F.lds + L_CUM);
    __syncthreads();
    ssd_stage<true>(F, l, cj, gi * 256, 256, XT);
    ssd_stage<false>(F, l, cj, 512 + gi * 128, 128, BM);
    ssd_stage<false>(F, l, cj, 768 + gi * 128, 128, CM);
    ssd_dt_cum(F, l, cj, gi);
    __syncthreads();
    const int fr = F.lane & 15, kq = F.lane >> 4, w = F.wave, i = 16 * w + fr;
    bf16x8v Cf[4];
#pragma unroll
    for (int ks = 0; ks < 4; ++ks) Cf[ks] = *(const LAS bf16x8v*)(CM + i * SPITCH + ks * 32 + kq * 8);
    f32x4 GT[8];
#pragma unroll
    for (int jt = 0; jt < 8; ++jt) { f32x4 a = {0.f, 0.f, 0.f, 0.f};
#pragma unroll
        for (int ks = 0; ks < 4; ++ks) { const bf16x8v A = *(const LAS bf16x8v*)(BM + (16 * jt + fr) * SPITCH + ks * 32 + kq * 8); a = __builtin_amdgcn_mfma_f32_16x16x32_bf16(A, Cf[ks], a, 0, 0, 0); }
        GT[jt] = a; }
    const bf16* P = WSP(bf16, WS_P); const bf16* HIN = WSP(bf16, WS_SHIN);
    const size_t row = (size_t)cj * 128 + i;
    f32x4 gq[4][4]; float ss = 0.f;
#pragma unroll
    for (int hl = 0; hl < 4; ++hl) {
        f32x4 accY[4];
#pragma unroll
        for (int pt = 0; pt < 4; ++pt) accY[pt] = (f32x4){0.f, 0.f, 0.f, 0.f};
        const float dh = F.a->in[I_M2D][l * 8 + gi * 4 + hl];
#pragma unroll 1
        for (int dir = 0; dir < 2; ++dir) {
            const int hd = dir * 4 + hl;
            int io = i; asm volatile("" : "+v"(io));
            const float ci = cum[hd * 128 + i];
#pragma unroll
            for (int kk = 0; kk < 4; ++kk) {
                const bool rel = dir == 0 ? (32 * kk <= 16 * w + 15) : (32 * kk + 31 >= 16 * w);
                if (rel) {
                    float sv[8];
#pragma unroll
                    for (int e = 0; e < 8; ++e) {
                        const int j = 32 * kk + 16 * (e >> 2) + 4 * kq + (e & 3);
                        const float g = GT[2 * kk + (e >> 2)][e & 3];
                        const bool valid = dir == 0 ? (j <= io) : (j >= io);
                        float v = valid ? g * __expf(ci - cum[hd * 128 + j]) * dtv[hd * 128 + j] : 0.f;
                        if (dir == 0 && j == io) v += dh;
                        sv[e] = v;
                    }
                    const bf16x8v Bf = pack8(sv);
#pragma unroll
                    for (int pt = 0; pt < 4; ++pt) {
                        const LAS bf16* xp = XT + (hl * 64 + pt * 16 + fr) * SPITCH + 32 * kk + 4 * kq;
                        const v2u a0 = *(const LAS v2u*)(xp), a1 = *(const LAS v2u*)(xp + 16);
                        v4u au; au.x = a0.x; au.y = a0.y; au.z = a1.x; au.w = a1.y;
                        accY[pt] = __builtin_amdgcn_mfma_f32_16x16x32_bf16(__builtin_bit_cast(bf16x8v, au), Bf, accY[pt], 0, 0, 0);
                    }
                }
            }
            const float ei = __expf(ci);
            const bf16* hp = HIN + ((size_t)((cj * 2 + gi) * 8 + hd) * 64 + fr) * 128 + kq * 8;
#pragma unroll
            for (int pt = 0; pt < 4; ++pt) {
                f32x4 tmp = {0.f, 0.f, 0.f, 0.f};
#pragma unroll
                for (int ks = 0; ks < 4; ++ks) { const bf16x8v A = *(const bf16x8v*)(hp + (size_t)(pt * 16) * 128 + ks * 32); tmp = __builtin_amdgcn_mfma_f32_16x16x32_bf16(A, Cf[ks], tmp, 0, 0, 0); }
                accY[pt] += tmp * ei;
            }
        }
#pragma unroll
        for (int pt = 0; pt < 4; ++pt) {
            const v2u zz = *(const v2u*)(P + row * NIN + PC_Z + gi * 256 + hl * 64 + pt * 16 + 4 * kq);
            f32x4 gv; gv[0] = accY[pt][0] * siluf_(bflo(zz.x)); gv[1] = accY[pt][1] * siluf_(bfhi(zz.x)); gv[2] = accY[pt][2] * siluf_(bflo(zz.y)); gv[3] = accY[pt][3] * siluf_(bfhi(zz.y));
            ss += (gv[0] * gv[0] + gv[1] * gv[1]) + (gv[2] * gv[2] + gv[3] * gv[3]);
            gq[hl][pt] = gv;
        }
    }
    ss += __shfl_xor(ss, 16); ss += __shfl_xor(ss, 32);
    const float rs = 1.f / sqrtf(ss * (1.f / 256.f) + RMS_EPS);
    bf16* MIX = WSP(bf16, WS_MIX);
#pragma unroll
    for (int hl = 0; hl < 4; ++hl)
#pragma unroll
        for (int pt = 0; pt < 4; ++pt) {
            const int ch = gi * 256 + hl * 64 + pt * 16 + 4 * kq;
            const f32x4 nw = *(const f32x4*)(F.a->in[I_M2NW] + l * GW + ch);
            const f32x4 o = gq[hl][pt] * rs * nw;
            v2u wv; wv.x = pk2(o[0], o[1]); wv.y = pk2(o[2], o[3]);
            *(v2u*)(MIX + row * DM + MX_SSD + ch) = wv;
        }
}

__device__ __forceinline__ void sg_job(Frame& F, int l, int cj, int hh) {
    LAS bf16* VT = (LAS bf16*)(F.lds);
    const bf16* P = WSP(bf16, WS_P); bf16* MIX = WSP(bf16, WS_MIX);
    const int r0 = cj * 128;
    __syncthreads();
    {
        const int d = F.lane * 2;
        const float g0 = F.a->in[I_SGLNG][l * GW + hh * 128 + d], g1 = F.a->in[I_SGLNG][l * GW + hh * 128 + d + 1];
        const float b0 = F.a->in[I_SGLNB][l * GW + hh * 128 + d], b1 = F.a->in[I_SGLNB][l * GW + hh * 128 + d + 1];
#pragma unroll 4
        for (int jj = 0; jj < 16; ++jj) {
            const int j = F.wave * 16 + jj;
            const unsigned w = *(const unsigned*)(P + (size_t)(r0 + j) * NIN + PC_SGV + hh * 128 + d);
            const float a0 = gelu_tanh(bflo(w)), a1 = gelu_tanh(bfhi(w));
            const float mean = wave_sum(a0 + a1) * (1.f / 128.f);
            const float d0 = a0 - mean, d1 = a1 - mean;
            const float rstd = 1.f / sqrtf(wave_sum(d0 * d0 + d1 * d1) * (1.f / 128.f) + LN_EPS);
            VT[d * SPITCH + j] = (bf16)f2bf(d0 * rstd * g0 + b0);
            VT[(d + 1) * SPITCH + j] = (bf16)f2bf(d1 * rstd * g1 + b1);
        }
    }
    __syncthreads();
    const int fr = F.lane & 15, kq = F.lane >> 4, i = 16 * F.wave + fr;
    const bf16* Wb = WSP(bf16, WS_SGWB) + (size_t)(l * 4 + hh) * 128 * 128 + (size_t)i * 128 + kq * 8;
    bf16x8v Wf[4];
#pragma unroll
    for (int ks = 0; ks < 4; ++ks) Wf[ks] = *(const bf16x8v*)(Wb + ks * 32);
    const float bs = F.a->in[I_SGB][(l * 4 + hh) * 128 + i];
    const size_t row = (size_t)r0 + i;
#pragma unroll
    for (int dt = 0; dt < 8; ++dt) {
        f32x4 acc = {0.f, 0.f, 0.f, 0.f};
#pragma unroll
        for (int ks = 0; ks < 4; ++ks) { const bf16x8v A = *(const LAS bf16x8v*)(VT + (16 * dt + fr) * SPITCH + ks * 32 + kq * 8); acc = __builtin_amdgcn_mfma_f32_16x16x32_bf16(A, Wf[ks], acc, 0, 0, 0); }
        const int dch = hh * 128 + 16 * dt + 4 * kq;
        const v2u uu = *(const v2u*)(P + row * NIN + PC_SGU + dch);
        v2u o; o.x = pk2(gelu_tanh(bflo(uu.x)) * (acc[0] + bs), gelu_tanh(bfhi(uu.x)) * (acc[1] + bs)); o.y = pk2(gelu_tanh(bflo(uu.y)) * (acc[2] + bs), gelu_tanh(bfhi(uu.y)) * (acc[3] + bs));
        *(v2u*)(MIX + row * DM + MX_SG + dch) = o;
    }
}
__device__ __forceinline__ void pool_job(Frame& F, int l, int cj, int gp) {
    LAS bf16* Mm = (LAS bf16*)(F.lds);
    const bf16* P = WSP(bf16, WS_P); bf16* MIX = WSP(bf16, WS_MIX);
    const int r0 = cj * 128, win = 2 << gp; int base, t0, len; row_seq(r0, base, t0, len);
    __syncthreads();
    for (int item = F.tid; item < 128 * 16; item += NTHREADS) {
        const int tk = item >> 4, c8 = (item & 15) * 8, t = t0 + tk;
        int lo = t - win / 2; if (lo < 0) lo = 0; int hi = t + win / 2 - 1; if (hi > len - 1) hi = len - 1;
        float sacc[8];
#pragma unroll
        for (int e = 0; e < 8; ++e) sacc[e] = 0.f;
        const bf16* pc = P + (size_t)base * NIN + PC_POOL + gp * 128 + c8;
        for (int k = lo; k <= hi; ++k) { const v4u r = *(const v4u*)(pc + (size_t)k * NIN);
            sacc[0] += bflo(r.x); sacc[1] += bfhi(r.x); sacc[2] += bflo(r.y); sacc[3] += bfhi(r.y); sacc[4] += bflo(r.z); sacc[5] += bfhi(r.z); sacc[6] += bflo(r.w); sacc[7] += bfhi(r.w); }
        const float inv = 1.f / (float)(hi - lo + 1);
        const v4u sf = *(const v4u*)(pc + (size_t)t * NIN);
        v4u q; q.x = pk2(sacc[0] * inv - bflo(sf.x), sacc[1] * inv - bfhi(sf.x)); q.y = pk2(sacc[2] * inv - bflo(sf.y), sacc[3] * inv - bfhi(sf.y));
        q.z = pk2(sacc[4] * inv - bflo(sf.z), sacc[5] * inv - bfhi(sf.z)); q.w = pk2(sacc[6] * inv - bflo(sf.w), sacc[7] * inv - bfhi(sf.w));
        *(LAS v4u*)(Mm + tk * SPITCH + c8) = q;
    }
    __syncthreads();
    const int fr = F.lane & 15, kq = F.lane >> 4, i = 16 * F.wave + fr;
    bf16x8v Mf[4];
#pragma unroll
    for (int ks = 0; ks < 4; ++ks) Mf[ks] = *(const LAS bf16x8v*)(Mm + i * SPITCH + ks * 32 + kq * 8);
    const bf16* Wt = WSP(bf16, WS_POOLWT) + (size_t)(l * 4 + gp) * 128 * 128 + (size_t)fr * 128 + kq * 8;
    const size_t row = (size_t)r0 + i;
#pragma unroll
    for (int dt = 0; dt < 8; ++dt) {
        f32x4 acc = {0.f, 0.f, 0.f, 0.f};
#pragma unroll
        for (int ks = 0; ks < 4; ++ks) { const bf16x8v A = *(const bf16x8v*)(Wt + (size_t)(16 * dt) * 128 + ks * 32); acc = __builtin_amdgcn_mfma_f32_16x16x32_bf16(A, Mf[ks], acc, 0, 0, 0); }
        const int dch = gp * 128 + 16 * dt + 4 * kq;
        const f32x4 pb = *(const f32x4*)(F.a->in[I_POOLB] + l * GW + dch), ps = *(const f32x4*)(F.a->in[I_POOLS] + l * GW + dch);
        const f32x4 ov = (acc + pb) * ps;
        v2u o; o.x = pk2(ov[0], ov[1]); o.y = pk2(ov[2], ov[3]);
        *(v2u*)(MIX + row * DM + MX_POOL + dch) = o;
    }
}
__device__ __forceinline__ void sgpool_tables(Frame& F) {
    const int gt = F.bid * NTHREADS + F.tid, NGT = F.G * NTHREADS;
    bf16* sgw = WSP(bf16, WS_SGWB); bf16* pwt = WSP(bf16, WS_POOLWT);
    for (int e = gt; e < DEPTH * 4 * 128 * 128; e += NGT) {
        sgw[e] = (bf16)f2bf(F.a->in[I_SGW][e]);
        const int d = (e >> 7) & 127, c = e & 127, lg = e >> 14;
        pwt[e] = (bf16)f2bf(F.a->in[I_POOLW][(size_t)lg * 16384 + c * 128 + d]);
    }
}
__device__ __forceinline__ void ssd_prep_oracle(Frame& F, int l) {
    const int gt = F.bid * NTHREADS + F.tid, NGT = F.G * NTHREADS;
    const bf16* P = WSP(bf16, WS_P); float* XC = WSP(float, WS_XC);
    const float* cw = F.a->in[I_M2CW] + (size_t)l * 4 * 1024; const float* cb = F.a->in[I_M2CB] + l * 1024;
    for (int i = gt; i < MT * 1024; i += NGT) {
        const int row = i >> 10, ch = i & 1023; int base, t, len; row_seq(row, base, t, len);
        float a = cb[ch];
#pragma unroll
        for (int k = 0; k < 4; ++k) { const int tt = t - 2 + k; if (tt >= 0 && tt < len) a += cw[k * 1024 + ch] * bf2f(P[(size_t)(base + tt) * NIN + PC_XBC + ch]); }
        XC[i] = siluf_(a);
    }
    const float* dtr = WSP(float, WS_DT); float* dts = WSP(float, WS_DTS);
    for (int i = gt; i < MT * 16; i += NGT) dts[i] = softplusf_(dtr[i] + F.a->in[I_M2DTB][l * 16 + (i & 15)]);
}
__device__ __forceinline__ void ssd_scan_oracle_job(Frame& F, int l, int b, int hd, int dir) {
    LAS float* xs = (LAS float*)(F.lds);
    LAS float* Bs = (LAS float*)(F.lds + 8192);
    LAS float* Cs = (LAS float*)(F.lds + 8192 + 16384);
    LAS float* ds = (LAS float*)(F.lds + 8192 + 32768);
    LAS float* yb = (LAS float*)(F.lds + 8192 + 32768 + 256);
    LAS int* rws = (LAS int*)(F.lds + 8192 + 32768 + 256 + 8192);
    const float* XC = WSP(float, WS_XC); const float* dts = WSP(float, WS_DTS); float* YD = WSP(float, WS_YD) + (size_t)dir * MT * GW;
    const int p = F.tid >> 3, nq = F.tid & 7, n0 = nq * 16, grp = hd >> 2;
    const float a = -expf(F.a->in[I_M2ALOG][l * 16 + dir * 8 + hd]);
    float hs[16];
#pragma unroll
    for (int k = 0; k < 16; ++k) hs[k] = 0.f;
    for (int q0 = 0; q0 < CTXL + SEQL; q0 += 32) {
        __syncthreads();
        for (int idx = F.tid; idx < 32 * 64; idx += NTHREADS) { const int i = idx >> 6, c = idx & 63; const int row = proc_row(q0 + i, dir, b); xs[idx] = XC[(size_t)row * 1024 + hd * 64 + c]; }
        for (int idx = F.tid; idx < 32 * 128; idx += NTHREADS) { const int i = idx >> 7, n = idx & 127; const int row = proc_row(q0 + i, dir, b);
            Bs[idx] = XC[(size_t)row * 1024 + 512 + grp * 128 + n]; Cs[idx] = XC[(size_t)row * 1024 + 768 + grp * 128 + n]; }
        if (F.tid < 32) { const int row = proc_row(q0 + F.tid, dir, b); ds[F.tid] = dts[(size_t)row * 16 + dir * 8 + hd]; rws[F.tid] = row; }
        __syncthreads();
        for (int i = 0; i < 32; ++i) {
            const float dt = ds[i], da = expf(dt * a), xd = xs[i * 64 + p] * dt;
            float part = 0.f;
#pragma unroll
            for (int k = 0; k < 16; ++k) { hs[k] = da * hs[k] + xd * Bs[i * 128 + n0 + k]; part += Cs[i * 128 + n0 + k] * hs[k]; }
            part += __shfl_xor(part, 1); part += __shfl_xor(part, 2); part += __shfl_xor(part, 4);
            if (nq == 0) yb[i * 64 + p] = part;
        }
        __syncthreads();
        for (int idx = F.tid; idx < 32 * 64; idx += NTHREADS) { const int i = idx >> 6, c = idx & 63; YD[(size_t)rws[i] * GW + hd * 64 + c] = yb[idx]; }
    }
    __syncthreads();
}
__device__ __forceinline__ void ssd_finish_oracle(Frame& F, int l) {
    const int gw = F.bid * NWAVES + F.wave, NGW = F.G * NWAVES;
    const float* XC = WSP(float, WS_XC); const float* YD = WSP(float, WS_YD); const bf16* P = WSP(bf16, WS_P); bf16* MIX = WSP(bf16, WS_MIX);
    for (int row = gw; row < MT; row += NGW) {
#pragma unroll
        for (int j = 0; j < 2; ++j) {
            const int ch = j * 256 + F.lane * 4;
            const f32x4 y0 = *(const f32x4*)(YD + (size_t)row * GW + ch), y1 = *(const f32x4*)(YD + (size_t)(MT + row) * GW + ch), xv = *(const f32x4*)(XC + (size_t)row * 1024 + ch);
            const float dh = F.a->in[I_M2D][l * 8 + (ch >> 6)];
            const v2u zz = *(const v2u*)(P + (size_t)row * NIN + PC_Z + ch);
            f32x4 gq; float zf[4] = {bflo(zz.x), bfhi(zz.x), bflo(zz.y), bfhi(zz.y)};
#pragma unroll
            for (int k = 0; k < 4; ++k) gq[k] = (y0[k] + y1[k] + dh * xv[k]) * siluf_(zf[k]);
            const float ss = wave_sum((gq[0] * gq[0] + gq[1] * gq[1]) + (gq[2] * gq[2] + gq[3] * gq[3]));
            const float rs = 1.f / sqrtf(ss * (1.f / 256.f) + RMS_EPS);
            const f32x4 nw = *(const f32x4*)(F.a->in[I_M2NW] + l * GW + ch);
            v2u w; w.x = pk2(gq[0] * rs * nw[0], gq[1] * rs * nw[1]); w.y = pk2(gq[2] * rs * nw[2], gq[3] * rs * nw[3]);
            *(v2u*)(MIX + (size_t)row * DM + MX_SSD + ch) = w;
        }
    }
}
__device__ __forceinline__ void sg_oracle_job(Frame& F, int l, int cj, int hh) {
    LAS float* v = (LAS float*)(F.lds);
    const bf16* P = WSP(bf16, WS_P); bf16* MIX = WSP(bf16, WS_MIX);
    const int r0 = cj * 128;
    __syncthreads();
    for (int j = F.wave; j < 128; j += NWAVES) {
        const unsigned w = *(const unsigned*)(P + (size_t)(r0 + j) * NIN + PC_SGV + hh * 128 + F.lane * 2);
        const float a0 = gelu_tanh(bflo(w)), a1 = gelu_tanh(bfhi(w));
        const float mean = wave_sum(a0 + a1) * (1.f / 128.f);
        const float d0 = a0 - mean, d1 = a1 - mean;
        const float rstd = 1.f / sqrtf(wave_sum(d0 * d0 + d1 * d1) * (1.f / 128.f) + LN_EPS);
        const int d = F.lane * 2;
        v[j * 128 + d] = d0 * rstd * F.a->in[I_SGLNG][l * GW + hh * 128 + d] + F.a->in[I_SGLNB][l * GW + hh * 128 + d];
        v[j * 128 + d + 1] = d1 * rstd * F.a->in[I_SGLNG][l * GW + hh * 128 + d + 1] + F.a->in[I_SGLNB][l * GW + hh * 128 + d + 1];
    }
    __syncthreads();
    const int d = F.tid & 127, ig = F.tid >> 7;
    const float* ws = F.a->in[I_SGW] + (size_t)(l * 4 + hh) * 128 * 128;
    for (int ii = 0; ii < 32; ++ii) {
        const int i = ig * 32 + ii;
        float s = F.a->in[I_SGB][(l * 4 + hh) * 128 + i];
        for (int j = 0; j < 128; ++j) s += ws[i * 128 + j] * v[j * 128 + d];
        const float uu = gelu_tanh(bf2f(P[(size_t)(r0 + i) * NIN + PC_SGU + hh * 128 + d]));
        MIX[(size_t)(r0 + i) * DM + MX_SG + hh * 128 + d] = (bf16)f2bf(uu * s);
    }
    __syncthreads();
}
__device__ __forceinline__ void pool_oracle_job(Frame& F, int l, int tile, int gp) {
    LAS float* m = (LAS float*)(F.lds);
    const bf16* P = WSP(bf16, WS_P); bf16* MIX = WSP(bf16, WS_MIX);
    const int r0 = tile * 32, win = 2 << gp;
    __syncthreads();
    for (int idx = F.tid; idx < 32 * 128; idx += NTHREADS) {
        const int i = idx >> 7, c = idx & 127; int base, t, len; row_seq(r0 + i, base, t, len);
        int lo = t - win / 2; if (lo < 0) lo = 0; int hi = t + win / 2 - 1; if (hi > len - 1) hi = len - 1;
        float s = 0.f;
        for (int k = lo; k <= hi; ++k) s += bf2f(P[(size_t)(base + k) * NIN + PC_POOL + gp * 128 + c]);
        m[idx] = s / (float)(hi - lo + 1) - bf2f(P[(size_t)(r0 + i) * NIN + PC_POOL + gp * 128 + c]);
    }
    __syncthreads();
    const int d = F.tid & 127, ig = F.tid >> 7;
    const float* w = F.a->in[I_POOLW] + (size_t)(l * 4 + gp) * 128 * 128;
    for (int ii = 0; ii < 8; ++ii) {
        const int i = ig * 8 + ii; float s = 0.f;
        for (int c = 0; c < 128; ++c) s += m[i * 128 + c] * w[c * 128 + d];
        s = (s + F.a->in[I_POOLB][l * GW + gp * 128 + d]) * F.a->in[I_POOLS][l * GW + gp * 128 + d];
        MIX[(size_t)(r0 + i) * DM + MX_POOL + gp * 128 + d] = (bf16)f2bf(s);
    }
    __syncthreads();
}
__device__ __forceinline__ void ffn_act_oracle(Frame& F, int l, int nrows) {
    const int gt = F.bid * NTHREADS + F.tid, NGT = F.G * NTHREADS;
    const bf16* GV = WSP(bf16, WS_GV); bf16* ACT = WSP(bf16, WS_ACT);
    const float* cw = F.a->in[I_FCW] + (size_t)l * 9 * FF; const float* cb = F.a->in[I_FCB] + l * FF;
    constexpr int FV = FF / 8;
    for (int i = gt; i < nrows * FV; i += NGT) {
        const int row = i / FV, f0 = (i % FV) * 8;
        float a[8];
#pragma unroll
        for (int k = 0; k < 8; ++k) a[k] = cb[f0 + k];
        if (row < ML) {
            const int b = row >> 12, t = row & 4095, r = t >> 6, c = t & 63;
            for (int dr = -1; dr <= 1; ++dr) for (int dc = -1; dc <= 1; ++dc) {
                const int rr = r + dr, c2 = c + dc; if (rr < 0 || rr > 63 || c2 < 0 || c2 > 63) continue;
                const v4u g = *(const v4u*)(GV + (size_t)(b * SEQL + rr * 64 + c2) * FF2 + f0);
                const float* w = cw + ((dr + 1) * 3 + (dc + 1)) * FF + f0;
                a[0] += w[0] * bflo(g.x); a[1] += w[1] * bfhi(g.x); a[2] += w[2] * bflo(g.y); a[3] += w[3] * bfhi(g.y);
                a[4] += w[4] * bflo(g.z); a[5] += w[5] * bfhi(g.z); a[6] += w[6] * bflo(g.w); a[7] += w[7] * bfhi(g.w);
            }
        } else {
            int base, t, len; row_seq(row, base, t, len);
            for (int k = 0; k < 3; ++k) { const int tt = t + k - 1; if (tt < 0 || tt >= len) continue;
                const v4u g = *(const v4u*)(GV + (size_t)(base + tt) * FF2 + f0);
                const float* w = cw + (3 + k) * FF + f0;
                a[0] += w[0] * bflo(g.x); a[1] += w[1] * bfhi(g.x); a[2] += w[2] * bflo(g.y); a[3] += w[3] * bfhi(g.y);
                a[4] += w[4] * bflo(g.z); a[5] += w[5] * bfhi(g.z); a[6] += w[6] * bflo(g.w); a[7] += w[7] * bfhi(g.w);
            }
        }
        const v4u vv = *(const v4u*)(GV + (size_t)row * FF2 + FF + f0);
        v4u o;
        o.x = pk2(gelu_tanh(a[0]) * bflo(vv.x), gelu_tanh(a[1]) * bfhi(vv.x)); o.y = pk2(gelu_tanh(a[2]) * bflo(vv.y), gelu_tanh(a[3]) * bfhi(vv.y));
        o.z = pk2(gelu_tanh(a[4]) * bflo(vv.z), gelu_tanh(a[5]) * bfhi(vv.z)); o.w = pk2(gelu_tanh(a[6]) * bflo(vv.w), gelu_tanh(a[7]) * bfhi(vv.w));
        *(v4u*)(ACT + (size_t)row * FF + f0) = o;
    }
}

constexpr int PH_PRO_A = 0, PH_PRO_B = 1, PH_PRO_C = 2, PH_L0 = 3, NPH_L = 11, N_PHASES = PH_L0 + DEPTH * NPH_L;


typedef GAS unsigned gu32;
#define RLX_AGENT __ATOMIC_RELAXED, __HIP_MEMORY_SCOPE_AGENT
constexpr int CW_BAR = 4096;
constexpr int LDS_ST_OFF = LDS_BYTES - 64;
#define XB_TMO      128
#define XB_XCNT(j)  (256  + 64 * (j))
#define XB_XSUB(j)  (1280 + 64 * (j))
#define XB_XGEN(j)  (2304 + 64 * (j))
#define XB_TOP      3328
#define XB_TOPGEN   3392
#define XCD_BAR_WORDS 3456
#define XB_SPIN_CAP (1u << 18)

__device__ __forceinline__ unsigned xb_ld(unsigned* p)              { return __hip_atomic_load(p, __ATOMIC_RELAXED, __HIP_MEMORY_SCOPE_AGENT); }
__device__ __forceinline__ unsigned xb_add(unsigned* p, unsigned v) { return __hip_atomic_fetch_add(p, v, __ATOMIC_RELAXED, __HIP_MEMORY_SCOPE_AGENT); }
__device__ __forceinline__ unsigned xb_xcc_id() { return (unsigned)__builtin_amdgcn_s_getreg((3 << 11) | 20) & 0xFu; }
#define XB_SPIN(cond, bar) do { unsigned _sp = 0; while (cond) { __builtin_amdgcn_s_sleep(1); \
    if ((++_sp & 255u) == 0u) { if (xb_ld(&(bar)[XB_TMO])) break; if (_sp > XB_SPIN_CAP) { atomicAdd(&(bar)[XB_TMO], 1u); break; } } } } while (0)

struct XcdBarrier {
    unsigned* bar; unsigned x;
    volatile LAS unsigned* st;
};

__device__ __forceinline__ XcdBarrier xcd_barrier_post(unsigned* bar, volatile LAS unsigned* st) {
    XcdBarrier b; b.bar = bar; b.x = xb_xcc_id(); b.st = st;
    if (threadIdx.x == 0) (void)xb_add(&bar[XB_XCNT(b.x)], 1u);
    return b;
}
__device__ __forceinline__ void xcd_barrier_complete(unsigned* bar, unsigned x, unsigned& nloc, unsigned& nx) {
    const unsigned G = gridDim.x * gridDim.y * gridDim.z;
    unsigned sum, cnt, mine, sp = 0u;
    for (;;) {
        sum = 0u; cnt = 0u; mine = 0u;
#pragma unroll
        for (unsigned j = 0; j < 16; ++j) { const unsigned c = xb_ld(&bar[XB_XCNT(j)]); sum += c; cnt += (c > 0u) ? 1u : 0u; mine = (j == x) ? c : mine; }
        if (sum == G) break;
        __builtin_amdgcn_s_sleep(1);
        if ((++sp & 255u) == 0u) { if (xb_ld(&bar[XB_TMO])) break; if (sp > XB_SPIN_CAP) { atomicAdd(&bar[XB_TMO], 1u); break; } }
    }
    nloc = mine > 0u ? mine : 1u; nx = cnt > 0u ? cnt : 1u;
}

__device__ __forceinline__ void xcd_barrier(const XcdBarrier& b) {
    asm volatile("s_waitcnt vmcnt(0)" ::: "memory");
    __syncthreads();
    if (threadIdx.x == 0) {
        unsigned* bar = b.bar;
        __builtin_amdgcn_s_waitcnt(0);
        unsigned nloc = b.st[0], nx = b.st[1];
        if (nloc == 0u) { xcd_barrier_complete(bar, b.x, nloc, nx); b.st[0] = nloc; b.st[1] = nx; }
        const unsigned old = xb_add(&bar[XB_XSUB(b.x)], 1u);
        const unsigned gen = old / nloc;
        if (old + 1u == (gen + 1u) * nloc) {
            __builtin_amdgcn_fence(__ATOMIC_RELEASE, "agent");
            asm volatile("s_waitcnt vmcnt(0)" ::: "memory");
            const unsigned og = xb_add(&bar[XB_TOP], 1u);
            const unsigned tg = og / nx;
            if (og + 1u == (tg + 1u) * nx) xb_add(&bar[XB_TOPGEN], 1u);
            else XB_SPIN(xb_ld(&bar[XB_TOPGEN]) == tg, bar);
            __builtin_amdgcn_fence(__ATOMIC_ACQUIRE, "agent");
            xb_add(&bar[XB_XGEN(b.x)], 1u);
            asm volatile("s_waitcnt vmcnt(0)" ::: "memory");
        } else {
            XB_SPIN(xb_ld(&bar[XB_XGEN(b.x)]) == gen, bar);
            __builtin_amdgcn_fence(__ATOMIC_ACQUIRE, "agent");
            asm volatile("s_waitcnt vmcnt(0)" ::: "memory");
        }
    }
    __syncthreads();
}


__device__ __forceinline__ void grid_bar() {
    XcdBarrier b; b.bar = (unsigned*)((const __attribute__((address_space(4))) Args*)__builtin_amdgcn_kernarg_segment_ptr())->ws + CW_BAR; b.x = xb_xcc_id();
    extern __shared__ __attribute__((aligned(16))) unsigned char lds_raw_[];
    b.st = (volatile LAS unsigned*)((LAS unsigned char*)lds_raw_ + LDS_ST_OFF);
    xcd_barrier(b);
}
template <int PH>
__device__ __forceinline__ void run_phase(LAS unsigned char* ldsp) {
    Frame F;
    F.lds = ldsp;
    { int t_ = threadIdx.x; asm volatile("" : "+v"(t_)); F.tid = t_; }
    F.lane = F.tid & 63; F.wave = __builtin_amdgcn_readfirstlane(F.tid >> 6);
    { int b_ = blockIdx.x, g_ = gridDim.x; asm volatile("" : "+s"(b_), "+s"(g_)); F.bid = b_; F.G = g_; }
    { const __attribute__((address_space(4))) Args* ap = (const __attribute__((address_space(4))) Args*)__builtin_amdgcn_kernarg_segment_ptr(); asm volatile("" : "+s"(ap)); F.a = ap; }
    if constexpr (PH == PH_PRO_A) { phase_pro_a(F); sgpool_tables(F); for (int j = F.bid; j < DEPTH * 2 * 32; j += F.G) s5_tables_job(F, j >> 6, (j >> 5) & 1, j & 31); }
    else if constexpr (PH == PH_PRO_B) phase_pro_b(F);
    else if constexpr (PH == PH_PRO_C) phase_pro_c(F);
    else {
        constexpr int l = (PH - PH_L0) / NPH_L, sp = (PH - PH_L0) % NPH_L;
        constexpr int MR = (l == DEPTH - 1) ? ML : MT;
        if constexpr (sp == 0) {
            pg8::Gemm g{WSP(bf16, WS_HMOD), WSP(bf16, WS_WIN) + (size_t)l * NIN * DM, MT, NIN, DM}; pg8::StaticOrder S; S.init(MT, NIN, F.G, F.bid);
            pg8::EpiIn E{WSP(bf16, WS_P), WSP(float, WS_DT)};
            pg8::gemm_phase<pg8::EpiIn, pg8::StaticOrder, true, true>(F.lds, g, S, E);
        } else if constexpr (sp == 1) {
            for (int j = F.bid; j < 136 + 32 * 17; j += F.G) { if (j < 136) ssd_state_job(F, l, j >> 1, j & 1); else s5_state_job(F, l, (j - 136) % 32, (j - 136) / 32); }
            constexpr int NCJ = (l == DEPTH - 1) ? 64 : 68;
            for (int j = F.bid; j < NCJ * 8; j += F.G) { if (j & 1) pool_job(F, l, j >> 3, (j >> 1) & 3); else sg_job(F, l, j >> 3, (j >> 1) & 3); }
        } else if constexpr (sp == 2) {
            if (F.bid < 128) ssd_scan(F, F.bid * NTHREADS + F.tid);
            else if (F.bid < 144) s5_scan(F, l, (F.bid - 128) * NTHREADS + F.tid);
        } else if constexpr (sp == 3) {
            constexpr int NSSD = (l == DEPTH - 1) ? 128 : 136, NS5 = 32 * ((l == DEPTH - 1) ? 16 : 17);
            for (int j = F.bid; j < NSSD + NS5; j += F.G) { if (j < NSSD) ssd_y_job(F, l, j >> 1, j & 1); else s5_out_job(F, l, (j - NSSD) % 32, (j - NSSD) / 32); }
        } else if constexpr (sp == 4) {
            pg8::Gemm g{WSP(bf16, WS_Z), WSP(bf16, WS_WGLU) + (size_t)l * GW * GW, MR, GW, GW}; pg8::StaticOrder S; S.init(MR, GW, F.G, F.bid);
            pg8::EpiGlu E{WSP(bf16, WS_Z), WSP(bf16, WS_MIX), F.a->in[I_GLUB] + l * GW};
            pg8::gemm_phase<pg8::EpiGlu, pg8::StaticOrder, true, true>(F.lds, g, S, E);
        } else if constexpr (sp == 5) {
            pg8::Gemm g{WSP(bf16, WS_MIX), WSP(bf16, WS_WOUT) + (size_t)l * DM * DM, MR, DM, DM}; pg8::StaticOrder S; S.init(MR, DM, F.G, F.bid);
            pg8::EpiRes E{WSP(float, WS_H), mvec(F, l, 0, 2), 6 * DM};
            pg8::gemm_phase<pg8::EpiRes, pg8::StaticOrder, true, true>(F.lds, g, S, E);
        } else if constexpr (sp == 6) {
            phase_ln(F, F.a->in[I_LN1G] + l * DM, F.a->in[I_LN1B] + l * DM, l, 3, false, MR);
        } else if constexpr (sp == 7) {
            pg8::Gemm g{WSP(bf16, WS_HMOD), WSP(bf16, WS_WUP) + (size_t)l * FF2 * DM, MR, FF2, DM}; pg8::StaticOrder S; S.init(MR, FF2, F.G, F.bid);
            pg8::EpiStore E{WSP(bf16, WS_GV), FF2};
            pg8::gemm_phase<pg8::EpiStore, pg8::StaticOrder, true, true>(F.lds, g, S, E);
        } else if constexpr (sp == 8) {
            ffn_act_oracle(F, l, MR);
        } else if constexpr (sp == 9) {
            pg8::Gemm g{WSP(bf16, WS_ACT), WSP(bf16, WS_WDN) + (size_t)l * DM * FF, MR, DM, FF}; pg8::StaticOrder S; S.init(MR, DM, F.G, F.bid);
            pg8::EpiRes E{WSP(float, WS_H), mvec(F, l, 0, 5), 6 * DM};
            pg8::gemm_phase<pg8::EpiRes, pg8::StaticOrder, true, true>(F.lds, g, S, E);
        } else {
            constexpr bool fin = (l == DEPTH - 1);
            phase_ln(F, F.a->in[I_LN2G] + l * DM, F.a->in[I_LN2B] + l * DM, fin ? l : l + 1, 0, fin, MR);
        }
    }
}
template <int PH, int HI>
__device__ __forceinline__ void run_range(LAS unsigned char* ldsp) {
    run_phase<PH>(ldsp);
    if constexpr (PH + 1 < HI) { if constexpr (PH == 0) cg::this_grid().sync(); else grid_bar(); run_range<PH + 1, HI>(ldsp); }
}
template <int LO, int HI>
__global__ void __launch_bounds__(NTHREADS, 2) mk_fwd(Args args) {
    extern __shared__ __attribute__((aligned(16))) unsigned char lds[];
    if constexpr (HI - LO > 1) {
        volatile LAS unsigned* st = (volatile LAS unsigned*)((LAS unsigned char*)lds + LDS_ST_OFF);
        if (threadIdx.x == 0) { st[0] = 0u; st[1] = 0u; }
        __syncthreads();
        (void)xcd_barrier_post((unsigned*)((const __attribute__((address_space(4))) Args*)__builtin_amdgcn_kernarg_segment_ptr())->ws + CW_BAR, st);
    }
    run_range<LO, HI>((LAS unsigned char*)lds);
}

#ifndef MK_ONE_LAUNCH
#define MK_ONE_LAUNCH 1
#endif
template <int PH> static void launch_phases(const Args& a, int grid, hipStream_t stream) {
    hipFuncSetAttribute((const void*)mk_fwd<PH, PH + 1>, hipFuncAttributeMaxDynamicSharedMemorySize, LDS_BYTES);
    hipLaunchKernelGGL((mk_fwd<PH, PH + 1>), dim3(grid), dim3(NTHREADS), LDS_BYTES, stream, a);
    if constexpr (PH + 1 < N_PHASES) launch_phases<PH + 1>(a, grid, stream);
}

extern "C" void kernel_launch(void* const* d_in, const int* in_sizes, int n_in, void* d_out, int out_size, void* d_ws, size_t ws_size, hipStream_t stream) {
    static int grid = 0;
    if (grid == 0) {
        if (n_in != N_IN || out_size != ML * DM || ws_size < WS_END) { fprintf(stderr, "kernel_launch: unexpected shapes n_in %d out %d ws %zu (need %zu)\n", n_in, out_size, ws_size, (size_t)WS_END); grid = -1; return; }
        int dev = 0, cus = 0;
        (void)hipGetDevice(&dev); (void)hipDeviceGetAttribute(&cus, hipDeviceAttributeMultiprocessorCount, dev);
#if MK_ONE_LAUNCH
        int per_cu = 0;
        if (hipFuncSetAttribute((const void*)mk_fwd<0, N_PHASES>, hipFuncAttributeMaxDynamicSharedMemorySize, LDS_BYTES) != hipSuccess) { fprintf(stderr, "hipFuncSetAttribute failed\n"); grid = -1; return; }
        (void)hipOccupancyMaxActiveBlocksPerMultiprocessor(&per_cu, (const void*)mk_fwd<0, N_PHASES>, NTHREADS, LDS_BYTES);
        (void)hipGetLastError();
        fprintf(stderr, "kernel_launch: cus %d per_cu %d\n", cus, per_cu);
        if (per_cu < 1) { grid = -1; return; }
#endif
        grid = cus;
    }
    if (grid < 0) return;
    (void)hipMemsetAsync((char*)d_ws + WS_CTL, 0, 65536, stream);
    Args a{};
    for (int i = 0; i < N_IN; ++i) a.in[i] = (const float*)d_in[i];
    a.out = (float*)d_out; a.ws = (unsigned char*)d_ws;
#if MK_ONE_LAUNCH
    void* kargs[] = {&a};
    hipError_t e = hipLaunchCooperativeKernel((const void*)mk_fwd<0, N_PHASES>, dim3(grid), dim3(NTHREADS), kargs, LDS_BYTES, stream);
    if (e != hipSuccess) fprintf(stderr, "cooperative launch failed: %s\n", hipGetErrorString(e));
#else
    launch_phases<0>(a, grid, stream);
#endif
}
```

```cpp
#include <hip/hip_runtime.h>
#include <hip/hip_cooperative_groups.h>
#include <cstdio>
#include <cstdint>
namespace cg = cooperative_groups;
namespace pg8 {
#define PG8_LAS __attribute__((address_space(3)))
typedef unsigned short bf16_t;
typedef short bf16x8 __attribute__((ext_vector_type(8)));
typedef float f32x4 __attribute__((ext_vector_type(4)));
typedef unsigned u32x4 __attribute__((ext_vector_type(4)));
constexpr int BM = 256, BK = 64, HALF = 128, HTB = HALF * BK * 2  , STAGE_BYTES = 8 * HTB, NXCD = 8, WGM = 8;

__host__ __device__ __forceinline__ int lds_byte(int r, int c) { const int st = (r >> 4) * 2 + (c >> 5), rr = r & 15, cc = c & 31, ob = rr * 64 + cc * 2; return st * 1024 + (ob ^ (((ob >> 9) & 1) << 5)); }
__host__ __device__ __forceinline__ void stage_rc(int b, int& R, int& C) { const int st = b / 1024, sb = b % 1024, swz = sb ^ (((sb >> 9) & 1) << 5); R = (st >> 1) * 16 + swz / 64; C = (st & 1) * 32 + (swz % 64) / 2; }
__host__ __device__ __forceinline__ int perm32(int rho) { const int n = rho >> 4, i = rho & 15; return 8 * (i >> 2) + 4 * n + (i & 3); }

struct Unit { int pm, pn, kofs; };
struct Gemm { const bf16_t* A; const bf16_t* Bt; int M, N, K, lda, ldb; };

struct StaticOrder {
    int nM, nN, nwg, G, c;
    __host__ __device__ void init(int M, int N, int G_, int c_) { nM = M / BM; nN = N / BM; nwg = nM * nN; G = G_; c = c_; }
    __host__ __device__ bool next(int i, Unit& u) const {
        const long L = (long)i * G + c; if (L >= nwg) return false;
        int wgid = (int)L; { const int q = nwg / NXCD, r = nwg % NXCD, xcd = wgid % NXCD, off = wgid / NXCD; wgid = (xcd < r ? xcd * (q + 1) : r * (q + 1) + (xcd - r) * q) + off; }
        const int nig = WGM * nN, gid = wgid / nig, fm = gid * WGM, gsz = (nM - fm) < WGM ? (nM - fm) : WGM;
        u.pm = fm + ((wgid % nig) % gsz); u.pn = (wgid % nig) / gsz; u.kofs = 0; return true;
    }
    __device__ __forceinline__ void a_ready(const Unit&) const {}
    __device__ __forceinline__ void done(const Unit&) const {}
};

__device__ __forceinline__ unsigned cvt_pk_bf16(float lo, float hi) { unsigned r; asm volatile("v_cvt_pk_bf16_f32 %0, %1, %2" : "=v"(r) : "v"(lo), "v"(hi)); return r; }
typedef float f32x2 __attribute__((ext_vector_type(2)));

template <class Epi, class Sched, bool ALIGN_EPI = false, bool SP2 = false>
__device__ __forceinline__ void gemm_phase(PG8_LAS unsigned char* lds, const Gemm g, const Sched& S, const Epi& E) {
    const int tid = threadIdx.x, wid = __builtin_amdgcn_readfirstlane(tid >> 6), lane = tid & 63, wr = wid >> 2, wc = wid & 3, fr = lane & 15, fq = lane >> 4;
    const int K = g.K, nt = K / BK;
    unsigned voffA[2], voffB[2];
#pragma unroll
    for (int i = 0; i < 2; ++i) { int R, C; stage_rc(tid * 16 + i * 8192, R, C); const int Rb = Epi::PERM ? ((R & ~31) + perm32(R & 31)) : R;
        voffA[i] = (unsigned)(R * g.lda + C) * 2u; voffB[i] = (unsigned)(Rb * g.ldb + C) * 2u; }
    const size_t kstep = (size_t)(BK * 2);
    const size_t hstepA = (size_t)HALF * g.lda * 2, hstepB = (size_t)HALF * g.ldb * 2;
    const size_t tstepA = 2 * hstepA, tstepB = 2 * hstepB;
    const unsigned ldsw = (unsigned)wid * 1024u;
    const int aoff = lds_byte(wr * 64 + fr, fq * 8), boff = lds_byte(wc * 32 + fr, fq * 8);
#define PG8_SA(b, h) (((b) * 2 + (h)) * HTB)
#define PG8_SB(b, h) ((4 + (b) * 2 + (h)) * HTB)
#define PG8_STAGE(bufoff, gbase, voff) do { _Pragma("unroll") for (int _i = 0; _i < 2; ++_i) \
        __builtin_amdgcn_global_load_lds((const unsigned*)((const char*)(gbase) + (voff)[_i]), (PG8_LAS unsigned*)(lds + (bufoff) + ldsw + _i * 8192), 16, 0, 0); } while (0)
#define PG8_LDA(dst, b, h) do { _Pragma("unroll") for (int m = 0; m < 4; ++m) _Pragma("unroll") for (int k = 0; k < 2; ++k) dst[m][k] = *(const PG8_LAS bf16x8*)(lds + PG8_SA(b, h) + aoff + m * 2048 + k * 1024); } while (0)
#define PG8_LDB(dst, b, h) do { _Pragma("unroll") for (int n = 0; n < 2; ++n) _Pragma("unroll") for (int k = 0; k < 2; ++k) dst[n][k] = *(const PG8_LAS bf16x8*)(lds + PG8_SB(b, h) + boff + n * 2048 + k * 1024); } while (0)
#define PG8_MMA(ai, bj, At, Bt) do { __builtin_amdgcn_s_setprio(1); _Pragma("unroll") for (int m = 0; m < 4; ++m) _Pragma("unroll") for (int n = 0; n < 2; ++n) _Pragma("unroll") for (int k = 0; k < 2; ++k) \
        acc[ai][bj][m][n] = __builtin_amdgcn_mfma_f32_16x16x32_bf16(Bt[n][k], At[m][k], acc[ai][bj][m][n], 0, 0, 0); __builtin_amdgcn_s_setprio(0); } while (0)
#define PG8_WAIT_V(n) asm volatile("s_waitcnt vmcnt(" #n ")" ::: "memory")
#define PG8_WAIT_L(n) asm volatile("s_waitcnt lgkmcnt(" #n ")" ::: "memory")
#define PG8_BAR __builtin_amdgcn_s_barrier()
#define PG8_SCHED __builtin_amdgcn_sched_barrier(0)
    Unit cur, nxt; int ui = 0;
    if (!S.next(0, cur)) return;
    f32x4 acc[2][2][4][2];
#pragma unroll
    for (int a = 0; a < 2; ++a)
#pragma unroll
        for (int b = 0; b < 2; ++b)
#pragma unroll
            for (int m = 0; m < 4; ++m)
#pragma unroll
                for (int n = 0; n < 2; ++n) acc[a][b][m][n] = (f32x4){0.f, 0.f, 0.f, 0.f};
    bf16x8 At[4][2], B0[2][2], B1[2][2];
    const char* cA = (const char*)g.A + (size_t)cur.pm * tstepA + (size_t)cur.kofs * 2; const char* cB = (const char*)g.Bt + (size_t)cur.pn * tstepB + (size_t)cur.kofs * 2;
    S.a_ready(cur);
    if constexpr (SP2) {
        PG8_STAGE(PG8_SB(0, 0), cB, voffB); PG8_STAGE(PG8_SB(0, 1), cB + hstepB, voffB); PG8_STAGE(PG8_SA(0, 0), cA, voffA); PG8_STAGE(PG8_SA(0, 1), cA + hstepA, voffA);
        if (wr == 1) PG8_BAR;
        PG8_WAIT_V(2); PG8_BAR;
        PG8_STAGE(PG8_SB(1, 0), cB + kstep, voffB); PG8_STAGE(PG8_SA(1, 0), cA + kstep, voffA); PG8_STAGE(PG8_SB(1, 1), cB + hstepB + kstep, voffB);
        PG8_WAIT_V(6); PG8_BAR;
    } else {
        PG8_STAGE(PG8_SB(0, 0), cB, voffB); PG8_STAGE(PG8_SA(0, 0), cA, voffA); PG8_STAGE(PG8_SB(0, 1), cB + hstepB, voffB); PG8_STAGE(PG8_SA(0, 1), cA + hstepA, voffA);
        if (wr == 1) PG8_BAR;
        PG8_WAIT_V(4); PG8_BAR;
        PG8_STAGE(PG8_SB(1, 0), cB + kstep, voffB); PG8_STAGE(PG8_SA(1, 0), cA + kstep, voffA); PG8_STAGE(PG8_SB(1, 1), cB + hstepB + kstep, voffB);
        PG8_WAIT_V(6); PG8_BAR;
    }
    for (;;) {
        const bool has_next = S.next(ui + 1, nxt);
        const char* nA = has_next ? (const char*)g.A + (size_t)nxt.pm * tstepA + (size_t)nxt.kofs * 2 : cA; const char* nB = has_next ? (const char*)g.Bt + (size_t)nxt.pn * tstepB + (size_t)nxt.kofs * 2 : cB;
        for (int t = 0; t < nt; t += 2) {
            const bool last = (t == nt - 2);
            const char* a1 = cA + (size_t)(t + 1) * kstep;
            const char* a2 = last ? nA : cA + (size_t)(t + 2) * kstep; const char* b2 = last ? nB : cB + (size_t)(t + 2) * kstep;
            const char* a3 = a2 + kstep; const char* b3 = b2 + kstep;
            if (last && has_next) S.a_ready(nxt);
            if constexpr (SP2) {
            PG8_LDB(B0, 0, 0); PG8_LDB(B1, 0, 1); PG8_SCHED; PG8_LDA(At, 0, 0); PG8_STAGE(PG8_SA(1, 1), a1 + hstepA, voffA);
            PG8_WAIT_V(8); PG8_WAIT_L(0); PG8_BAR; PG8_MMA(0, 0, At, B0); PG8_MMA(0, 1, At, B1); PG8_BAR; PG8_SCHED;
            PG8_LDA(At, 0, 1); PG8_STAGE(PG8_SB(0, 0), b2, voffB); PG8_STAGE(PG8_SB(0, 1), b2 + hstepB, voffB); PG8_STAGE(PG8_SA(0, 0), a2, voffA);
            PG8_WAIT_V(8); PG8_WAIT_L(0); PG8_BAR; PG8_MMA(1, 0, At, B0); PG8_MMA(1, 1, At, B1); PG8_BAR; PG8_SCHED;
            PG8_LDB(B0, 1, 0); PG8_LDB(B1, 1, 1); PG8_SCHED; PG8_LDA(At, 1, 0); PG8_STAGE(PG8_SA(0, 1), a2 + hstepA, voffA);
            PG8_WAIT_V(8); PG8_WAIT_L(0); PG8_BAR; PG8_MMA(0, 0, At, B0); PG8_MMA(0, 1, At, B1); PG8_BAR; PG8_SCHED;
            PG8_LDA(At, 1, 1); PG8_STAGE(PG8_SB(1, 0), b3, voffB); PG8_STAGE(PG8_SB(1, 1), b3 + hstepB, voffB); PG8_STAGE(PG8_SA(1, 0), a3, voffA);
            PG8_WAIT_V(8); PG8_WAIT_L(0); PG8_BAR; PG8_MMA(1, 0, At, B0); PG8_MMA(1, 1, At, B1); PG8_BAR; PG8_SCHED;
            } else {
            PG8_LDB(B0, 0, 0); PG8_SCHED; PG8_LDA(At, 0, 0); PG8_STAGE(PG8_SA(1, 1), a1 + hstepA, voffA);
            PG8_WAIT_L(8); PG8_BAR; PG8_WAIT_L(0); PG8_MMA(0, 0, At, B0); PG8_BAR; PG8_SCHED;
            PG8_LDB(B1, 0, 1); PG8_STAGE(PG8_SB(0, 0), b2, voffB);
            PG8_BAR; PG8_WAIT_L(0); PG8_MMA(0, 1, At, B1); PG8_BAR;
            PG8_LDA(At, 0, 1); PG8_STAGE(PG8_SA(0, 0), a2, voffA);
            PG8_BAR; PG8_WAIT_L(0); PG8_MMA(1, 0, At, B0); PG8_BAR; PG8_SCHED;
            PG8_STAGE(PG8_SB(0, 1), b2 + hstepB, voffB);
            PG8_WAIT_V(6); PG8_BAR; PG8_MMA(1, 1, At, B1); PG8_BAR;
            PG8_LDB(B0, 1, 0); PG8_SCHED; PG8_LDA(At, 1, 0); PG8_STAGE(PG8_SA(0, 1), a2 + hstepA, voffA);
            PG8_WAIT_L(8); PG8_BAR; PG8_WAIT_L(0); PG8_MMA(0, 0, At, B0); PG8_BAR; PG8_SCHED;
            PG8_LDB(B1, 1, 1); PG8_STAGE(PG8_SB(1, 0), b3, voffB);
            PG8_BAR; PG8_WAIT_L(0); PG8_MMA(0, 1, At, B1); PG8_BAR;
            PG8_LDA(At, 1, 1); PG8_STAGE(PG8_SA(1, 0), a3, voffA);
            PG8_BAR; PG8_WAIT_L(0); PG8_MMA(1, 0, At, B0); PG8_BAR; PG8_SCHED;
            PG8_STAGE(PG8_SB(1, 1), b3 + hstepB, voffB);
            PG8_WAIT_V(6); PG8_BAR; PG8_MMA(1, 1, At, B1); PG8_BAR;
            }
        }
        if constexpr (ALIGN_EPI) { if (wr == 0) PG8_BAR; }
        if constexpr (!Epi::AFTER_DRAIN) { E(acc, cur, wr, wc, fr, fq); S.done(cur); }
        if (!has_next) break;
#pragma unroll
        for (int a = 0; a < 2; ++a)
#pragma unroll
            for (int b = 0; b < 2; ++b)
#pragma unroll
                for (int m = 0; m < 4; ++m)
#pragma unroll
                    for (int n = 0; n < 2; ++n) acc[a][b][m][n] = (f32x4){0.f, 0.f, 0.f, 0.f};
        cur = nxt; cA = nA; cB = nB; ++ui;
        if constexpr (ALIGN_EPI) { if (wr == 1) PG8_BAR; }
    }
    PG8_WAIT_V(0);
    if constexpr (!ALIGN_EPI) { if (wr == 0) PG8_BAR; }
    PG8_BAR;
    if constexpr (Epi::AFTER_DRAIN) { E.fused(acc, cur, wr, wc, fr, fq, lds, wid, lane); S.done(cur); }
#undef PG8_SA
#undef PG8_SB
#undef PG8_STAGE
#undef PG8_LDA
#undef PG8_LDB
#undef PG8_MMA
#undef PG8_WAIT_V
#undef PG8_WAIT_L
#undef PG8_BAR
#undef PG8_SCHED
}
}


constexpr int DM = 2048, NB = 2, SEQL = 4096, CTXL = 256, DEPTH = 2;
constexpr int ML = NB * SEQL, MC = NB * CTXL, MT = ML + MC;
constexpr int NIN = 3840, NINR = 3600;
constexpr int FF = 5632, FF2 = 11264;
constexpr int GW = 512;
constexpr float ALPHA = 1.4142135623730951f;
constexpr float LN_EPS = 1e-5f, RMS_EPS = 1e-5f;
constexpr int ADA_KS = 16;
constexpr int PC_S5 = 0, PC_SGU = 512, PC_SGV = 1024, PC_POOL = 1536, PC_Z = 2048, PC_XBC = 2560, PC_DT = 3584;
constexpr int MX_S5 = 0, MX_SG = 512, MX_POOL = 1024, MX_SSD = 1536;

enum { I_X = 0, I_C, I_CTX, I_CCTX, I_WADA, I_BADA, I_WIN, I_WOUT, I_LN1G, I_LN1B, I_LN2G, I_LN2B,
       I_S5ARE, I_S5AIM, I_S5BRE, I_S5BIM, I_S5CRE, I_S5CIM, I_S5LS, I_S5D, I_GLUW, I_GLUB,
       I_SGLNG, I_SGLNB, I_SGW, I_SGB, I_POOLW, I_POOLB, I_POOLS,
       I_M2CW, I_M2CB, I_M2DTB, I_M2ALOG, I_M2D, I_M2NW,
       I_WUP, I_FCW, I_FCB, I_WDN, N_IN };

constexpr size_t MiB = 1u << 20;
constexpr size_t WS_CTL = 0;
constexpr size_t WS_MADA = 1 * MiB;
constexpr size_t WS_MPART = 2 * MiB;
constexpr size_t WS_SGWB = 7 * MiB;
constexpr size_t WS_POOLWT = 7 * MiB + 512 * 1024;
constexpr size_t WS_WIN = 8 * MiB;
constexpr size_t WS_WOUT = 40 * MiB;
constexpr size_t WS_WUP = 56 * MiB;
constexpr size_t WS_WDN = 144 * MiB;
constexpr size_t WS_WGLU = 188 * MiB;
constexpr size_t WS_H = 190 * MiB;
constexpr size_t WS_HMOD = 258 * MiB;
constexpr size_t WS_P = 292 * MiB;
constexpr size_t WS_DT = 356 * MiB;
constexpr size_t WS_DTS = 357 * MiB;
constexpr size_t WS_MIX = 358 * MiB;
constexpr size_t WS_Z = 392 * MiB;
constexpr size_t WS_Y5 = 401 * MiB;
constexpr size_t WS_SLAB = 418 * MiB;
constexpr size_t WS_XC = 418 * MiB;
constexpr size_t WS_YD = 452 * MiB;
constexpr size_t WS_GV = 486 * MiB;
constexpr size_t WS_ACT = WS_P;
constexpr size_t WS_S5KT = 673 * MiB;
constexpr size_t WS_S5WS = 676 * MiB;
constexpr size_t WS_S5WC = 692 * MiB;
constexpr size_t WS_S5AQ = 708 * MiB;
constexpr size_t WS_S5S = WS_Y5;
constexpr size_t WS_S5HIN = WS_Y5 + 10 * MiB;
constexpr size_t WS_SST = 709 * MiB;
constexpr size_t WS_SHIN = 743 * MiB;
constexpr size_t WS_SDEC = 760 * MiB;
constexpr size_t WS_END = 767 * MiB;
constexpr int S5Q = 32, S5NCH = MT / S5Q;

constexpr int NWAVES = 8, NTHREADS = 512;
constexpr int LDS_BYTES = 163840;

#define GAS __attribute__((address_space(1)))
#define LAS __attribute__((address_space(3)))
typedef unsigned short bf16;
typedef unsigned v4u __attribute__((ext_vector_type(4)));
typedef unsigned v2u __attribute__((ext_vector_type(2)));
typedef float f32x4 __attribute__((ext_vector_type(4)));

__device__ __forceinline__ unsigned f2bf(float f) { unsigned u = __builtin_bit_cast(unsigned, f); return (u + 0x7fffu + ((u >> 16) & 1u)) >> 16; }
__device__ __forceinline__ unsigned pk2(float lo, float hi) { return f2bf(lo) | (f2bf(hi) << 16); }
__device__ __forceinline__ float bf2f(unsigned short h) { return __builtin_bit_cast(float, (unsigned)h << 16); }
__device__ __forceinline__ float bflo(unsigned w) { return __builtin_bit_cast(float, w << 16); }
__device__ __forceinline__ float bfhi(unsigned w) { return __builtin_bit_cast(float, w & 0xffff0000u); }
__device__ __forceinline__ float sigmoidf_(float x) { return 1.f / (1.f + __expf(-x)); }
__device__ __forceinline__ float siluf_(float x) { return x * sigmoidf_(x); }
__device__ __forceinline__ float gelu_tanh(float x) {
    const float u = 0.7978845608028654f * (x + 0.044715f * x * x * x);
    const float t = 1.f - 2.f / (1.f + __expf(2.f * u));
    return 0.5f * x * (1.f + t);
}
__device__ __forceinline__ float softplusf_(float x) { return x > 20.f ? x : log1pf(expf(x)); }
__device__ __forceinline__ float wave_sum(float v) {
#pragma unroll
    for (int o = 1; o < 64; o <<= 1) v += __shfl_xor(v, o);
    return v;
}

namespace pg8 {
struct EpiIn {
    static constexpr bool PERM = true, AFTER_DRAIN = false;
    bf16_t* P; float* DT;
    __device__ __forceinline__ void operator()(const f32x4 (&acc)[2][2][4][2], const Unit& u, int wr, int wc, int fr, int fq) const {
        const int row0 = u.pm * BM + wr * 64 + fr;
        if (u.pn == 14) {
            if (wc == 0 && fq < 2) {
#pragma unroll
                for (int ai = 0; ai < 2; ++ai)
#pragma unroll
                    for (int m = 0; m < 4; ++m) { float* d = DT + (size_t)(row0 + ai * HALF + m * 16) * 16 + 8 * fq;
                        *(f32x4*)(d) = acc[ai][0][m][0]; *(f32x4*)(d + 4) = acc[ai][0][m][1]; }
            }
            return;
        }
        const int col0 = u.pn * BM + wc * 32 + 8 * fq;
#pragma unroll
        for (int ai = 0; ai < 2; ++ai)
#pragma unroll
            for (int m = 0; m < 4; ++m) { bf16_t* rowp = P + (size_t)(row0 + ai * HALF + m * 16) * NIN + col0;
#pragma unroll
                for (int bj = 0; bj < 2; ++bj) { const f32x4 v0 = acc[ai][bj][m][0], v1 = acc[ai][bj][m][1];
                    u32x4 w; w.x = cvt_pk_bf16(v0[0], v0[1]); w.y = cvt_pk_bf16(v0[2], v0[3]); w.z = cvt_pk_bf16(v1[0], v1[1]); w.w = cvt_pk_bf16(v1[2], v1[3]);
                    *(u32x4*)(rowp + bj * HALF) = w; } }
    }
};
struct EpiStore {
    static constexpr bool PERM = true, AFTER_DRAIN = false;
    bf16_t* O; int ldc;
    __device__ __forceinline__ void operator()(const f32x4 (&acc)[2][2][4][2], const Unit& u, int wr, int wc, int fr, int fq) const {
        const int row0 = u.pm * BM + wr * 64 + fr, col0 = u.pn * BM + wc * 32 + 8 * fq;
#pragma unroll
        for (int ai = 0; ai < 2; ++ai)
#pragma unroll
            for (int m = 0; m < 4; ++m) { bf16_t* rowp = O + (size_t)(row0 + ai * HALF + m * 16) * ldc + col0;
#pragma unroll
                for (int bj = 0; bj < 2; ++bj) { const f32x4 v0 = acc[ai][bj][m][0], v1 = acc[ai][bj][m][1];
                    u32x4 w; w.x = cvt_pk_bf16(v0[0], v0[1]); w.y = cvt_pk_bf16(v0[2], v0[3]); w.z = cvt_pk_bf16(v1[0], v1[1]); w.w = cvt_pk_bf16(v1[2], v1[3]);
                    *(u32x4*)(rowp + bj * HALF) = w; } }
    }
};
struct EpiGlu {
    static constexpr bool PERM = true, AFTER_DRAIN = false;
    const bf16_t* Z; bf16_t* O; const float* bias;
    __device__ __forceinline__ void operator()(const f32x4 (&acc)[2][2][4][2], const Unit& u, int wr, int wc, int fr, int fq) const {
        const int row0 = u.pm * BM + wr * 64 + fr, col0 = u.pn * BM + wc * 32 + 8 * fq;
#pragma unroll
        for (int ai = 0; ai < 2; ++ai)
#pragma unroll
            for (int m = 0; m < 4; ++m) { const int row = row0 + ai * HALF + m * 16;
#pragma unroll
                for (int bj = 0; bj < 2; ++bj) { const int col = col0 + bj * HALF;
                    const u32x4 zz = *(const u32x4*)(Z + (size_t)row * GW + col);
                    const f32x4 b0 = *(const f32x4*)(bias + col), b1 = *(const f32x4*)(bias + col + 4);
                    const f32x4 v0 = acc[ai][bj][m][0] + b0, v1 = acc[ai][bj][m][1] + b1;
                    float o[8];
                    o[0] = bflo(zz.x) * sigmoidf_(v0[0]); o[1] = bfhi(zz.x) * sigmoidf_(v0[1]); o[2] = bflo(zz.y) * sigmoidf_(v0[2]); o[3] = bfhi(zz.y) * sigmoidf_(v0[3]);
                    o[4] = bflo(zz.z) * sigmoidf_(v1[0]); o[5] = bfhi(zz.z) * sigmoidf_(v1[1]); o[6] = bflo(zz.w) * sigmoidf_(v1[2]); o[7] = bfhi(zz.w) * sigmoidf_(v1[3]);
                    u32x4 w; w.x = cvt_pk_bf16(o[0], o[1]); w.y = cvt_pk_bf16(o[2], o[3]); w.z = cvt_pk_bf16(o[4], o[5]); w.w = cvt_pk_bf16(o[6], o[7]);
                    *(u32x4*)(O + (size_t)row * DM + col) = w; } }
    }
};
struct EpiRes {
    static constexpr bool PERM = false, AFTER_DRAIN = false;
    float* H; const float* gate; int vstride;
    __device__ __forceinline__ void operator()(const f32x4 (&acc)[2][2][4][2], const Unit& u, int wr, int wc, int fr, int fq) const {
        const int row0 = u.pm * BM + wr * 64 + fr, col0 = u.pn * BM + wc * 32 + 4 * fq;
        const int var = u.pm < 16 ? 0 : (u.pm < 32 ? 1 : 2);
        const float* gv = gate + (size_t)var * vstride;
#pragma unroll
        for (int bj = 0; bj < 2; ++bj)
#pragma unroll
            for (int n = 0; n < 2; ++n) { const int col = col0 + bj * HALF + n * 16; const f32x4 g4 = *(const f32x4*)(gv + col);
#pragma unroll
                for (int ai = 0; ai < 2; ++ai)
#pragma unroll
                    for (int m = 0; m < 4; ++m) { float* p = H + (size_t)(row0 + ai * HALF + m * 16) * DM + col;
                        const f32x4 hv = *(const f32x4*)p; *(f32x4*)p = hv * ALPHA + g4 * acc[ai][bj][m][n]; } }
    }
};
struct SplitOrder {
    int nN, KS, KSL, pm0, nwg, G, c;
    __host__ __device__ void init(int N, int KS_, int KSL_, int pm0_, int G_, int c_) { nN = N / BM; KS = KS_; KSL = KSL_; pm0 = pm0_; nwg = 2 * nN * KS; G = G_; c = c_; }
    __host__ __device__ bool next(int i, Unit& u) const {
        const long L = (long)i * G + c; if (L >= nwg) return false;
        const int ks = (int)L / (2 * nN), r = (int)L % (2 * nN); u.pm = pm0 + (r & 1); u.pn = r >> 1; u.kofs = ks * KSL; return true;
    }
    __device__ __forceinline__ void a_ready(const Unit&) const {}
    __device__ __forceinline__ void done(const Unit&) const {}
};
struct EpiSlab {
    static constexpr bool PERM = false, AFTER_DRAIN = false;
    float* S; int KSL, pm0;
    __device__ __forceinline__ void operator()(const f32x4 (&acc)[2][2][4][2], const Unit& u, int wr, int wc, int fr, int fq) const {
        const int row0 = (u.pm - pm0) * BM + wr * 64 + fr, col0 = u.pn * BM + wc * 32 + 4 * fq;
        float* base = S + (size_t)(u.kofs / KSL) * MC * DM;
#pragma unroll
        for (int ai = 0; ai < 2; ++ai)
#pragma unroll
            for (int m = 0; m < 4; ++m) { float* rowp = base + (size_t)(row0 + ai * HALF + m * 16) * DM + col0;
#pragma unroll
                for (int bj = 0; bj < 2; ++bj)
#pragma unroll
                    for (int n = 0; n < 2; ++n) *(f32x4*)(rowp + bj * HALF + n * 16) = acc[ai][bj][m][n]; }
    }
};
}

struct Args { const float* in[N_IN]; float* out; unsigned char* ws; };

struct Frame {
    LAS unsigned char* lds;
    int tid, lane, wave, bid, G;
    const __attribute__((address_space(4))) Args* a;
};
#define WSP(T, off) ((T*)(F.a->ws + (off)))

__device__ __forceinline__ void row_seq(int row, int& base, int& t, int& len) {
    if (row < ML) { base = row & ~(SEQL - 1); t = row & (SEQL - 1); len = SEQL; }
    else { base = ML + ((row - ML) & ~(CTXL - 1)); t = (row - ML) & (CTXL - 1); len = CTXL; }
}
__device__ __forceinline__ int proc_row(int q, int dir, int b) {
    if (q < CTXL) { const int t = dir ? (CTXL - 1 - q) : q; return ML + b * CTXL + t; }
    const int ql = q - CTXL; const int t = dir ? (SEQL - 1 - ql) : ql; return b * SEQL + t;
}

__device__ __forceinline__ void transpose_item(const float* W, int K, int N, bf16* WT, LAS float* scr, int item, int nblk, int lane) {
    const int kb = item / nblk, nb = item % nblk, k0 = 64 * kb, n0 = 32 * nb;
    const int nn = n0 + (lane & 31);
#pragma unroll 8
    for (int i = 0; i < 32; ++i) { const int kk = 2 * i + (lane >> 5); scr[kk * 33 + (lane & 31)] = (nn < N) ? W[(size_t)(k0 + kk) * N + nn] : 0.f; }
    asm volatile("s_waitcnt lgkmcnt(0)" ::: "memory");
    const int c = lane & 7;
#pragma unroll
    for (int j = 0; j < 4; ++j) { const int n = (lane >> 3) + 8 * j; const LAS float* s = scr + (8 * c) * 33 + n;
        v4u o; o.x = pk2(s[0 * 33], s[1 * 33]); o.y = pk2(s[2 * 33], s[3 * 33]); o.z = pk2(s[4 * 33], s[5 * 33]); o.w = pk2(s[6 * 33], s[7 * 33]);
        *(v4u*)(WT + (size_t)(n0 + n) * K + k0 + 8 * c) = o; }
    asm volatile("s_waitcnt lgkmcnt(0)" ::: "memory");
}

__device__ __forceinline__ void phase_pro_a(Frame& F) {
    LAS float* scr = (LAS float*)(F.lds + F.wave * 16384);
    const int gw = F.bid * NWAVES + F.wave, NGW = F.G * NWAVES;
    constexpr int I_IN = (DM / 64) * (NIN / 32), I_OUT = (DM / 64) * (DM / 32), I_UP = (DM / 64) * (FF2 / 32), I_DN = (FF / 64) * (DM / 32), I_GL = (GW / 64) * (GW / 32);
    constexpr int PER_L = I_IN + I_OUT + I_UP + I_DN + I_GL;
    for (int it = gw; it < DEPTH * PER_L; it += NGW) {
        const int l = it / PER_L; int r = it % PER_L;
        if (r < I_IN) { transpose_item(F.a->in[I_WIN] + (size_t)l * DM * NINR, DM, NINR, WSP(bf16, WS_WIN) + (size_t)l * NIN * DM, scr, r, NIN / 32, F.lane); continue; } r -= I_IN;
        if (r < I_OUT) { transpose_item(F.a->in[I_WOUT] + (size_t)l * DM * DM, DM, DM, WSP(bf16, WS_WOUT) + (size_t)l * DM * DM, scr, r, DM / 32, F.lane); continue; } r -= I_OUT;
        if (r < I_UP) { transpose_item(F.a->in[I_WUP] + (size_t)l * DM * FF2, DM, FF2, WSP(bf16, WS_WUP) + (size_t)l * FF2 * DM, scr, r, FF2 / 32, F.lane); continue; } r -= I_UP;
        if (r < I_DN) { transpose_item(F.a->in[I_WDN] + (size_t)l * FF * DM, FF, DM, WSP(bf16, WS_WDN) + (size_t)l * DM * FF, scr, r, DM / 32, F.lane); continue; } r -= I_DN;
        transpose_item(F.a->in[I_GLUW] + (size_t)l * GW * GW, GW, GW, WSP(bf16, WS_WGLU) + (size_t)l * GW * GW, scr, r, GW / 32, F.lane);
    }
    constexpr int NCB = 6 * DM / 256, KSL = DM / ADA_KS;
    const float* c = F.a->in[I_C]; const float* cc = F.a->in[I_CCTX];
    for (int job = gw; job < DEPTH * NCB * ADA_KS; job += NGW) {
        const int l = job / (NCB * ADA_KS), r = job % (NCB * ADA_KS), cb = r / ADA_KS, ks = r % ADA_KS;
        const float* W = F.a->in[I_WADA] + (size_t)l * DM * 6 * DM + cb * 256 + F.lane * 4;
        f32x4 a0 = {0.f, 0.f, 0.f, 0.f}, a1 = a0, a2 = a0;
#pragma unroll 4
        for (int k = ks * KSL; k < (ks + 1) * KSL; ++k) {
            const f32x4 w = *(const f32x4*)(W + (size_t)k * 6 * DM);
            const float s0 = siluf_(c[k]), s1 = siluf_(c[DM + k]), s2 = siluf_(cc[k]);
            a0 += w * s0; a1 += w * s1; a2 += w * s2;
        }
        float* mp = WSP(float, WS_MPART) + ((size_t)(l * ADA_KS + ks) * 3) * 6 * DM + cb * 256 + F.lane * 4;
        *(f32x4*)(mp) = a0; *(f32x4*)(mp + 6 * DM) = a1; *(f32x4*)(mp + 2 * 6 * DM) = a2;
    }
}

__device__ __forceinline__ void phase_pro_b(Frame& F) {
    const int gt = F.bid * NTHREADS + F.tid, NGT = F.G * NTHREADS;
    for (int i = gt; i < DEPTH * 3 * 6 * DM; i += NGT) {
        const int l = i / (3 * 6 * DM), r = i % (3 * 6 * DM), v = r / (6 * DM), n = r % (6 * DM);
        float s = F.a->in[I_BADA][l * 6 * DM + n];
        const float* mp = WSP(float, WS_MPART) + ((size_t)(l * ADA_KS) * 3 + v) * 6 * DM + n;
#pragma unroll
        for (int ks = 0; ks < ADA_KS; ++ks) s += mp[(size_t)ks * 3 * 6 * DM];
        WSP(float, WS_MADA)[i] = s;
    }
}
__device__ __forceinline__ const float* mvec(Frame& F, int l, int v, int j) { return WSP(float, WS_MADA) + ((size_t)(l * 3 + v) * 6 + j) * DM; }
__device__ __forceinline__ int row_var(int row) { return row < SEQL ? 0 : (row < ML ? 1 : 2); }

template <bool DO_LN>
__device__ __forceinline__ void row_pass(Frame& F, const float* srcrow, const float* g, const float* b, float* dstrow, bf16* modrow, const float* shift, const float* scale,
                                         const float* slab = nullptr, int nslab = 0, const float* gatev = nullptr) {
    int lo = F.lane * 4; asm volatile("" : "+v"(lo));
    f32x4 v[8];
#pragma unroll
    for (int j = 0; j < 8; ++j) v[j] = *(const f32x4*)(srcrow + lo + j * 256);
    if (slab) {
#pragma unroll 1
        for (int jj = 0; jj < 8; jj += 2) {
            f32x4 a0 = {0.f, 0.f, 0.f, 0.f}, a1 = a0;
            const float* sp = slab + lo + jj * 256;
#pragma unroll 1
            for (int k = 0; k < nslab; ++k) { a0 += *(const f32x4*)(sp); a1 += *(const f32x4*)(sp + 256); sp += (size_t)MC * DM; }
            const f32x4 g0 = *(const f32x4*)(gatev + lo + jj * 256), g1 = *(const f32x4*)(gatev + lo + jj * 256 + 256);
            if (jj == 0) { v[0] = v[0] * ALPHA + g0 * a0; v[1] = v[1] * ALPHA + g1 * a1; }
            else if (jj == 2) { v[2] = v[2] * ALPHA + g0 * a0; v[3] = v[3] * ALPHA + g1 * a1; }
            else if (jj == 4) { v[4] = v[4] * ALPHA + g0 * a0; v[5] = v[5] * ALPHA + g1 * a1; }
            else { v[6] = v[6] * ALPHA + g0 * a0; v[7] = v[7] * ALPHA + g1 * a1; }
        }
    }
    if (DO_LN) {
        float s = 0.f;
#pragma unroll
        for (int j = 0; j < 8; ++j) s += (v[j][0] + v[j][1]) + (v[j][2] + v[j][3]);
        const float mean = wave_sum(s) * (1.f / DM); float s2 = 0.f;
#pragma unroll
        for (int j = 0; j < 8; ++j) { v[j] = v[j] - mean; s2 += (v[j][0] * v[j][0] + v[j][1] * v[j][1]) + (v[j][2] * v[j][2] + v[j][3] * v[j][3]); }
        const float rstd = 1.f / sqrtf(wave_sum(s2) * (1.f / DM) + LN_EPS);
#pragma unroll
        for (int j = 0; j < 8; ++j) { const f32x4 gg = *(const f32x4*)(g + lo + j * 256), bb = *(const f32x4*)(b + lo + j * 256); v[j] = v[j] * rstd * gg + bb; }
    }
    if (dstrow) {
#pragma unroll
        for (int j = 0; j < 8; ++j) *(f32x4*)(dstrow + lo + j * 256) = v[j];
    }
    if (modrow) {
#pragma unroll
        for (int j = 0; j < 8; ++j) { const f32x4 sh = *(const f32x4*)(shift + lo + j * 256), sc = *(const f32x4*)(scale + lo + j * 256);
            const f32x4 o = v[j] * (sc + 1.f) + sh; v2u w; w.x = pk2(o[0], o[1]); w.y = pk2(o[2], o[3]);
            *(v2u*)(modrow + lo + j * 256) = w; }
    }
}
__device__ __forceinline__ void phase_pro_c(Frame& F) {
    const int gw = F.bid * NWAVES + F.wave, NGW = F.G * NWAVES;
    for (int row = gw; row < MT; row += NGW) {
        const float* src = row < ML ? F.a->in[I_X] + (size_t)row * DM : F.a->in[I_CTX] + (size_t)(row - ML) * DM;
        const int v = row_var(row);
        row_pass<false>(F, src, nullptr, nullptr, WSP(float, WS_H) + (size_t)row * DM, WSP(bf16, WS_HMOD) + (size_t)row * DM, mvec(F, 0, v, 0), mvec(F, 0, v, 1));
    }
}
__device__ __forceinline__ void phase_ln(Frame& F, const float* g, const float* b, int ml, int js, bool final_out, int nrows, int nslab, const float* gate_ctx) {
    const int gw = F.bid * NWAVES + F.wave, NGW = F.G * NWAVES;
    for (int row = gw; row < nrows; row += NGW) {
        const int v = row_var(row);
        float* hrow = WSP(float, WS_H) + (size_t)row * DM;
        if (final_out) row_pass<true>(F, hrow, g, b, F.a->out + (size_t)row * DM, nullptr, nullptr, nullptr);
        else if (row < ML) row_pass<true>(F, hrow, g, b, hrow, WSP(bf16, WS_HMOD) + (size_t)row * DM, mvec(F, ml, v, js), mvec(F, ml, v, js + 1));
        else row_pass<true>(F, hrow, g, b, hrow, WSP(bf16, WS_HMOD) + (size_t)row * DM, mvec(F, ml, v, js), mvec(F, ml, v, js + 1), WSP(float, WS_SLAB) + (size_t)(row - ML) * DM, nslab, gate_ctx);
    }
}

__device__ __forceinline__ void s5_oracle_job(Frame& F, int l, int b, int g) {
    LAS float* hb = (LAS float*)(F.lds);
    LAS float* cs = (LAS float*)(F.lds + 8192);
    const int p = F.lane;
    const bf16* P = WSP(bf16, WS_P);
    float* Y5 = WSP(float, WS_Y5); bf16* Z = WSP(bf16, WS_Z);
    for (int dir = 0; dir < 2; ++dir) {
        const int gi = (l * 2 + dir) * 32 + g;
        const float ar = F.a->in[I_S5ARE][gi * 64 + p], ai = F.a->in[I_S5AIM][gi * 64 + p];
        const float step = expf(F.a->in[I_S5LS][gi]);
        const float e = expf(ar * step); float sn, cn; sincosf(ai * step, &sn, &cn);
        const float abr = e * cn, abi = e * sn;
        const float den = ar * ar + ai * ai;
        const float qr = ((abr - 1.f) * ar + abi * ai) / den, qi = (abi * ar - (abr - 1.f) * ai) / den;
        float bbr[16], bbi[16];
#pragma unroll
        for (int h = 0; h < 16; ++h) { const float br = F.a->in[I_S5BRE][(size_t)(gi * 64 + p) * 16 + h], bi = F.a->in[I_S5BIM][(size_t)(gi * 64 + p) * 16 + h];
            bbr[h] = qr * br - qi * bi; bbi[h] = qr * bi + qi * br; }
        asm volatile("s_waitcnt lgkmcnt(0)" ::: "memory");
#pragma unroll
        for (int ho = 0; ho < 16; ++ho) { cs[(ho * 64 + p) * 2] = F.a->in[I_S5CRE][(size_t)(gi * 16 + ho) * 64 + p]; cs[(ho * 64 + p) * 2 + 1] = F.a->in[I_S5CIM][(size_t)(gi * 16 + ho) * 64 + p]; }
        float hr = 0.f, hi = 0.f;
        for (int blk = 0; blk < (CTXL + SEQL) / 16; ++blk) {
            for (int i = 0; i < 16; ++i) {
                const int row = proc_row(blk * 16 + i, dir, b);
                const v4u u0 = *(const v4u*)(P + (size_t)row * NIN + PC_S5 + g * 16), u1 = *(const v4u*)(P + (size_t)row * NIN + PC_S5 + g * 16 + 8);
                float u[16];
                u[0] = bflo(u0.x); u[1] = bfhi(u0.x); u[2] = bflo(u0.y); u[3] = bfhi(u0.y); u[4] = bflo(u0.z); u[5] = bfhi(u0.z); u[6] = bflo(u0.w); u[7] = bfhi(u0.w);
                u[8] = bflo(u1.x); u[9] = bfhi(u1.x); u[10] = bflo(u1.y); u[11] = bfhi(u1.y); u[12] = bflo(u1.z); u[13] = bfhi(u1.z); u[14] = bflo(u1.w); u[15] = bfhi(u1.w);
                float bur = 0.f, bui = 0.f;
#pragma unroll
                for (int h = 0; h < 16; ++h) { bur += bbr[h] * u[h]; bui += bbi[h] * u[h]; }
                const float nr = abr * hr - abi * hi + bur, ni = abr * hi + abi * hr + bui;
                hr = nr; hi = ni;
                hb[(i * 64 + p) * 2] = hr; hb[(i * 64 + p) * 2 + 1] = hi;
            }
            asm volatile("s_waitcnt lgkmcnt(0)" ::: "memory");
            {
                const int i = F.lane >> 2, ho4 = (F.lane & 3) * 4;
                float y[4] = {0.f, 0.f, 0.f, 0.f};
                for (int pp = 0; pp < 64; ++pp) { const float xr = hb[(i * 64 + pp) * 2], xi = hb[(i * 64 + pp) * 2 + 1];
#pragma unroll
                    for (int j = 0; j < 4; ++j) y[j] += xr * cs[((ho4 + j) * 64 + pp) * 2] - xi * cs[((ho4 + j) * 64 + pp) * 2 + 1]; }
                const int row = proc_row(blk * 16 + i, dir, b);
                float* yp = Y5 + (size_t)row * GW + g * 16 + ho4;
                if (dir == 0) { *(f32x4*)yp = (f32x4){y[0], y[1], y[2], y[3]}; }
                else {
                    const f32x4 yf = *(const f32x4*)yp;
                    const v2u uu = *(const v2u*)(P + (size_t)row * NIN + PC_S5 + g * 16 + ho4);
                    const float* dd = F.a->in[I_S5D] + l * GW + g * 16 + ho4;
                    const float z0 = gelu_tanh(yf[0] + y[0] + dd[0] * bflo(uu.x)), z1 = gelu_tanh(yf[1] + y[1] + dd[1] * bfhi(uu.x));
                    const float z2 = gelu_tanh(yf[2] + y[2] + dd[2] * bflo(uu.y)), z3 = gelu_tanh(yf[3] + y[3] + dd[3] * bfhi(uu.y));
                    v2u w; w.x = pk2(z0, z1); w.y = pk2(z2, z3);
                    *(v2u*)(Z + (size_t)row * GW + g * 16 + ho4) = w;
                }
            }
            asm volatile("s_waitcnt vmcnt(0) lgkmcnt(0)" ::: "memory");
        }
        asm volatile("s_waitcnt vmcnt(0) lgkmcnt(0)" ::: "memory");
    }
}

typedef short bf16x8v __attribute__((ext_vector_type(8)));
__device__ __forceinline__ size_t s5_gi(int l, int dir, int g) { return (size_t)((l * 2 + dir) * 32 + g); }
__device__ __forceinline__ void s5_tables_job(Frame& F, int l, int dir, int g) {
    LAS float* pw = (LAS float*)(F.lds);
    LAS float* bb = (LAS float*)(F.lds + 33 * 64 * 8);
    LAS float* cc = (LAS float*)(F.lds + 33 * 64 * 8 + 8192);
    const size_t gi = s5_gi(l, dir, g);
    __syncthreads();
    if (F.tid < 64) {
        const int p = F.tid;
        const float ar = F.a->in[I_S5ARE][gi * 64 + p], ai = F.a->in[I_S5AIM][gi * 64 + p];
        const float step = expf(F.a->in[I_S5LS][gi]);
        for (int n = 0; n <= S5Q; ++n) { const float e = expf(ar * step * (float)n); float sn, cn; sincosf(ai * step * (float)n, &sn, &cn); pw[(n * 64 + p) * 2] = e * cn; pw[(n * 64 + p) * 2 + 1] = e * sn; }
        const float e = expf(ar * step); float sn, cn; sincosf(ai * step, &sn, &cn);
        const float abr = e * cn, abi = e * sn, den = ar * ar + ai * ai;
        const float qr = ((abr - 1.f) * ar + abi * ai) / den, qi = (abi * ar - (abr - 1.f) * ai) / den;
        for (int h = 0; h < 16; ++h) { const float br = F.a->in[I_S5BRE][(gi * 64 + p) * 16 + h], bi = F.a->in[I_S5BIM][(gi * 64 + p) * 16 + h];
            bb[(p * 16 + h) * 2] = qr * br - qi * bi; bb[(p * 16 + h) * 2 + 1] = qr * bi + qi * br; }
        for (int ho = 0; ho < 16; ++ho) { cc[(ho * 64 + p) * 2] = F.a->in[I_S5CRE][(gi * 16 + ho) * 64 + p]; cc[(ho * 64 + p) * 2 + 1] = F.a->in[I_S5CIM][(gi * 16 + ho) * 64 + p]; }
        float* aq = WSP(float, WS_S5AQ) + (gi * 64 + p) * 2;
        const float eq = expf(ar * step * (float)S5Q); float snq, cnq; sincosf(ai * step * (float)S5Q, &snq, &cnq);
        aq[0] = eq * cnq; aq[1] = eq * snq;
    }
    __syncthreads();
    bf16* KT = WSP(bf16, WS_S5KT) + gi * 33 * 256;
    for (int e = F.tid; e < 33 * 256; e += NTHREADS) {
        const int tau = e / 256 - 1, ho = (e >> 4) & 15, hi = e & 15;
        float v = 0.f;
        if (tau >= 0) {
            for (int p = 0; p < 64; ++p) {
                const float cr = cc[(ho * 64 + p) * 2], ci = cc[(ho * 64 + p) * 2 + 1], pr = pw[(tau * 64 + p) * 2], pi = pw[(tau * 64 + p) * 2 + 1];
                const float xr = cr * pr - ci * pi, xi = cr * pi + ci * pr;
                v += xr * bb[(p * 16 + hi) * 2] - xi * bb[(p * 16 + hi) * 2 + 1];
            }
            if (dir == 0 && tau == 0 && ho == hi) v += F.a->in[I_S5D][l * GW + g * 16 + ho];
        }
        KT[e] = (bf16)f2bf(v);
    }
    bf16* WSt = WSP(bf16, WS_S5WS) + gi * 128 * 512;
    for (int e = F.tid; e < 128 * 512; e += NTHREADS) {
        const int p2 = e >> 9, sh = e & 511, sidx = sh >> 4, hi = sh & 15, p = p2 & 63;
        const int n = dir ? sidx : (S5Q - 1 - sidx);
        const float pr = pw[(n * 64 + p) * 2], pi = pw[(n * 64 + p) * 2 + 1], br = bb[(p * 16 + hi) * 2], bi = bb[(p * 16 + hi) * 2 + 1];
        const float v = (p2 < 64) ? (pr * br - pi * bi) : (pr * bi + pi * br);
        WSt[e] = (bf16)f2bf(v);
    }
    bf16* WCt = WSP(bf16, WS_S5WC) + gi * 512 * 128;
    for (int e = F.tid; e < 512 * 128; e += NTHREADS) {
        const int th = e >> 7, p2 = e & 127, t = th >> 4, ho = th & 15, p = p2 & 63;
        const int n = dir ? (S5Q - t) : (t + 1);
        const float pr = pw[(n * 64 + p) * 2], pi = pw[(n * 64 + p) * 2 + 1], cr = cc[(ho * 64 + p) * 2], ci = cc[(ho * 64 + p) * 2 + 1];
        const float v = (p2 < 64) ? (cr * pr - ci * pi) : -(cr * pi + ci * pr);
        WCt[e] = (bf16)f2bf(v);
    }
    __syncthreads();
}
__device__ __forceinline__ void s5_state_job(Frame& F, int l, int g, int cs) {
    const int col = F.lane & 15, kq = F.lane >> 4, mq = F.wave & 3, dir = F.wave >> 2;
    const int ch = cs * 16 + col; const size_t row0 = (size_t)ch * S5Q;
    const bf16* P = WSP(bf16, WS_P);
    bf16x8v U[16];
#pragma unroll
    for (int ks = 0; ks < 16; ++ks) U[ks] = *(const bf16x8v*)(P + (row0 + 2 * ks + (kq >> 1)) * NIN + PC_S5 + g * 16 + 8 * (kq & 1));
    const bf16* WSt = WSP(bf16, WS_S5WS) + s5_gi(l, dir, g) * 128 * 512;
    float* S = WSP(float, WS_S5S);
#pragma unroll
    for (int mt = 0; mt < 2; ++mt) {
        const int mtile = mq * 2 + mt;
        f32x4 acc = {0.f, 0.f, 0.f, 0.f};
        const bf16* ap = WSt + (size_t)(mtile * 16 + col) * 512 + kq * 8;
#pragma unroll
        for (int ks = 0; ks < 16; ++ks) { const bf16x8v A = *(const bf16x8v*)(ap + ks * 32); acc = __builtin_amdgcn_mfma_f32_16x16x32_bf16(A, U[ks], acc, 0, 0, 0); }
        *(f32x4*)(S + (((size_t)ch * 2 + dir) * 32 + g) * 128 + mtile * 16 + 4 * kq) = acc;
    }
}
__device__ __forceinline__ void s5_scan(Frame& F, int l, int idx) {
    const int p = idx & 63, g = (idx >> 6) & 31, dir = (idx >> 11) & 1, b = idx >> 12;
    const float* aq = WSP(float, WS_S5AQ) + (s5_gi(l, dir, g) * 64 + p) * 2;
    const float qr = aq[0], qi = aq[1];
    const float* S = WSP(float, WS_S5S); bf16* HIN = WSP(bf16, WS_S5HIN);
    float hr = 0.f, hi = 0.f;
    constexpr int NC = CTXL / S5Q, NL = SEQL / S5Q;
#pragma unroll 8
    for (int st = 0; st < NC + NL; ++st) {
        int ch;
        if (st < NC) ch = 256 + b * NC + (dir ? NC - 1 - st : st); else ch = b * NL + (dir ? NL - 1 - (st - NC) : (st - NC));
        const size_t o = (((size_t)ch * 2 + dir) * 32 + g) * 128 + p;
        const float sr = S[o], si = S[o + 64];
        HIN[o] = (bf16)f2bf(hr); HIN[o + 64] = (bf16)f2bf(hi);
        const float nr = qr * hr - qi * hi + sr, ni = qr * hi + qi * hr + si;
        hr = nr; hi = ni;
    }
}
__device__ __forceinline__ void s5_out_job(Frame& F, int l, int g, int cs) {
    const int col = F.lane & 15, kq = F.lane >> 4;
    const int ch = cs * 16 + col; const size_t row0 = (size_t)ch * S5Q;
    const bf16* P = WSP(bf16, WS_P);
    LAS bf16* KTl = (LAS bf16*)(F.lds);
    __syncthreads();
    {
        const v4u* src0 = (const v4u*)(WSP(bf16, WS_S5KT) + s5_gi(l, 0, g) * 33 * 256);
        const v4u* src1 = (const v4u*)(WSP(bf16, WS_S5KT) + s5_gi(l, 1, g) * 33 * 256);
        for (int e = F.tid; e < 33 * 32; e += NTHREADS) { ((LAS v4u*)KTl)[e] = src0[e]; ((LAS v4u*)KTl)[33 * 32 + e] = src1[e]; }
    }
    bf16x8v U[16], Hf[4], Hb[4];
#pragma unroll
    for (int ks = 0; ks < 16; ++ks) U[ks] = *(const bf16x8v*)(P + (row0 + 2 * ks + (kq >> 1)) * NIN + PC_S5 + g * 16 + 8 * (kq & 1));
    const bf16* HIN = WSP(bf16, WS_S5HIN);
#pragma unroll
    for (int k4 = 0; k4 < 4; ++k4) { Hf[k4] = *(const bf16x8v*)(HIN + (((size_t)ch * 2 + 0) * 32 + g) * 128 + k4 * 32 + kq * 8); Hb[k4] = *(const bf16x8v*)(HIN + (((size_t)ch * 2 + 1) * 32 + g) * 128 + k4 * 32 + kq * 8); }
    const LAS bf16* KTf = KTl + col * 16 + 8 * (kq & 1);
    const LAS bf16* KTb = KTl + 33 * 256 + col * 16 + 8 * (kq & 1);
    const bf16* WCf = WSP(bf16, WS_S5WC) + s5_gi(l, 0, g) * 512 * 128 + (size_t)col * 128 + kq * 8;
    const bf16* WCb = WSP(bf16, WS_S5WC) + s5_gi(l, 1, g) * 512 * 128 + (size_t)col * 128 + kq * 8;
    bf16* Z = WSP(bf16, WS_Z);
    __syncthreads();
#pragma unroll 1
    for (int tt = 0; tt < 4; ++tt) {
        const int t = F.wave * 4 + tt;
        f32x4 acc = {0.f, 0.f, 0.f, 0.f};
        bf16x8v Wf[4], Wb[4];
#pragma unroll
        for (int k4 = 0; k4 < 4; ++k4) { Wf[k4] = *(const bf16x8v*)(WCf + (size_t)t * 16 * 128 + k4 * 32); Wb[k4] = *(const bf16x8v*)(WCb + (size_t)t * 16 * 128 + k4 * 32); }
#pragma unroll
        for (int ks = 0; ks < 16; ++ks) {
            const int sidx = 2 * ks + (kq >> 1);
            if (2 * ks <= t) { int tau = t - sidx; tau = tau < 0 ? -1 : tau; const bf16x8v A = *(const LAS bf16x8v*)(KTf + (tau + 1) * 256); acc = __builtin_amdgcn_mfma_f32_16x16x32_bf16(A, U[ks], acc, 0, 0, 0); }
            if (2 * ks + 1 >= t) { int tau = sidx - t; tau = tau < 0 ? -1 : tau; const bf16x8v A = *(const LAS bf16x8v*)(KTb + (tau + 1) * 256); acc = __builtin_amdgcn_mfma_f32_16x16x32_bf16(A, U[ks], acc, 0, 0, 0); }
        }
#pragma unroll
        for (int k4 = 0; k4 < 4; ++k4) { acc = __builtin_amdgcn_mfma_f32_16x16x32_bf16(Wf[k4], Hf[k4], acc, 0, 0, 0); acc = __builtin_amdgcn_mfma_f32_16x16x32_bf16(Wb[k4], Hb[k4], acc, 0, 0, 0); }
        v2u w; w.x = pk2(gelu_tanh(acc[0]), gelu_tanh(acc[1])); w.y = pk2(gelu_tanh(acc[2]), gelu_tanh(acc[3]));
        *(v2u*)(Z + (row0 + t) * GW + g * 16 + 4 * kq) = w;
    }
}
constexpr int SPITCH = 136;
constexpr int L_XT = 0, L_B = 256 * SPITCH * 2, L_C = L_B + 128 * SPITCH * 2, L_DTV = L_C + 128 * SPITCH * 2, L_CUM = L_DTV + 4096, L_E = L_CUM + 4096;
static_assert(L_E + 64 <= LDS_BYTES, "SSD LDS map");

template <bool TR>
__device__ __forceinline__ void ssd_stage(Frame& F, int l, int cj, int xch0, int nch, LAS bf16* dst) {
    const bf16* P = WSP(bf16, WS_P);
    const int r0 = cj * 128; int base, t0, len; row_seq(r0, base, t0, len);
    const int ncv = nch >> 3;
    const float* cw = F.a->in[I_M2CW] + (size_t)l * 4 * 1024 + xch0; const float* cb = F.a->in[I_M2CB] + l * 1024 + xch0;
    for (int item = F.tid; item < ncv * 16; item += NTHREADS) {
        const int cv = item % ncv, ts = item / ncv, c8 = cv * 8, tq = ts * 8;
        float w[4][8], bsv[8];
#pragma unroll
        for (int k = 0; k < 4; ++k) { const f32x4 a = *(const f32x4*)(cw + k * 1024 + c8), b = *(const f32x4*)(cw + k * 1024 + c8 + 4);
            w[k][0] = a[0]; w[k][1] = a[1]; w[k][2] = a[2]; w[k][3] = a[3]; w[k][4] = b[0]; w[k][5] = b[1]; w[k][6] = b[2]; w[k][7] = b[3]; }
        { const f32x4 a = *(const f32x4*)(cb + c8), b = *(const f32x4*)(cb + c8 + 4); bsv[0] = a[0]; bsv[1] = a[1]; bsv[2] = a[2]; bsv[3] = a[3]; bsv[4] = b[0]; bsv[5] = b[1]; bsv[6] = b[2]; bsv[7] = b[3]; }
        v4u raw[11];
#pragma unroll
        for (int i = 0; i < 11; ++i) { const int t = t0 + tq - 2 + i;
            raw[i] = (t >= 0 && t < len) ? *(const v4u*)(P + (size_t)(base + t) * NIN + PC_XBC + xch0 + c8) : (v4u){0u, 0u, 0u, 0u}; }
        unsigned pk[8][4];
#pragma unroll
        for (int i = 0; i < 8; ++i) {
            float o[8];
#pragma unroll
            for (int e = 0; e < 8; ++e) o[e] = bsv[e];
#pragma unroll
            for (int k = 0; k < 4; ++k) { const v4u r = raw[i + k];
                o[0] += w[k][0] * bflo(r.x); o[1] += w[k][1] * bfhi(r.x); o[2] += w[k][2] * bflo(r.y); o[3] += w[k][3] * bfhi(r.y);
                o[4] += w[k][4] * bflo(r.z); o[5] += w[k][5] * bfhi(r.z); o[6] += w[k][6] * bflo(r.w); o[7] += w[k][7] * bfhi(r.w); }
#pragma unroll
            for (int e = 0; e < 8; ++e) o[e] = siluf_(o[e]);
            if (TR) {
#pragma unroll
                for (int e = 0; e < 8; ++e) { const unsigned hb = f2bf(o[e]); if (i & 1) pk[e][i >> 1] |= hb << 16; else pk[e][i >> 1] = hb; }
            } else {
                v4u q; q.x = pk2(o[0], o[1]); q.y = pk2(o[2], o[3]); q.z = pk2(o[4], o[5]); q.w = pk2(o[6], o[7]);
                *(LAS v4u*)(dst + (tq + i) * SPITCH + c8) = q;
            }
        }
        if (TR) {
#pragma unroll
            for (int e = 0; e < 8; ++e) { v4u q; q.x = pk[e][0]; q.y = pk[e][1]; q.z = pk[e][2]; q.w = pk[e][3]; *(LAS v4u*)(dst + (c8 + e) * SPITCH + tq) = q; }
        }
    }
}
__device__ __forceinline__ void ssd_dt_cum(Frame& F, int l, int cj, int gi) {
    LAS float* dtv = (LAS float*)(F.lds + L_DTV); LAS float* cum = (LAS float*)(F.lds + L_CUM); LAS float* Ea = (LAS float*)(F.lds + L_E);
    const int hd = F.wave, dir = hd >> 2, h = gi * 4 + (hd & 3);
    const float* DT = WSP(float, WS_DT);
    const float bias = F.a->in[I_M2DTB][l * 16 + dir * 8 + h];
    const float a = -expf(F.a->in[I_M2ALOG][l * 16 + dir * 8 + h]);
    const int q0 = 2 * F.lane;
    const float dt0 = softplusf_(DT[(size_t)(cj * 128 + q0) * 16 + dir * 8 + h] + bias), dt1 = softplusf_(DT[(size_t)(cj * 128 + q0 + 1) * 16 + dir * 8 + h] + bias);
    const float da0 = dt0 * a, da1 = dt1 * a;
    float ps = da0 + da1;
#pragma unroll
    for (int o = 1; o < 64; o <<= 1) { const float t = __shfl_up(ps, o); if (F.lane >= o) ps += t; }
    const float tot = __shfl(ps, 63);
    float c0, c1;
    if (dir == 0) { c0 = ps - da1; c1 = ps; } else { c0 = tot - (ps - da0 - da1); c1 = tot - (ps - da1); }
    dtv[hd * 128 + q0] = dt0; dtv[hd * 128 + q0 + 1] = dt1; cum[hd * 128 + q0] = c0; cum[hd * 128 + q0 + 1] = c1;
    if (F.lane == 0) Ea[hd] = tot;
}
__device__ __forceinline__ void unpack8(const bf16x8v v, float (&o)[8]) {
    const v4u u = __builtin_bit_cast(v4u, v);
    o[0] = bflo(u.x); o[1] = bfhi(u.x); o[2] = bflo(u.y); o[3] = bfhi(u.y); o[4] = bflo(u.z); o[5] = bfhi(u.z); o[6] = bflo(u.w); o[7] = bfhi(u.w);
}
__device__ __forceinline__ bf16x8v pack8(const float (&o)[8]) {
    v4u u; u.x = pk2(o[0], o[1]); u.y = pk2(o[2], o[3]); u.z = pk2(o[4], o[5]); u.w = pk2(o[6], o[7]);
    return __builtin_bit_cast(bf16x8v, u);
}
__device__ __forceinline__ void ssd_state_job(Frame& F, int l, int cj, int gi) {
    LAS bf16* XT = (LAS bf16*)(F.lds + L_XT); LAS bf16* BT = (LAS bf16*)(F.lds + L_B);
    LAS float* dtv = (LAS float*)(F.lds + L_DTV); LAS float* cum = (LAS float*)(F.lds + L_CUM); LAS float* Ea = (LAS float*)(F.lds + L_E);
    __syncthreads();
    ssd_stage<true>(F, l, cj, gi * 256, 256, XT);
    ssd_stage<true>(F, l, cj, 512 + gi * 128, 128, BT);
    ssd_dt_cum(F, l, cj, gi);
    __syncthreads();
    const int fr = F.lane & 15, kq = F.lane >> 4, nt = F.wave;
    bf16x8v BTf[4];
#pragma unroll
    for (int ks = 0; ks < 4; ++ks) BTf[ks] = *(const LAS bf16x8v*)(BT + (16 * nt + fr) * SPITCH + ks * 32 + kq * 8);
    float* SST = WSP(float, WS_SST); float* DEC = WSP(float, WS_SDEC);
#pragma unroll 1
    for (int hd = 0; hd < 8; ++hd) {
        const int hl = hd & 3; const float E = Ea[hd];
        float wq[4][8];
#pragma unroll
        for (int ks = 0; ks < 4; ++ks)
#pragma unroll
            for (int e = 0; e < 8; ++e) { const int q = ks * 32 + kq * 8 + e; wq[ks][e] = dtv[hd * 128 + q] * __expf(E - cum[hd * 128 + q]); }
#pragma unroll
        for (int pt = 0; pt < 4; ++pt) {
            f32x4 acc = {0.f, 0.f, 0.f, 0.f};
#pragma unroll
            for (int ks = 0; ks < 4; ++ks) {
                const bf16x8v raw = *(const LAS bf16x8v*)(XT + (hl * 64 + pt * 16 + fr) * SPITCH + ks * 32 + kq * 8);
                float xv[8]; unpack8(raw, xv);
#pragma unroll
                for (int e = 0; e < 8; ++e) xv[e] *= wq[ks][e];
                acc = __builtin_amdgcn_mfma_f32_16x16x32_bf16(BTf[ks], pack8(xv), acc, 0, 0, 0);
            }
            *(f32x4*)(SST + ((size_t)((cj * 2 + gi) * 8 + hd) * 64 + pt * 16 + fr) * 128 + 16 * nt + 4 * kq) = acc;
        }
        if (F.tid == 0) DEC[(cj * 2 + gi) * 8 + hd] = __expf(E);
    }
}
__device__ __forceinline__ void ssd_scan(Frame& F, int idx) {
    const int n4 = idx & 31, p = (idx >> 5) & 63, hdg = (idx >> 11) & 15, b = idx >> 15;
    const int dir = (hdg >> 2) & 1;
    const float* SST = WSP(float, WS_SST); const float* DEC = WSP(float, WS_SDEC); bf16* HIN = WSP(bf16, WS_SHIN);
    f32x4 h = {0.f, 0.f, 0.f, 0.f};
#pragma unroll 2
    for (int st = 0; st < 34; ++st) {
        const int cj = st < 2 ? 64 + b * 2 + (dir ? 1 - st : st) : b * 32 + (dir ? 31 - (st - 2) : st - 2);
        const size_t o = ((size_t)(cj * 16 + hdg) * 64 + p) * 128 + n4 * 4;
        const f32x4 sv = *(const f32x4*)(SST + o); const float d = DEC[cj * 16 + hdg];
        v2u w; w.x = pk2(h[0], h[1]); w.y = pk2(h[2], h[3]);
        *(v2u*)(HIN + o) = w;
        h = h * d + sv;
    }
}
__device__ __forceinline__ void ssd_y_job(Frame& F, int l, int cj, int gi) {
    LAS bf16* XT = (LAS bf16*)(F.lds + L_XT); LAS bf16* BM = (LAS bf16*)(F.lds + L_B); LAS bf16* CM = (LAS bf16*)(F.lds + L_C);
    LAS float* dtv = (LAS float*)(F.lds + L_DTV); LAS float* cum = (LAS float*)(F.lds + L_CUM);
    __syncthreads();
    ssd_stage<true>(F, l, cj, gi * 256, 256, XT);
    ssd_stage<false>(F, l, cj, 512 + gi * 128, 128, BM);
    ssd_stage<false>(F, l, cj, 768 + gi * 128, 128, CM);
    ssd_dt_cum(F, l, cj, gi);
    __syncthreads();
    const int fr = F.lane & 15, kq = F.lane >> 4, w = F.wave, i = 16 * w + fr;
    bf16x8v Cf[4];
#pragma unroll
    for (int ks = 0; ks < 4; ++ks) Cf[ks] = *(const LAS bf16x8v*)(CM + i * SPITCH + ks * 32 + kq * 8);
    f32x4 GT[8];
#pragma unroll
    for (int jt = 0; jt < 8; ++jt) { f32x4 a = {0.f, 0.f, 0.f, 0.f};
#pragma unroll
        for (int ks = 0; ks < 4; ++ks) { const bf16x8v A = *(const LAS bf16x8v*)(BM + (16 * jt + fr) * SPITCH + ks * 32 + kq * 8); a = __builtin_amdgcn_mfma_f32_16x16x32_bf16(A, Cf[ks], a, 0, 0, 0); }
        GT[jt] = a; }
    const bf16* P = WSP(bf16, WS_P); const bf16* HIN = WSP(bf16, WS_SHIN);
    const size_t row = (size_t)cj * 128 + i;
    f32x4 gq[4][4]; float ss = 0.f;
#pragma unroll
    for (int hl = 0; hl < 4; ++hl) {
        f32x4 accY[4];
#pragma unroll
        for (int pt = 0; pt < 4; ++pt) accY[pt] = (f32x4){0.f, 0.f, 0.f, 0.f};
        const float dh = F.a->in[I_M2D][l * 8 + gi * 4 + hl];
#pragma unroll 1
        for (int dir = 0; dir < 2; ++dir) {
            const int hd = dir * 4 + hl;
            int io = i; asm volatile("" : "+v"(io));
            const float ci = cum[hd * 128 + i];
#pragma unroll
            for (int kk = 0; kk < 4; ++kk) {
                const bool rel = dir == 0 ? (32 * kk <= 16 * w + 15) : (32 * kk + 31 >= 16 * w);
                if (rel) {
                    float sv[8];
#pragma unroll
                    for (int e = 0; e < 8; ++e) {
                        const int j = 32 * kk + 16 * (e >> 2) + 4 * kq + (e & 3);
                        const float g = GT[2 * kk + (e >> 2)][e & 3];
                        const bool valid = dir == 0 ? (j <= io) : (j >= io);
                        float v = valid ? g * __expf(ci - cum[hd * 128 + j]) * dtv[hd * 128 + j] : 0.f;
                        if (dir == 0 && j == io) v += dh;
                        sv[e] = v;
                    }
                    const bf16x8v Bf = pack8(sv);
#pragma unroll
                    for (int pt = 0; pt < 4; ++pt) {
                        const LAS bf16* xp = XT + (hl * 64 + pt * 16 + fr) * SPITCH + 32 * kk + 4 * kq;
                        const v2u a0 = *(const LAS v2u*)(xp), a1 = *(const LAS v2u*)(xp + 16);
                        v4u au; au.x = a0.x; au.y = a0.y; au.z = a1.x; au.w = a1.y;
                        accY[pt] = __builtin_amdgcn_mfma_f32_16x16x32_bf16(__builtin_bit_cast(bf16x8v, au), Bf, accY[pt], 0, 0, 0);
                    }
                }
            }
            const float ei = __expf(ci);
            const bf16* hp = HIN + ((size_t)((cj * 2 + gi) * 8 + hd) * 64 + fr) * 128 + kq * 8;
#pragma unroll
            for (int pt = 0; pt < 4; ++pt) {
                f32x4 tmp = {0.f, 0.f, 0.f, 0.f};
#pragma unroll
                for (int ks = 0; ks < 4; ++ks) { const bf16x8v A = *(const bf16x8v*)(hp + (size_t)(pt * 16) * 128 + ks * 32); tmp = __builtin_amdgcn_mfma_f32_16x16x32_bf16(A, Cf[ks], tmp, 0, 0, 0); }
                accY[pt] += tmp * ei;
            }
        }
#pragma unroll
        for (int pt = 0; pt < 4; ++pt) {
            const v2u zz = *(const v2u*)(P + row * NIN + PC_Z + gi * 256 + hl * 64 + pt * 16 + 4 * kq);
            f32x4 gv; gv[0] = accY[pt][0] * siluf_(bflo(zz.x)); gv[1] = accY[pt][1] * siluf_(bfhi(zz.x)); gv[2] = accY[pt][2] * siluf_(bflo(zz.y)); gv[3] = accY[pt][3] * siluf_(bfhi(zz.y));
            ss += (gv[0] * gv[0] + gv[1] * gv[1]) + (gv[2] * gv[2] + gv[3] * gv[3]);
            gq[hl][pt] = gv;
        }
    }
    ss += __shfl_xor(ss, 16); ss += __shfl_xor(ss, 32);
    const float rs = 1.f / sqrtf(ss * (1.f / 256.f) + RMS_EPS);
    bf16* MIX = WSP(bf16, WS_MIX);
#pragma unroll
    for (int hl = 0; hl < 4; ++hl)
#pragma unroll
        for (int pt = 0; pt < 4; ++pt) {
            const int ch = gi * 256 + hl * 64 + pt * 16 + 4 * kq;
            const f32x4 nw = *(const f32x4*)(F.a->in[I_M2NW] + l * GW + ch);
            const f32x4 o = gq[hl][pt] * rs * nw;
            v2u wv; wv.x = pk2(o[0], o[1]); wv.y = pk2(o[2], o[3]);
            *(v2u*)(MIX + row * DM + MX_SSD + ch) = wv;
        }
}

__device__ __forceinline__ void sg_job(Frame& F, int l, int cj, int hh) {
    LAS bf16* VT = (LAS bf16*)(F.lds);
    const bf16* P = WSP(bf16, WS_P); bf16* MIX = WSP(bf16, WS_MIX);
    const int r0 = cj * 128;
    __syncthreads();
    {
        const int d = F.lane * 2;
        const float g0 = F.a->in[I_SGLNG][l * GW + hh * 128 + d], g1 = F.a->in[I_SGLNG][l * GW + hh * 128 + d + 1];
        const float b0 = F.a->in[I_SGLNB][l * GW + hh * 128 + d], b1 = F.a->in[I_SGLNB][l * GW + hh * 128 + d + 1];
#pragma unroll 4
        for (int jj = 0; jj < 16; ++jj) {
            const int j = F.wave * 16 + jj;
            const unsigned w = *(const unsigned*)(P + (size_t)(r0 + j) * NIN + PC_SGV + hh * 128 + d);
            const float a0 = gelu_tanh(bflo(w)), a1 = gelu_tanh(bfhi(w));
            const float mean = wave_sum(a0 + a1) * (1.f / 128.f);
            const float d0 = a0 - mean, d1 = a1 - mean;
            const float rstd = 1.f / sqrtf(wave_sum(d0 * d0 + d1 * d1) * (1.f / 128.f) + LN_EPS);
            VT[d * SPITCH + j] = (bf16)f2bf(d0 * rstd * g0 + b0);
            VT[(d + 1) * SPITCH + j] = (bf16)f2bf(d1 * rstd * g1 + b1);
        }
    }
    __syncthreads();
    const int fr = F.lane & 15, kq = F.lane >> 4, i = 16 * F.wave + fr;
    const bf16* Wb = WSP(bf16, WS_SGWB) + (size_t)(l * 4 + hh) * 128 * 128 + (size_t)i * 128 + kq * 8;
    bf16x8v Wf[4];
#pragma unroll
    for (int ks = 0; ks < 4; ++ks) Wf[ks] = *(const bf16x8v*)(Wb + ks * 32);
    const float bs = F.a->in[I_SGB][(l * 4 + hh) * 128 + i];
    const size_t row = (size_t)r0 + i;
#pragma unroll
    for (int dt = 0; dt < 8; ++dt) {
        f32x4 acc = {0.f, 0.f, 0.f, 0.f};
#pragma unroll
        for (int ks = 0; ks < 4; ++ks) { const bf16x8v A = *(const LAS bf16x8v*)(VT + (16 * dt + fr) * SPITCH + ks * 32 + kq * 8); acc = __builtin_amdgcn_mfma_f32_16x16x32_bf16(A, Wf[ks], acc, 0, 0, 0); }
        const int dch = hh * 128 + 16 * dt + 4 * kq;
        const v2u uu = *(const v2u*)(P + row * NIN + PC_SGU + dch);
        v2u o; o.x = pk2(gelu_tanh(bflo(uu.x)) * (acc[0] + bs), gelu_tanh(bfhi(uu.x)) * (acc[1] + bs)); o.y = pk2(gelu_tanh(bflo(uu.y)) * (acc[2] + bs), gelu_tanh(bfhi(uu.y)) * (acc[3] + bs));
        *(v2u*)(MIX + row * DM + MX_SG + dch) = o;
    }
}
__device__ __forceinline__ void pool_job(Frame& F, int l, int cj, int gp) {
    LAS bf16* Mm = (LAS bf16*)(F.lds);
    const bf16* P = WSP(bf16, WS_P); bf16* MIX = WSP(bf16, WS_MIX);
    const int r0 = cj * 128, win = 2 << gp; int base, t0, len; row_seq(r0, base, t0, len);
    __syncthreads();
    for (int item = F.tid; item < 128 * 16; item += NTHREADS) {
        const int tk = item >> 4, c8 = (item & 15) * 8, t = t0 + tk;
        int lo = t - win / 2; if (lo < 0) lo = 0; int hi = t + win / 2 - 1; if (hi > len - 1) hi = len - 1;
        float sacc[8];
#pragma unroll
        for (int e = 0; e < 8; ++e) sacc[e] = 0.f;
        const bf16* pc = P + (size_t)base * NIN + PC_POOL + gp * 128 + c8;
        for (int k = lo; k <= hi; ++k) { const v4u r = *(const v4u*)(pc + (size_t)k * NIN);
            sacc[0] += bflo(r.x); sacc[1] += bfhi(r.x); sacc[2] += bflo(r.y); sacc[3] += bfhi(r.y); sacc[4] += bflo(r.z); sacc[5] += bfhi(r.z); sacc[6] += bflo(r.w); sacc[7] += bfhi(r.w); }
        const float inv = 1.f / (float)(hi - lo + 1);
        const v4u sf = *(const v4u*)(pc + (size_t)t * NIN);
        v4u q; q.x = pk2(sacc[0] * inv - bflo(sf.x), sacc[1] * inv - bfhi(sf.x)); q.y = pk2(sacc[2] * inv - bflo(sf.y), sacc[3] * inv - bfhi(sf.y));
        q.z = pk2(sacc[4] * inv - bflo(sf.z), sacc[5] * inv - bfhi(sf.z)); q.w = pk2(sacc[6] * inv - bflo(sf.w), sacc[7] * inv - bfhi(sf.w));
        *(LAS v4u*)(Mm + tk * SPITCH + c8) = q;
    }
    __syncthreads();
    const int fr = F.lane & 15, kq = F.lane >> 4, i = 16 * F.wave + fr;
    bf16x8v Mf[4];
#pragma unroll
    for (int ks = 0; ks < 4; ++ks) Mf[ks] = *(const LAS bf16x8v*)(Mm + i * SPITCH + ks * 32 + kq * 8);
    const bf16* Wt = WSP(bf16, WS_POOLWT) + (size_t)(l * 4 + gp) * 128 * 128 + (size_t)fr * 128 + kq * 8;
    const size_t row = (size_t)r0 + i;
#pragma unroll
    for (int dt = 0; dt < 8; ++dt) {
        f32x4 acc = {0.f, 0.f, 0.f, 0.f};
#pragma unroll
        for (int ks = 0; ks < 4; ++ks) { const bf16x8v A = *(const bf16x8v*)(Wt + (size_t)(16 * dt) * 128 + ks * 32); acc = __builtin_amdgcn_mfma_f32_16x16x32_bf16(A, Mf[ks], acc, 0, 0, 0); }
        const int dch = gp * 128 + 16 * dt + 4 * kq;
        const f32x4 pb = *(const f32x4*)(F.a->in[I_POOLB] + l * GW + dch), ps = *(const f32x4*)(F.a->in[I_POOLS] + l * GW + dch);
        const f32x4 ov = (acc + pb) * ps;
        v2u o; o.x = pk2(ov[0], ov[1]); o.y = pk2(ov[2], ov[3]);
        *(v2u*)(MIX + row * DM + MX_POOL + dch) = o;
    }
}
__device__ __forceinline__ void sgpool_tables(Frame& F) {
    const int gt = F.bid * NTHREADS + F.tid, NGT = F.G * NTHREADS;
    bf16* sgw = WSP(bf16, WS_SGWB); bf16* pwt = WSP(bf16, WS_POOLWT);
    for (int e = gt; e < DEPTH * 4 * 128 * 128; e += NGT) {
        sgw[e] = (bf16)f2bf(F.a->in[I_SGW][e]);
        const int d = (e >> 7) & 127, c = e & 127, lg = e >> 14;
        pwt[e] = (bf16)f2bf(F.a->in[I_POOLW][(size_t)lg * 16384 + c * 128 + d]);
    }
}
__device__ __forceinline__ void ssd_prep_oracle(Frame& F, int l) {
    const int gt = F.bid * NTHREADS + F.tid, NGT = F.G * NTHREADS;
    const bf16* P = WSP(bf16, WS_P); float* XC = WSP(float, WS_XC);
    const float* cw = F.a->in[I_M2CW] + (size_t)l * 4 * 1024; const float* cb = F.a->in[I_M2CB] + l * 1024;
    for (int i = gt; i < MT * 1024; i += NGT) {
        const int row = i >> 10, ch = i & 1023; int base, t, len; row_seq(row, base, t, len);
        float a = cb[ch];
#pragma unroll
        for (int k = 0; k < 4; ++k) { const int tt = t - 2 + k; if (tt >= 0 && tt < len) a += cw[k * 1024 + ch] * bf2f(P[(size_t)(base + tt) * NIN + PC_XBC + ch]); }
        XC[i] = siluf_(a);
    }
    const float* dtr = WSP(float, WS_DT); float* dts = WSP(float, WS_DTS);
    for (int i = gt; i < MT * 16; i += NGT) dts[i] = softplusf_(dtr[i] + F.a->in[I_M2DTB][l * 16 + (i & 15)]);
}
__device__ __forceinline__ void ssd_scan_oracle_job(Frame& F, int l, int b, int hd, int dir) {
    LAS float* xs = (LAS float*)(F.lds);
    LAS float* Bs = (LAS float*)(F.lds + 8192);
    LAS float* Cs = (LAS float*)(F.lds + 8192 + 16384);
    LAS float* ds = (LAS float*)(F.lds + 8192 + 32768);
    LAS float* yb = (LAS float*)(F.lds + 8192 + 32768 + 256);
    LAS int* rws = (LAS int*)(F.lds + 8192 + 32768 + 256 + 8192);
    const float* XC = WSP(float, WS_XC); const float* dts = WSP(float, WS_DTS); float* YD = WSP(float, WS_YD) + (size_t)dir * MT * GW;
    const int p = F.tid >> 3, nq = F.tid & 7, n0 = nq * 16, grp = hd >> 2;
    const float a = -expf(F.a->in[I_M2ALOG][l * 16 + dir * 8 + hd]);
    float hs[16];
#pragma unroll
    for (int k = 0; k < 16; ++k) hs[k] = 0.f;
    for (int q0 = 0; q0 < CTXL + SEQL; q0 += 32) {
        __syncthreads();
        for (int idx = F.tid; idx < 32 * 64; idx += NTHREADS) { const int i = idx >> 6, c = idx & 63; const int row = proc_row(q0 + i, dir, b); xs[idx] = XC[(size_t)row * 1024 + hd * 64 + c]; }
        for (int idx = F.tid; idx < 32 * 128; idx += NTHREADS) { const int i = idx >> 7, n = idx & 127; const int row = proc_row(q0 + i, dir, b);
            Bs[idx] = XC[(size_t)row * 1024 + 512 + grp * 128 + n]; Cs[idx] = XC[(size_t)row * 1024 + 768 + grp * 128 + n]; }
        if (F.tid < 32) { const int row = proc_row(q0 + F.tid, dir, b); ds[F.tid] = dts[(size_t)row * 16 + dir * 8 + hd]; rws[F.tid] = row; }
        __syncthreads();
        for (int i = 0; i < 32; ++i) {
            const float dt = ds[i], da = expf(dt * a), xd = xs[i * 64 + p] * dt;
            float part = 0.f;
#pragma unroll
            for (int k = 0; k < 16; ++k) { hs[k] = da * hs[k] + xd * Bs[i * 128 + n0 + k]; part += Cs[i * 128 + n0 + k] * hs[k]; }
            part += __shfl_xor(part, 1); part += __shfl_xor(part, 2); part += __shfl_xor(part, 4);
            if (nq == 0) yb[i * 64 + p] = part;
        }
        __syncthreads();
        for (int idx = F.tid; idx < 32 * 64; idx += NTHREADS) { const int i = idx >> 6, c = idx & 63; YD[(size_t)rws[i] * GW + hd * 64 + c] = yb[idx]; }
    }
    __syncthreads();
}
__device__ __forceinline__ void ssd_finish_oracle(Frame& F, int l) {
    const int gw = F.bid * NWAVES + F.wave, NGW = F.G * NWAVES;
    const float* XC = WSP(float, WS_XC); const float* YD = WSP(float, WS_YD); const bf16* P = WSP(bf16, WS_P); bf16* MIX = WSP(bf16, WS_MIX);
    for (int row = gw; row < MT; row += NGW) {
#pragma unroll
        for (int j = 0; j < 2; ++j) {
            const int ch = j * 256 + F.lane * 4;
            const f32x4 y0 = *(const f32x4*)(YD + (size_t)row * GW + ch), y1 = *(const f32x4*)(YD + (size_t)(MT + row) * GW + ch), xv = *(const f32x4*)(XC + (size_t)row * 1024 + ch);
            const float dh = F.a->in[I_M2D][l * 8 + (ch >> 6)];
            const v2u zz = *(const v2u*)(P + (size_t)row * NIN + PC_Z + ch);
            f32x4 gq; float zf[4] = {bflo(zz.x), bfhi(zz.x), bflo(zz.y), bfhi(zz.y)};
#pragma unroll
            for (int k = 0; k < 4; ++k) gq[k] = (y0[k] + y1[k] + dh * xv[k]) * siluf_(zf[k]);
            const float ss = wave_sum((gq[0] * gq[0] + gq[1] * gq[1]) + (gq[2] * gq[2] + gq[3] * gq[3]));
            const float rs = 1.f / sqrtf(ss * (1.f / 256.f) + RMS_EPS);
            const f32x4 nw = *(const f32x4*)(F.a->in[I_M2NW] + l * GW + ch);
            v2u w; w.x = pk2(gq[0] * rs * nw[0], gq[1] * rs * nw[1]); w.y = pk2(gq[2] * rs * nw[2], gq[3] * rs * nw[3]);
            *(v2u*)(MIX + (size_t)row * DM + MX_SSD + ch) = w;
        }
    }
}
__device__ __forceinline__ void sg_oracle_job(Frame& F, int l, int cj, int hh) {
    LAS float* v = (LAS float*)(F.lds);
    const bf16* P = WSP(bf16, WS_P); bf16* MIX = WSP(bf16, WS_MIX);
    const int r0 = cj * 128;
    __syncthreads();
    for (int j = F.wave; j < 128; j += NWAVES) {
        const unsigned w = *(const unsigned*)(P + (size_t)(r0 + j) * NIN + PC_SGV + hh * 128 + F.lane * 2);
        const float a0 = gelu_tanh(bflo(w)), a1 = gelu_tanh(bfhi(w));
        const float mean = wave_sum(a0 + a1) * (1.f / 128.f);
        const float d0 = a0 - mean, d1 = a1 - mean;
        const float rstd = 1.f / sqrtf(wave_sum(d0 * d0 + d1 * d1) * (1.f / 128.f) + LN_EPS);
        const int d = F.lane * 2;
        v[j * 128 + d] = d0 * rstd * F.a->in[I_SGLNG][l * GW + hh * 128 + d] + F.a->in[I_SGLNB][l * GW + hh * 128 + d];
        v[j * 128 + d + 1] = d1 * rstd * F.a->in[I_SGLNG][l * GW + hh * 128 + d + 1] + F.a->in[I_SGLNB][l * GW + hh * 128 + d + 1];
    }
    __syncthreads();
    const int d = F.tid & 127, ig = F.tid >> 7;
    const float* ws = F.a->in[I_SGW] + (size_t)(l * 4 + hh) * 128 * 128;
    for (int ii = 0; ii < 32; ++ii) {
        const int i = ig * 32 + ii;
        float s = F.a->in[I_SGB][(l * 4 + hh) * 128 + i];
        for (int j = 0; j < 128; ++j) s += ws[i * 128 + j] * v[j * 128 + d];
        const float uu = gelu_tanh(bf2f(P[(size_t)(r0 + i) * NIN + PC_SGU + hh * 128 + d]));
        MIX[(size_t)(r0 + i) * DM + MX_SG + hh * 128 + d] = (bf16)f2bf(uu * s);
    }
    __syncthreads();
}
__device__ __forceinline__ void pool_oracle_job(Frame& F, int l, int tile, int gp) {
    LAS float* m = (LAS float*)(F.lds);
    const bf16* P = WSP(bf16, WS_P); bf16* MIX = WSP(bf16, WS_MIX);
    const int r0 = tile * 32, win = 2 << gp;
    __syncthreads();
    for (int idx = F.tid; idx < 32 * 128; idx += NTHREADS) {
        const int i = idx >> 7, c = idx & 127; int base, t, len; row_seq(r0 + i, base, t, len);
        int lo = t - win / 2; if (lo < 0) lo = 0; int hi = t + win / 2 - 1; if (hi > len - 1) hi = len - 1;
        float s = 0.f;
        for (int k = lo; k <= hi; ++k) s += bf2f(P[(size_t)(base + k) * NIN + PC_POOL + gp * 128 + c]);
        m[idx] = s / (float)(hi - lo + 1) - bf2f(P[(size_t)(r0 + i) * NIN + PC_POOL + gp * 128 + c]);
    }
    __syncthreads();
    const int d = F.tid & 127, ig = F.tid >> 7;
    const float* w = F.a->in[I_POOLW] + (size_t)(l * 4 + gp) * 128 * 128;
    for (int ii = 0; ii < 8; ++ii) {
        const int i = ig * 8 + ii; float s = 0.f;
        for (int c = 0; c < 128; ++c) s += m[i * 128 + c] * w[c * 128 + d];
        s = (s + F.a->in[I_POOLB][l * GW + gp * 128 + d]) * F.a->in[I_POOLS][l * GW + gp * 128 + d];
        MIX[(size_t)(r0 + i) * DM + MX_POOL + gp * 128 + d] = (bf16)f2bf(s);
    }
    __syncthreads();
}
__device__ __forceinline__ void ffn_act_oracle(Frame& F, int l, int nrows) {
    const int gt = F.bid * NTHREADS + F.tid, NGT = F.G * NTHREADS;
    const bf16* GV = WSP(bf16, WS_GV); bf16* ACT = WSP(bf16, WS_ACT);
    const float* cw = F.a->in[I_FCW] + (size_t)l * 9 * FF; const float* cb = F.a->in[I_FCB] + l * FF;
    constexpr int FV = FF / 8;
    for (int i = gt; i < nrows * FV; i += NGT) {
        const int row = i / FV, f0 = (i % FV) * 8;
        float a[8];
#pragma unroll
        for (int k = 0; k < 8; ++k) a[k] = cb[f0 + k];
        if (row < ML) {
            const int b = row >> 12, t = row & 4095, r = t >> 6, c = t & 63;
            for (int dr = -1; dr <= 1; ++dr) for (int dc = -1; dc <= 1; ++dc) {
                const int rr = r + dr, c2 = c + dc; if (rr < 0 || rr > 63 || c2 < 0 || c2 > 63) continue;
                const v4u g = *(const v4u*)(GV + (size_t)(b * SEQL + rr * 64 + c2) * FF2 + f0);
                const float* w = cw + ((dr + 1) * 3 + (dc + 1)) * FF + f0;
                a[0] += w[0] * bflo(g.x); a[1] += w[1] * bfhi(g.x); a[2] += w[2] * bflo(g.y); a[3] += w[3] * bfhi(g.y);
                a[4] += w[4] * bflo(g.z); a[5] += w[5] * bfhi(g.z); a[6] += w[6] * bflo(g.w); a[7] += w[7] * bfhi(g.w);
            }
        } else {
            int base, t, len; row_seq(row, base, t, len);
            for (int k = 0; k < 3; ++k) { const int tt = t + k - 1; if (tt < 0 || tt >= len) continue;
                const v4u g = *(const v4u*)(GV + (size_t)(base + tt) * FF2 + f0);
                const float* w = cw + (3 + k) * FF + f0;
                a[0] += w[0] * bflo(g.x); a[1] += w[1] * bfhi(g.x); a[2] += w[2] * bflo(g.y); a[3] += w[3] * bfhi(g.y);
                a[4] += w[4] * bflo(g.z); a[5] += w[5] * bfhi(g.z); a[6] += w[6] * bflo(g.w); a[7] += w[7] * bfhi(g.w);
            }
        }
        const v4u vv = *(const v4u*)(GV + (size_t)row * FF2 + FF + f0);
        v4u o;
        o.x = pk2(gelu_tanh(a[0]) * bflo(vv.x), gelu_tanh(a[1]) * bfhi(vv.x)); o.y = pk2(gelu_tanh(a[2]) * bflo(vv.y), gelu_tanh(a[3]) * bfhi(vv.y));
        o.z = pk2(gelu_tanh(a[4]) * bflo(vv.z), gelu_tanh(a[5]) * bfhi(vv.z)); o.w = pk2(gelu_tanh(a[6]) * bflo(vv.w), gelu_tanh(a[7]) * bfhi(vv.w));
        *(v4u*)(ACT + (size_t)row * FF + f0) = o;
    }
}

constexpr int PH_PRO_A = 0, PH_PRO_B = 1, PH_PRO_C = 2, PH_L0 = 3, NPH_L = 13, N_PHASES = PH_L0 + DEPTH * NPH_L;


__device__ __forceinline__ void fma8(float (&a)[8], const float (&w)[8], const v4u g) {
    a[0] += w[0] * bflo(g.x); a[1] += w[1] * bfhi(g.x); a[2] += w[2] * bflo(g.y); a[3] += w[3] * bfhi(g.y);
    a[4] += w[4] * bflo(g.z); a[5] += w[5] * bfhi(g.z); a[6] += w[6] * bflo(g.w); a[7] += w[7] * bfhi(g.w);
}
__device__ __forceinline__ void ffn_act(Frame& F, int l, bool with_ctx) {
    const int gt = F.bid * NTHREADS + F.tid, NGT = F.G * NTHREADS;
    const bf16* GV = WSP(bf16, WS_GV); bf16* ACT = WSP(bf16, WS_ACT);
    const float* cw = F.a->in[I_FCW] + (size_t)l * 9 * FF; const float* cb = F.a->in[I_FCB] + l * FF;
    constexpr int FV = FF / 8, SEG = 32;
    const int nseg_lat = ML / SEG, nseg = nseg_lat + (with_ctx ? MC / SEG : 0);
    for (int task = gt; task < nseg * FV; task += NGT) {
        const int fv = task % FV, sg = task / FV, f0 = fv * 8;
        int row0, lstart, llen; bool has_up, has_dn;
        if (sg < nseg_lat) { row0 = sg * SEG; lstart = row0 & ~63; llen = 64; const int gr = (row0 >> 6) & 63; has_up = gr > 0; has_dn = gr < 63; }
        else { row0 = ML + (sg - nseg_lat) * SEG; lstart = ML + ((row0 - ML) & ~(CTXL - 1)); llen = CTXL; has_up = false; has_dn = false; }
        float w[9][8], bsv[8];
#pragma unroll
        for (int k = 0; k < 9; ++k) { const f32x4 a = *(const f32x4*)(cw + k * FF + f0), b = *(const f32x4*)(cw + k * FF + f0 + 4);
            w[k][0] = a[0]; w[k][1] = a[1]; w[k][2] = a[2]; w[k][3] = a[3]; w[k][4] = b[0]; w[k][5] = b[1]; w[k][6] = b[2]; w[k][7] = b[3]; }
        { const f32x4 a = *(const f32x4*)(cb + f0), b = *(const f32x4*)(cb + f0 + 4); bsv[0] = a[0]; bsv[1] = a[1]; bsv[2] = a[2]; bsv[3] = a[3]; bsv[4] = b[0]; bsv[5] = b[1]; bsv[6] = b[2]; bsv[7] = b[3]; }
        const v4u zero = {0u, 0u, 0u, 0u};
        const bf16* gp = GV + (size_t)row0 * FF2 + f0;
        const int c0 = row0 - lstart;
        v4u Lu, Lm, Ld, Mu, Mm, Md, Ru, Rm, Rd;
        if (c0 > 0) { Lm = *(const v4u*)(gp - (size_t)FF2); Lu = has_up ? *(const v4u*)(gp - (size_t)65 * FF2) : zero; Ld = has_dn ? *(const v4u*)(gp + (size_t)63 * FF2) : zero; } else { Lu = zero; Lm = zero; Ld = zero; }
        Mm = *(const v4u*)(gp); Mu = has_up ? *(const v4u*)(gp - (size_t)64 * FF2) : zero; Md = has_dn ? *(const v4u*)(gp + (size_t)64 * FF2) : zero;
#pragma unroll 2
        for (int i = 0; i < SEG; ++i) {
            const bf16* gc = gp + (size_t)i * FF2;
            if (c0 + i + 1 < llen) { Rm = *(const v4u*)(gc + (size_t)FF2); Ru = has_up ? *(const v4u*)(gc - (size_t)63 * FF2) : zero; Rd = has_dn ? *(const v4u*)(gc + (size_t)65 * FF2) : zero; } else { Ru = zero; Rm = zero; Rd = zero; }
            const v4u vv = *(const v4u*)(gc + FF);
            float a[8];
#pragma unroll
            for (int e = 0; e < 8; ++e) a[e] = bsv[e];
            fma8(a, w[0], Lu); fma8(a, w[1], Mu); fma8(a, w[2], Ru);
            fma8(a, w[3], Lm); fma8(a, w[4], Mm); fma8(a, w[5], Rm);
            fma8(a, w[6], Ld); fma8(a, w[7], Md); fma8(a, w[8], Rd);
            v4u o;
            o.x = pk2(gelu_tanh(a[0]) * bflo(vv.x), gelu_tanh(a[1]) * bfhi(vv.x)); o.y = pk2(gelu_tanh(a[2]) * bflo(vv.y), gelu_tanh(a[3]) * bfhi(vv.y));
            o.z = pk2(gelu_tanh(a[4]) * bflo(vv.z), gelu_tanh(a[5]) * bfhi(vv.z)); o.w = pk2(gelu_tanh(a[6]) * bflo(vv.w), gelu_tanh(a[7]) * bfhi(vv.w));
            *(v4u*)(ACT + (size_t)(row0 + i) * FF + f0) = o;
            Lu = Mu; Lm = Mm; Ld = Md; Mu = Ru; Mm = Rm; Md = Rd;
        }
    }
}
typedef GAS unsigned gu32;
#define RLX_AGENT __ATOMIC_RELAXED, __HIP_MEMORY_SCOPE_AGENT
constexpr int CW_BAR = 4096;
constexpr int LDS_ST_OFF = LDS_BYTES - 64;
#define XB_TMO      128
#define XB_XCNT(j)  (256  + 64 * (j))
#define XB_XSUB(j)  (1280 + 64 * (j))
#define XB_XGEN(j)  (2304 + 64 * (j))
#define XB_TOP      3328
#define XB_TOPGEN   3392
#define XCD_BAR_WORDS 3456
#define XB_SPIN_CAP (1u << 18)

__device__ __forceinline__ unsigned xb_ld(unsigned* p)              { return __hip_atomic_load(p, __ATOMIC_RELAXED, __HIP_MEMORY_SCOPE_AGENT); }
__device__ __forceinline__ unsigned xb_add(unsigned* p, unsigned v) { return __hip_atomic_fetch_add(p, v, __ATOMIC_RELAXED, __HIP_MEMORY_SCOPE_AGENT); }
__device__ __forceinline__ unsigned xb_xcc_id() { return (unsigned)__builtin_amdgcn_s_getreg((3 << 11) | 20) & 0xFu; }
#define XB_SPIN(cond, bar) do { unsigned _sp = 0; while (cond) { __builtin_amdgcn_s_sleep(1); \
    if ((++_sp & 255u) == 0u) { if (xb_ld(&(bar)[XB_TMO])) break; if (_sp > XB_SPIN_CAP) { atomicAdd(&(bar)[XB_TMO], 1u); break; } } } } while (0)

struct XcdBarrier {
    unsigned* bar; unsigned x;
    volatile LAS unsigned* st;
};

__device__ __forceinline__ XcdBarrier xcd_barrier_post(unsigned* bar, volatile LAS unsigned* st) {
    XcdBarrier b; b.bar = bar; b.x = xb_xcc_id(); b.st = st;
    if (threadIdx.x == 0) (void)xb_add(&bar[XB_XCNT(b.x)], 1u);
    return b;
}
__device__ __forceinline__ void xcd_barrier_complete(unsigned* bar, unsigned x, unsigned& nloc, unsigned& nx) {
    const unsigned G = gridDim.x * gridDim.y * gridDim.z;
    unsigned sum, cnt, mine, sp = 0u;
    for (;;) {
        sum = 0u; cnt = 0u; mine = 0u;
#pragma unroll
        for (unsigned j = 0; j < 16; ++j) { const unsigned c = xb_ld(&bar[XB_XCNT(j)]); sum += c; cnt += (c > 0u) ? 1u : 0u; mine = (j == x) ? c : mine; }
        if (sum == G) break;
        __builtin_amdgcn_s_sleep(1);
        if ((++sp & 255u) == 0u) { if (xb_ld(&bar[XB_TMO])) break; if (sp > XB_SPIN_CAP) { atomicAdd(&bar[XB_TMO], 1u); break; } }
    }
    nloc = mine > 0u ? mine : 1u; nx = cnt > 0u ? cnt : 1u;
}

__device__ __forceinline__ void xcd_barrier(const XcdBarrier& b) {
    asm volatile("s_waitcnt vmcnt(0)" ::: "memory");
    __syncthreads();
    if (threadIdx.x == 0) {
        unsigned* bar = b.bar;
        __builtin_amdgcn_s_waitcnt(0);
        unsigned nloc = b.st[0], nx = b.st[1];
        if (nloc == 0u) { xcd_barrier_complete(bar, b.x, nloc, nx); b.st[0] = nloc; b.st[1] = nx; }
        const unsigned old = xb_add(&bar[XB_XSUB(b.x)], 1u);
        const unsigned gen = old / nloc;
        if (old + 1u == (gen + 1u) * nloc) {
            __builtin_amdgcn_fence(__ATOMIC_RELEASE, "agent");
            asm volatile("s_waitcnt vmcnt(0)" ::: "memory");
            const unsigned og = xb_add(&bar[XB_TOP], 1u);
            const unsigned tg = og / nx;
            if (og + 1u == (tg + 1u) * nx) xb_add(&bar[XB_TOPGEN], 1u);
            else XB_SPIN(xb_ld(&bar[XB_TOPGEN]) == tg, bar);
            __builtin_amdgcn_fence(__ATOMIC_ACQUIRE, "agent");
            xb_add(&bar[XB_XGEN(b.x)], 1u);
            asm volatile("s_waitcnt vmcnt(0)" ::: "memory");
        } else {
            XB_SPIN(xb_ld(&bar[XB_XGEN(b.x)]) == gen, bar);
            __builtin_amdgcn_fence(__ATOMIC_ACQUIRE, "agent");
            asm volatile("s_waitcnt vmcnt(0)" ::: "memory");
        }
    }
    __syncthreads();
}


__device__ __forceinline__ void grid_bar() {
    XcdBarrier b; b.bar = (unsigned*)((const __attribute__((address_space(4))) Args*)__builtin_amdgcn_kernarg_segment_ptr())->ws + CW_BAR; b.x = xb_xcc_id();
    extern __shared__ __attribute__((aligned(16))) unsigned char lds_raw_[];
    b.st = (volatile LAS unsigned*)((LAS unsigned char*)lds_raw_ + LDS_ST_OFF);
    xcd_barrier(b);
}

constexpr int CW_QUEUE = 1024;
__device__ __forceinline__ int next_job(Frame& F, int q) {
    volatile LAS int* slot = (volatile LAS int*)(F.lds + LDS_BYTES - 128);
    __syncthreads();
    if (F.tid == 0) *slot = (int)__hip_atomic_fetch_add((unsigned*)(F.a->ws + WS_CTL) + CW_QUEUE + 64 * q, 1u, __ATOMIC_RELAXED, __HIP_MEMORY_SCOPE_AGENT);
    __syncthreads();
    return *slot;
}
template <int PH>
__device__ __forceinline__ void run_phase(LAS unsigned char* ldsp) {
    Frame F;
    F.lds = ldsp;
    { int t_ = threadIdx.x; asm volatile("" : "+v"(t_)); F.tid = t_; }
    F.lane = F.tid & 63; F.wave = __builtin_amdgcn_readfirstlane(F.tid >> 6);
    { int b_ = blockIdx.x, g_ = gridDim.x; asm volatile("" : "+s"(b_), "+s"(g_)); F.bid = b_; F.G = g_; }
    { const __attribute__((address_space(4))) Args* ap = (const __attribute__((address_space(4))) Args*)__builtin_amdgcn_kernarg_segment_ptr(); asm volatile("" : "+s"(ap)); F.a = ap; }
    if constexpr (PH == PH_PRO_A) { phase_pro_a(F); sgpool_tables(F); for (int j = F.bid; j < DEPTH * 2 * 32; j += F.G) s5_tables_job(F, j >> 6, (j >> 5) & 1, j & 31); }
    else if constexpr (PH == PH_PRO_B) phase_pro_b(F);
    else if constexpr (PH == PH_PRO_C) phase_pro_c(F);
    else {
        constexpr int l = (PH - PH_L0) / NPH_L, sp = (PH - PH_L0) % NPH_L;
        constexpr int MR = (l == DEPTH - 1) ? ML : MT;
        if constexpr (sp == 0) {
            pg8::Gemm g{WSP(bf16, WS_HMOD), WSP(bf16, WS_WIN) + (size_t)l * NIN * DM, MT, NIN, DM, DM, DM}; pg8::StaticOrder S; S.init(MT, NIN, F.G, F.bid);
            pg8::EpiIn E{WSP(bf16, WS_P), WSP(float, WS_DT)};
            pg8::gemm_phase<pg8::EpiIn, pg8::StaticOrder, true, true>(F.lds, g, S, E);
        } else if constexpr (sp == 1) {
            constexpr int NCJ = (l == DEPTH - 1) ? 64 : 68, N0 = 136, N1 = N0 + NCJ * 8, N2 = N1 + 32 * 17;
            for (int j = next_job(F, l * 2); j < N2; j = next_job(F, l * 2)) {
                if (j < N0) ssd_state_job(F, l, j >> 1, j & 1);
                else if (j < N1) { const int k = j - N0; if (k & 1) pool_job(F, l, k >> 3, (k >> 1) & 3); else sg_job(F, l, k >> 3, (k >> 1) & 3); }
                else { const int k = j - N1; s5_state_job(F, l, k % 32, k / 32); }
            }
        } else if constexpr (sp == 2) {
            if (F.bid < 128) ssd_scan(F, F.bid * NTHREADS + F.tid);
            else if (F.bid < 144) s5_scan(F, l, (F.bid - 128) * NTHREADS + F.tid);
        } else if constexpr (sp == 3) {
            constexpr int NSSD = (l == DEPTH - 1) ? 128 : 136, NS5 = 32 * ((l == DEPTH - 1) ? 16 : 17);
            for (int j = next_job(F, l * 2 + 1); j < NSSD + NS5; j = next_job(F, l * 2 + 1)) { if (j < NSSD) ssd_y_job(F, l, j >> 1, j & 1); else s5_out_job(F, l, (j - NSSD) % 32, (j - NSSD) / 32); }
        } else if constexpr (sp == 4) {
            pg8::Gemm g{WSP(bf16, WS_Z), WSP(bf16, WS_WGLU) + (size_t)l * GW * GW, MR, GW, GW, GW, GW}; pg8::StaticOrder S; S.init(MR, GW, F.G, F.bid);
            pg8::EpiGlu E{WSP(bf16, WS_Z), WSP(bf16, WS_MIX), F.a->in[I_GLUB] + l * GW};
            pg8::gemm_phase<pg8::EpiGlu, pg8::StaticOrder, true, true>(F.lds, g, S, E);
        } else if constexpr (sp == 5) {
            pg8::Gemm g{WSP(bf16, WS_MIX), WSP(bf16, WS_WOUT) + (size_t)l * DM * DM, ML, DM, DM, DM, DM}; pg8::StaticOrder S; S.init(ML, DM, F.G, F.bid);
            pg8::EpiRes E{WSP(float, WS_H), mvec(F, l, 0, 2), 6 * DM};
            pg8::gemm_phase<pg8::EpiRes, pg8::StaticOrder, true, true>(F.lds, g, S, E);
        } else if constexpr (sp == 6) {
            if constexpr (MR > ML) {
                pg8::Gemm g2{WSP(bf16, WS_MIX), WSP(bf16, WS_WOUT) + (size_t)l * DM * DM, MC, DM, 512, DM, DM}; pg8::SplitOrder S2; S2.init(DM, 4, 512, ML / 256, F.G, F.bid);
                pg8::EpiSlab E2{WSP(float, WS_SLAB), 512, ML / 256};
                pg8::gemm_phase<pg8::EpiSlab, pg8::SplitOrder, true, true>(F.lds, g2, S2, E2);
            }
        } else if constexpr (sp == 7) {
            phase_ln(F, F.a->in[I_LN1G] + l * DM, F.a->in[I_LN1B] + l * DM, l, 3, false, MR, 4, mvec(F, l, 2, 2));
        } else if constexpr (sp == 8) {
            pg8::Gemm g{WSP(bf16, WS_HMOD), WSP(bf16, WS_WUP) + (size_t)l * FF2 * DM, MR, FF2, DM, DM, DM}; pg8::StaticOrder S; S.init(MR, FF2, F.G, F.bid);
            pg8::EpiStore E{WSP(bf16, WS_GV), FF2};
            pg8::gemm_phase<pg8::EpiStore, pg8::StaticOrder, true, true>(F.lds, g, S, E);
        } else if constexpr (sp == 9) {
            ffn_act(F, l, l != DEPTH - 1);
        } else if constexpr (sp == 10) {
            pg8::Gemm g{WSP(bf16, WS_ACT), WSP(bf16, WS_WDN) + (size_t)l * DM * FF, ML, DM, FF, FF, FF}; pg8::StaticOrder S; S.init(ML, DM, F.G, F.bid);
            pg8::EpiRes E{WSP(float, WS_H), mvec(F, l, 0, 5), 6 * DM};
            pg8::gemm_phase<pg8::EpiRes, pg8::StaticOrder, true, true>(F.lds, g, S, E);
        } else if constexpr (sp == 11) {
            if constexpr (MR > ML) {
                pg8::Gemm g2{WSP(bf16, WS_ACT), WSP(bf16, WS_WDN) + (size_t)l * DM * FF, MC, DM, 512, FF, FF}; pg8::SplitOrder S2; S2.init(DM, 11, 512, ML / 256, F.G, F.bid);
                pg8::EpiSlab E2{WSP(float, WS_SLAB), 512, ML / 256};
                pg8::gemm_phase<pg8::EpiSlab, pg8::SplitOrder, true, true>(F.lds, g2, S2, E2);
            }
        } else {
            constexpr bool fin = (l == DEPTH - 1);
            phase_ln(F, F.a->in[I_LN2G] + l * DM, F.a->in[I_LN2B] + l * DM, fin ? l : l + 1, 0, fin, MR, 11, mvec(F, l, 2, 5));
        }
    }
}
template <int PH, int HI>
__device__ __forceinline__ void run_range(LAS unsigned char* ldsp) {
    run_phase<PH>(ldsp);
#if defined(PROBE_DUP)
    {
        constexpr int sp_ = PH >= PH_L0 ? (PH - PH_L0) % NPH_L : -1;
        constexpr bool dup = (PROBE_DUP == 1 && PH == PH_PRO_A) || (PROBE_DUP == 2 && (sp_ == 1 || sp_ == 2 || sp_ == 3)) || (PROBE_DUP == 3 && (sp_ == 9 || PH == PH_PRO_C)) || (PROBE_DUP == 4 && sp_ == 0) || (PROBE_DUP == 5 && sp_ == 8) || (PROBE_DUP == 6 && sp_ == 1) || (PROBE_DUP == 7 && sp_ == 2) || (PROBE_DUP == 8 && sp_ == 3) || (PROBE_DUP == 9 && sp_ == 4);
        if constexpr (dup) { grid_bar(); run_phase<PH>(ldsp); }
    }
#endif
    if constexpr (PH + 1 < HI) {
        constexpr int spb = PH >= PH_L0 ? (PH - PH_L0) % NPH_L : -1;
        if constexpr (PH == 0) cg::this_grid().sync();
        else if constexpr (spb != 5 && spb != 10) grid_bar();
        run_range<PH + 1, HI>(ldsp);
    }
}
template <int LO, int HI>
__global__ void __launch_bounds__(NTHREADS, 2) mk_fwd(Args args) {
    extern __shared__ __attribute__((aligned(16))) unsigned char lds[];
    if constexpr (HI - LO > 1) {
        volatile LAS unsigned* st = (volatile LAS unsigned*)((LAS unsigned char*)lds + LDS_ST_OFF);
        if (threadIdx.x == 0) { st[0] = 0u; st[1] = 0u; }
        __syncthreads();
        (void)xcd_barrier_post((unsigned*)((const __attribute__((address_space(4))) Args*)__builtin_amdgcn_kernarg_segment_ptr())->ws + CW_BAR, st);
    }
    run_range<LO, HI>((LAS unsigned char*)lds);
}

#ifndef MK_ONE_LAUNCH
#define MK_ONE_LAUNCH 1
#endif
template <int PH> static void launch_phases(const Args& a, int grid, hipStream_t stream) {
    hipFuncSetAttribute((const void*)mk_fwd<PH, PH + 1>, hipFuncAttributeMaxDynamicSharedMemorySize, LDS_BYTES);
    hipLaunchKernelGGL((mk_fwd<PH, PH + 1>), dim3(grid), dim3(NTHREADS), LDS_BYTES, stream, a);
    if constexpr (PH + 1 < N_PHASES) launch_phases<PH + 1>(a, grid, stream);
}

extern "C" void kernel_launch(void* const* d_in, const int* in_sizes, int n_in, void* d_out, int out_size, void* d_ws, size_t ws_size, hipStream_t stream) {
    static int grid = 0;
    if (grid == 0) {
        if (n_in != N_IN || out_size != ML * DM || ws_size < WS_END) { fprintf(stderr, "kernel_launch: unexpected shapes n_in %d out %d ws %zu (need %zu)\n", n_in, out_size, ws_size, (size_t)WS_END); grid = -1; return; }
        int dev = 0, cus = 0;
        (void)hipGetDevice(&dev); (void)hipDeviceGetAttribute(&cus, hipDeviceAttributeMultiprocessorCount, dev);
#if MK_ONE_LAUNCH
        int per_cu = 0;
        if (hipFuncSetAttribute((const void*)mk_fwd<0, N_PHASES>, hipFuncAttributeMaxDynamicSharedMemorySize, LDS_BYTES) != hipSuccess) { fprintf(stderr, "hipFuncSetAttribute failed\n"); grid = -1; return; }
        (void)hipOccupancyMaxActiveBlocksPerMultiprocessor(&per_cu, (const void*)mk_fwd<0, N_PHASES>, NTHREADS, LDS_BYTES);
        (void)hipGetLastError();
        fprintf(stderr, "kernel_launch: cus %d per_cu %d\n", cus, per_cu);
        if (per_cu < 1) { grid = -1; return; }
#endif
        grid = cus;
    }
    if (grid < 0) return;
    (void)hipMemsetAsync((char*)d_ws + WS_CTL, 0, 65536, stream);
    Args a{};
    for (int i = 0; i < N_IN; ++i) a.in[i] = (const float*)d_in[i];
    a.out = (float*)d_out; a.ws = (unsigned char*)d_ws;
#if MK_ONE_LAUNCH
    void* kargs[] = {&a};
    hipError_t e = hipLaunchCooperativeKernel((const void*)mk_fwd<0, N_PHASES>, dim3(grid), dim3(NTHREADS), kargs, LDS_BYTES, stream);
    if (e != hipSuccess) fprintf(stderr, "cooperative launch failed: %s\n", hipGetErrorString(e));
#else
    launch_phases<0>(a, grid, stream);
#endif
}
```
